# Optimizing an MI355X kernel written in HIP

```python
import jax, jax.numpy as jnp
from jax import lax
import numpy as np

D_MODEL = 1024
BATCH = 32
SEQ = 2048
DEPTH = 1

GRID_W = 64
Q_BLOCK = 128
ROPE_THETA = 10000.0
MIX_WIDTH = D_MODEL
HEAD_DIM = 64
ATT_WIDTH = MIX_WIDTH // 2
ATT_HEADS = ATT_WIDTH // HEAD_DIM
ATT_KV_HEADS = 2
KV_WIDTH = ATT_KV_HEADS * HEAD_DIM
RWKV_WIDTH = MIX_WIDTH - ATT_WIDTH
RWKV_HEAD = 64
RWKV_HEADS = RWKV_WIDTH // RWKV_HEAD
DECAY_LORA = 64
ICLR_LORA = 64
GATE_LORA = 128
N_SHIFT = 3 * RWKV_WIDTH + DECAY_LORA + ICLR_LORA + GATE_LORA
N_IN = ATT_WIDTH + 2 * KV_WIDTH + N_SHIFT
DECAY_SCALE = 0.606531
GN_EPS = 64e-5
NORM_EPS = 1e-6
L2_EPS = 1e-12
N_EXPERTS = 16
EC_CAPACITY = 2
EXPERT_FF = 1024

kernel_name = "hybrid_attn_rwkv7_ec_moe_block"


def _rmsnorm(x, g):
    xf = x.astype(jnp.float32)
    y = xf * lax.rsqrt(jnp.mean(xf * xf, axis=-1, keepdims=True) + NORM_EPS)
    return y.astype(x.dtype) * g


def _axial_rope_tables(seq):
    rows = seq // GRID_W
    row = jnp.repeat(jnp.arange(rows, dtype=jnp.float32), GRID_W)
    col = jnp.tile(jnp.arange(GRID_W, dtype=jnp.float32), rows)
    n_pairs_axis = HEAD_DIM // 4
    freqs = ROPE_THETA ** (-jnp.arange(n_pairs_axis, dtype=jnp.float32) / n_pairs_axis)
    ang = jnp.concatenate([row[:, None] * freqs, col[:, None] * freqs], axis=-1)
    return jnp.cos(ang), jnp.sin(ang)


def _apply_rope(x, cos, sin):
    xp = x.reshape(*x.shape[:-1], HEAD_DIM // 2, 2)
    x0, x1 = xp[..., 0], xp[..., 1]
    c = cos[None, :, None, :].astype(x.dtype)
    s = sin[None, :, None, :].astype(x.dtype)
    return jnp.stack([x0 * c - x1 * s, x0 * s + x1 * c], axis=-1).reshape(x.shape)


def _block_attention(q, k, v):
    B, S = q.shape[:2]
    nb = S // Q_BLOCK
    grp = ATT_HEADS // ATT_KV_HEADS
    qb = q.reshape(B, nb, Q_BLOCK, ATT_KV_HEADS, grp, HEAD_DIM).transpose(1, 0, 2, 3, 4, 5)
    scale = HEAD_DIM ** -0.5

    def one_block(qi):
        s = jnp.einsum('bqhgd,bkhd->bhgqk', qi, k, preferred_element_type=jnp.float32) * scale
        p = jax.nn.softmax(s, axis=-1).astype(v.dtype)
        return jnp.einsum('bhgqk,bkhd->bqhgd', p, v)

    o = lax.map(one_block, qb)
    return o.transpose(1, 0, 2, 3, 4, 5).reshape(B, S, ATT_WIDTH)


def _centred_shift(p, mu):
    zero = jnp.zeros_like(p[:, :1])
    prev = jnp.concatenate([zero, p[:, :-1]], axis=1)
    nxt = jnp.concatenate([p[:, 1:], zero], axis=1)
    return p + mu * (0.5 * (prev + nxt) - p)


def _wkv7_scan(r, w, k, v, kk, a, reverse):
    B, T, H, N = r.shape

    def step(S, inp):
        r_t, w_t, k_t, v_t, kk_t, a_t = inp
        sa = jnp.einsum('bhvk,bhk->bhv', S, -kk_t)
        S = (S * w_t[:, :, None, :] + sa[..., None] * (kk_t * a_t)[:, :, None, :]
             + v_t[..., None] * k_t[:, :, None, :])
        return S, jnp.einsum('bhvk,bhk->bhv', S, r_t)

    xs = tuple(jnp.swapaxes(z, 0, 1) for z in (r, w, k, v, kk, a))
    S0 = jnp.zeros((B, H, N, N), jnp.float32)
    _, y = lax.scan(step, S0, xs, reverse=reverse)
    return jnp.swapaxes(y, 0, 1)


def _rwkv7_bidir(p, mu_shift, w0, w_up, a0, a_up, g_up, k_k, k_a, r_k, ln_w, ln_b):
    dt = p.dtype
    p = _centred_shift(p, mu_shift)
    R = RWKV_WIDTH
    r, k, v, dw, da, dg = jnp.split(
        p, [R, 2 * R, 3 * R, 3 * R + DECAY_LORA, 3 * R + DECAY_LORA + ICLR_LORA], axis=-1)
    B, T, _ = r.shape

    def heads(z):
        return z.reshape(B, T, RWKV_HEADS, RWKV_HEAD).astype(jnp.float32)

    kk = heads(k * k_k)
    kk = kk / jnp.maximum(jnp.sqrt(jnp.sum(kk * kk, axis=-1, keepdims=True)), L2_EPS)
    g = jax.nn.sigmoid(dg) @ g_up
    tw = jnp.tanh(dw)
    rh, vh = heads(r), heads(v)

    def direction(d, reverse):
        w = jnp.exp(-DECAY_SCALE * jax.nn.sigmoid(w0[d] + tw @ w_up[d]))
        a = jax.nn.sigmoid(a0[d] + da @ a_up[d])
        kd = heads(k * (1.0 + (a - 1.0) * k_a))
        ah = heads(a)
        y = _wkv7_scan(rh, heads(w), kd, vh, kk, ah, reverse)
        bonus = jnp.sum(rh * kd * r_k, axis=-1, keepdims=True) * vh
        return y, bonus

    y_f, bonus_f = direction(0, False)
    y_b, bonus_b = direction(1, True)
    y = y_f + y_b
    mean = jnp.mean(y, axis=-1, keepdims=True)
    var = jnp.mean(jnp.square(y - mean), axis=-1, keepdims=True)
    y = ((y - mean) * lax.rsqrt(var + GN_EPS)).reshape(B, T, R) * ln_w + ln_b
    y = y + (bonus_f + bonus_b).reshape(B, T, R)
    return (y * g).astype(dt)


def _expert_choice_ffn(h, w_router, w_gate, w_up, w_down):
    B, S, D = h.shape
    cap = EC_CAPACITY * S // N_EXPERTS
    aff = jax.nn.softmax((h @ w_router).astype(jnp.float32), axis=-1)
    vals, idx = lax.top_k(jnp.swapaxes(aff, 1, 2), cap)
    hg = jax.vmap(lambda hb, ib: hb[ib])(h, idx)
    hid = (jax.nn.silu(jnp.einsum('becd,edf->becf', hg, w_gate))
           * jnp.einsum('becd,edf->becf', hg, w_up))
    y = jnp.einsum('becf,efd->becd', hid, w_down) * vals[..., None].astype(h.dtype)
    return jax.vmap(
        lambda yb, ib: jnp.zeros((S, D), h.dtype).at[ib.reshape(-1)].add(yb.reshape(-1, D))
    )(y, idx)


def setup_inputs(seed: int = 0) -> dict:
    key = jax.random.key(seed)
    ks = jax.random.split(key, 28)
    L, D, E, F = DEPTH, D_MODEL, N_EXPERTS, EXPERT_FF

    def nrm(k, shape, s):
        return jax.random.normal(k, shape, jnp.float32) * s

    return {
        "x": nrm(ks[0], (BATCH, SEQ, D), 1.0),
        "c": nrm(ks[1], (BATCH, D), 1.0),
        "w_ada": nrm(ks[2], (L, D, 6 * D), 0.5 * D ** -0.5),
        "b_ada": nrm(ks[3], (L, 6 * D), 0.02),
        "g_mix": 1.0 + nrm(ks[4], (L, D), 0.02),
        "w_in": nrm(ks[5], (L, D, N_IN), D ** -0.5),
        "q_norm": 1.0 + nrm(ks[6], (L, HEAD_DIM), 0.02),
        "k_norm": 1.0 + nrm(ks[7], (L, HEAD_DIM), 0.02),
        "mu_shift": jax.random.uniform(ks[8], (L, N_SHIFT), jnp.float32, 0.0, 1.0),
        "w0": nrm(ks[9], (L, 2, RWKV_WIDTH), 1.0),
        "w_up": nrm(ks[10], (L, 2, DECAY_LORA, RWKV_WIDTH), 0.5 * DECAY_LORA ** -0.5),
        "a0": nrm(ks[11], (L, 2, RWKV_WIDTH), 0.5),
        "a_up": nrm(ks[12], (L, 2, ICLR_LORA, RWKV_WIDTH), 0.5 * ICLR_LORA ** -0.5),
        "g_up": nrm(ks[13], (L, GATE_LORA, RWKV_WIDTH), GATE_LORA ** -0.5),
        "k_k": 0.85 + nrm(ks[14], (L, RWKV_WIDTH), 0.05),
        "k_a": 1.0 + nrm(ks[15], (L, RWKV_WIDTH), 0.05),
        "r_k": nrm(ks[16], (L, RWKV_HEADS, RWKV_HEAD), 0.1),
        "ln_w": 1.0 + nrm(ks[17], (L, RWKV_WIDTH), 0.02),
        "ln_b": nrm(ks[18], (L, RWKV_WIDTH), 0.02),
        "w_out": nrm(ks[19], (L, MIX_WIDTH, D), MIX_WIDTH ** -0.5),
        "g_ffn": 1.0 + nrm(ks[20], (L, D), 0.02),
        "w_router": nrm(ks[21], (L, D, E), D ** -0.5),
        "w_gate": nrm(ks[22], (L, E, D, F), D ** -0.5),
        "w_up_e": nrm(ks[23], (L, E, D, F), D ** -0.5),
        "w_down": nrm(ks[24], (L, E, F, D), F ** -0.5),
    }


def reference(x, c, w_ada, b_ada, g_mix, w_in, q_norm, k_norm, mu_shift, w0, w_up, a0,
              a_up, g_up, k_k, k_a, r_k, ln_w, ln_b, w_out, g_ffn, w_router, w_gate,
              w_up_e, w_down):
    B, S, _ = x.shape
    cos, sin = _axial_rope_tables(S)
    cond = jax.nn.silu(c)
    for l in range(DEPTH):
        mod = (cond @ w_ada[l] + b_ada[l])[:, None, :]
        sh1, sc1, gt1, sh2, sc2, gt2 = jnp.split(mod, 6, axis=-1)

        h = _rmsnorm(x, g_mix[l]) * (1.0 + sc1) + sh1
        p = h @ w_in[l]
        pq, pk, pv, pr = jnp.split(
            p, [ATT_WIDTH, ATT_WIDTH + KV_WIDTH, ATT_WIDTH + 2 * KV_WIDTH], axis=-1)
        q = _apply_rope(_rmsnorm(pq.reshape(B, S, ATT_HEADS, HEAD_DIM), q_norm[l]), cos, sin)
        k = _apply_rope(_rmsnorm(pk.reshape(B, S, ATT_KV_HEADS, HEAD_DIM), k_norm[l]), cos, sin)
        v = pv.reshape(B, S, ATT_KV_HEADS, HEAD_DIM)
        o_att = _block_attention(q, k, v)
        o_rwkv = _rwkv7_bidir(pr, mu_shift[l], w0[l], w_up[l], a0[l], a_up[l], g_up[l],
                              k_k[l], k_a[l], r_k[l], ln_w[l], ln_b[l])
        x = x + gt1 * (jnp.concatenate([o_att, o_rwkv], axis=-1) @ w_out[l])

        h2 = _rmsnorm(x, g_ffn[l]) * (1.0 + sc2) + sh2
        x = x + gt2 * _expert_choice_ffn(h2, w_router[l], w_gate[l], w_up_e[l], w_down[l])
    return x
```

```cpp
#include <hip/hip_runtime.h>
#include <hip/hip_cooperative_groups.h>
#include <hip/hip_bf16.h>
#include <cstdio>
#include <cstdint>
#include <cmath>
namespace cg = cooperative_groups;

#ifndef MK_N_LAUNCHES
#define MK_N_LAUNCHES 1
#endif
#ifndef DBG_REPEAT
#define DBG_REPEAT -1
#endif
#ifndef GEMM_GLDS
#define GEMM_GLDS 0
#endif
#ifndef WKV_PREFETCH
#define WKV_PREFETCH 1
#endif
#ifndef DBG_XFLAGS
#define DBG_XFLAGS 0
#endif
#ifndef USE_VALU_SCAN
#define USE_VALU_SCAN 0
#endif
#ifndef DBG_MASK
#define DBG_MASK 0x7ff
#endif

constexpr int DM = 1024, NB = 32, SEQ = 2048, MT = NB * SEQ;
constexpr int NIN = 2560, AW = 512, KVW = 128, RW = 512, NSH = 1792;
constexpr int NE = 16, CAP = 256, FF = 1024;
constexpr int NGROUP = NB * NE;
constexpr float NORM_EPS = 1e-6f, GN_EPS = 64e-5f, DECAY_SCALE = 0.606531f;
constexpr float QSCALE = 0.125f * 1.4426950408889634f;

constexpr size_t MiB = 1u << 20;
constexpr size_t WS_CTL = 0, CTL_ZERO_BYTES = 64 * 1024;
constexpr int CW_BAR = 4096;
constexpr size_t WS_MOD = 1 * MiB;
constexpr size_t WS_ROPE = 2 * MiB;
constexpr size_t WS_AFF = 3 * MiB;
constexpr size_t WS_IDX = 7 * MiB;
constexpr size_t WS_VAL = 7 * MiB + 512 * 1024;
constexpr size_t WS_INV = 8 * MiB;
constexpr size_t WS_BON = 12 * MiB;
constexpr size_t WS_GUPT = 16 * MiB;
constexpr size_t WS_WUPT = 16 * MiB + 128 * 1024;
constexpr size_t WS_AUPT = 16 * MiB + 256 * 1024;
constexpr size_t WS_AUPT2 = 16 * MiB + 384 * 1024;
constexpr size_t WS_WIN = 17 * MiB;
constexpr size_t WS_WOUT = 22 * MiB;
constexpr size_t WS_WGU = 24 * MiB;
constexpr size_t WS_WD = 88 * MiB;
constexpr size_t WS_H = 120 * MiB;
constexpr size_t WS_Q = 248 * MiB;
constexpr size_t WS_K = 312 * MiB;
constexpr size_t WS_V = 328 * MiB;
constexpr size_t WS_PR = 344 * MiB;
constexpr size_t WS_XG = 248 * MiB;
constexpr size_t WS_Y = 248 * MiB;
constexpr size_t WS_MIX = 568 * MiB;
constexpr size_t WS_YF = 696 * MiB;
constexpr size_t WS_YB = 760 * MiB;
constexpr size_t WS_RKVS = 824 * MiB;
constexpr size_t WS_TDS = 120 * MiB;
constexpr size_t WS_HID = 568 * MiB;
constexpr size_t WS_X1 = 696 * MiB;
constexpr size_t WS_END = 1016 * MiB;

constexpr int RING_BYTES = 131072;
constexpr int LIDX_OFF = RING_BYTES + 512;
constexpr int LDS_BYTES = 147456;
constexpr int MISC_OFF = LDS_BYTES - 256;
constexpr int NWAVES = 8;

#define GAS __attribute__((address_space(1)))
#define LAS __attribute__((address_space(3)))
typedef unsigned short bf16;
typedef unsigned v4u __attribute__((ext_vector_type(4)));
typedef unsigned v2u __attribute__((ext_vector_type(2)));
typedef float f32x4 __attribute__((ext_vector_type(4)));
typedef float f32x2 __attribute__((ext_vector_type(2)));
typedef short bf16x8 __attribute__((ext_vector_type(8)));
#define LDS_WAIT() asm volatile("s_waitcnt lgkmcnt(0)" ::: "memory")
#define VM_WAIT() asm volatile("s_waitcnt vmcnt(0)" ::: "memory")
__device__ __forceinline__ unsigned cvt2_fp8(float a, float b, unsigned old, bool hi) { a = __builtin_amdgcn_fmed3f(a, -448.0f, 448.0f); b = __builtin_amdgcn_fmed3f(b, -448.0f, 448.0f); return hi ? __builtin_amdgcn_cvt_pk_fp8_f32(a, b, old, true) : __builtin_amdgcn_cvt_pk_fp8_f32(a, b, old, false); }
typedef __bf16 bf16x2_hw __attribute__((ext_vector_type(2)));
__device__ __forceinline__ unsigned pk2(float lo, float hi) { const f32x2 v = {lo, hi}; return __builtin_bit_cast(unsigned, __builtin_convertvector(v, bf16x2_hw)); }
__device__ __forceinline__ unsigned f2bf(float f) { return pk2(f, 0.f) & 0xffffu; }
__device__ __forceinline__ float bf2f(unsigned short h) { return __builtin_bit_cast(float, (unsigned)h << 16); }
__device__ __forceinline__ float bflo(unsigned w) { return __builtin_bit_cast(float, w << 16); }
__device__ __forceinline__ float bfhi(unsigned w) { return __builtin_bit_cast(float, w & 0xffff0000u); }
#define DPP_ADD(v, CTRL) ((v) + __builtin_bit_cast(float, __builtin_amdgcn_update_dpp(0, __builtin_bit_cast(int, (v)), (CTRL), 0xf, 0xf, false)))
__device__ __forceinline__ float xor16_sum(float v) { auto r = __builtin_amdgcn_permlane16_swap(__float_as_uint(v), __float_as_uint(v), false, false); return __uint_as_float(r[0]) + __uint_as_float(r[1]); }
__device__ __forceinline__ float xor32_sum(float v) { auto r = __builtin_amdgcn_permlane32_swap(__float_as_uint(v), __float_as_uint(v), false, false); return __uint_as_float(r[0]) + __uint_as_float(r[1]); }
__device__ __forceinline__ float wave_sum(float v) {
    v = DPP_ADD(v, 0xB1); v = DPP_ADD(v, 0x4E); v = DPP_ADD(v, 0x141); v = DPP_ADD(v, 0x140);
    return xor32_sum(xor16_sum(v));
}
__device__ __forceinline__ float sigmoidf_(float x) { return 1.0f / (1.0f + __expf(-x)); }

namespace pg8 {
#define PG8_LAS __attribute__((address_space(3)))
typedef unsigned short bf16_t;
typedef short bf16x8 __attribute__((ext_vector_type(8)));
typedef float f32x4 __attribute__((ext_vector_type(4)));
typedef unsigned u32x4 __attribute__((ext_vector_type(4)));
constexpr int BM = 256, BK = 64, HALF = 128, HTB = HALF * BK * 2, STAGE_BYTES = 8 * HTB, NXCD = 8, WGM = 8;

__host__ __device__ __forceinline__ int lds_byte(int r, int c) { const int st = (r >> 4) * 2 + (c >> 5), rr = r & 15, cc = c & 31, ob = rr * 64 + cc * 2; return st * 1024 + (ob ^ (((ob >> 9) & 1) << 5)); }
__host__ __device__ __forceinline__ void stage_rc(int b, int& R, int& C) { const int st = b / 1024, sb = b % 1024, swz = sb ^ (((sb >> 9) & 1) << 5); R = (st >> 1) * 16 + swz / 64; C = (st & 1) * 32 + (swz % 64) / 2; }
__host__ __device__ __forceinline__ int perm32(int rho) { const int n = rho >> 4, i = rho & 15; return 8 * (i >> 2) + 4 * n + (i & 3); }

struct Unit { int pm, pn, bt; };
struct Gemm { const bf16_t* A; const bf16_t* Bt; int M, N, K; };

struct StaticOrder {
    static constexpr bool GATHER = false;
    int nM, nN, nwg, G, c;
    __host__ __device__ void init(int M, int N, int G_, int c_) { nM = M / BM; nN = N / BM; nwg = nM * nN; G = G_; c = c_; }
    __host__ __device__ bool next(int i, Unit& u) const {
        const long L = (long)i * G + c; if (L >= nwg) return false;
        int wgid = (int)L; { const int q = nwg / NXCD, r = nwg % NXCD, xcd = wgid % NXCD, off = wgid / NXCD; wgid = (xcd < r ? xcd * (q + 1) : r * (q + 1) + (xcd - r) * q) + off; }
        const int nig = WGM * nN, gid = wgid / nig, fm = gid * WGM, gsz = (nM - fm) < WGM ? (nM - fm) : WGM;
        u.pm = fm + ((wgid % nig) % gsz); u.pn = (wgid % nig) / gsz; u.bt = u.pn; return true;
    }
};

__device__ __forceinline__ unsigned cvt_pk_bf16(float lo, float hi) { unsigned r; asm volatile("v_cvt_pk_bf16_f32 %0, %1, %2" : "=v"(r) : "v"(lo), "v"(hi)); return r; }

typedef int v8i_t __attribute__((ext_vector_type(8)));
typedef int v4i_t __attribute__((ext_vector_type(4)));
template <class Sched> __device__ __forceinline__ unsigned a_base_of(const Sched& S, const Unit& u, unsigned tstep) { if constexpr (Sched::GATHER) return S.a_base(u); else return (unsigned)u.pm * tstep; }
template <class Epi, class Sched, bool ALIGN_EPI = false, bool SP2 = false, bool FP8 = false>
__device__ __forceinline__ void gemm_phase(PG8_LAS unsigned char* lds, const Gemm g, const Sched& S, const Epi& E, const bool skip_epi = false) {
    const int tid = threadIdx.x, wid = __builtin_amdgcn_readfirstlane(tid >> 6), lane = tid & 63, wr = wid >> 2, wc = wid & 3, fr = lane & 15, fq = lane >> 4;
    int K = g.K; asm volatile("" : "+s"(K));
    const int nt = K / BK;
    unsigned voffA[2], voffB[2];
#pragma unroll
    for (int i = 0; i < 2; ++i) { int R, C; stage_rc(tid * 16 + i * 8192, R, C); const int Rb = Epi::PERM ? ((R & ~31) + perm32(R & 31)) : R;
        voffA[i] = (unsigned)(R * K + C) * 2u; voffB[i] = (unsigned)(Rb * K + C) * 2u; }
    const unsigned kstep = (unsigned)(BK * 2);
    const unsigned hstep = (unsigned)HALF * (unsigned)K * 2u;
    const unsigned tstep = 2u * hstep;
    const unsigned ldsw = (unsigned)wid * 1024u;
    const int aoff = lds_byte(wr * 64 + fr, fq * 8), boff = lds_byte(wc * 32 + fr, fq * 8);
    const __amdgpu_buffer_rsrc_t rsA = __builtin_amdgcn_make_buffer_rsrc((void*)g.A, 0, 0x7fffffff, 0x00020000), rsB = __builtin_amdgcn_make_buffer_rsrc((void*)g.Bt, 0, 0x7fffffff, 0x00020000);
#define PG8_SA(b, h) (((b) * 2 + (h)) * HTB)
#define PG8_SB(b, h) ((4 + (b) * 2 + (h)) * HTB)
#if GEMM_GLDS
#define PG8_STAGE(bufoff, rs, soff, voff) do { _Pragma("unroll") for (int _i = 0; _i < 2; ++_i) { \
        if constexpr (FP8) __builtin_amdgcn_raw_ptr_buffer_load_lds(rs, (PG8_LAS void*)(lds + (bufoff) + ldsw + _i * 8192), 16, (int)(voff)[_i], (int)(soff), 0, 0); \
        else __builtin_amdgcn_global_load_lds((const unsigned*)((&rs == &rsA ? (const char*)g.A : (const char*)g.Bt) + (size_t)(soff) + (voff)[_i]), (PG8_LAS unsigned*)(lds + (bufoff) + ldsw + _i * 8192), 16, 0, 0); } } while (0)
#else
#define PG8_STAGE(bufoff, rs, soff, voff) do { _Pragma("unroll") for (int _i = 0; _i < 2; ++_i) \
        __builtin_amdgcn_raw_ptr_buffer_load_lds(rs, (PG8_LAS void*)(lds + (bufoff) + ldsw + _i * 8192), 16, (int)(voff)[_i], (int)(soff), 0, 0); } while (0)
#endif
#define PG8_STAGE_A(bufoff, half, soff, gsel) do { if constexpr (Sched::GATHER) { PG8_STAGE(bufoff, rsA, soff, gsel[half]); } else { PG8_STAGE(bufoff, rsA, (soff) + (half) * hstep, voffA); } } while (0)
#define PG8_LDA(dst, b, h) do { if constexpr (FP8) { _Pragma("unroll") for (int m = 0; m < 4; ++m) { const v4i_t _lo = *(const PG8_LAS v4i_t*)(lds + PG8_SA(b, h) + aoff + m * 2048), _hi = *(const PG8_LAS v4i_t*)(lds + PG8_SA(b, h) + aoff + m * 2048 + 1024); dst##8[m] = __builtin_shufflevector(_lo, _hi, 0, 1, 2, 3, 4, 5, 6, 7); } } \
    else { _Pragma("unroll") for (int m = 0; m < 4; ++m) _Pragma("unroll") for (int k = 0; k < 2; ++k) dst[m][k] = *(const PG8_LAS bf16x8*)(lds + PG8_SA(b, h) + aoff + m * 2048 + k * 1024); } } while (0)
#define PG8_LDB(dst, b, h) do { if constexpr (FP8) { _Pragma("unroll") for (int n = 0; n < 2; ++n) { const v4i_t _lo = *(const PG8_LAS v4i_t*)(lds + PG8_SB(b, h) + boff + n * 2048), _hi = *(const PG8_LAS v4i_t*)(lds + PG8_SB(b, h) + boff + n * 2048 + 1024); dst##8[n] = __builtin_shufflevector(_lo, _hi, 0, 1, 2, 3, 4, 5, 6, 7); } } \
    else { _Pragma("unroll") for (int n = 0; n < 2; ++n) _Pragma("unroll") for (int k = 0; k < 2; ++k) dst[n][k] = *(const PG8_LAS bf16x8*)(lds + PG8_SB(b, h) + boff + n * 2048 + k * 1024); } } while (0)
#define PG8_MMA(ai, bj, At, Bt) do { __builtin_amdgcn_s_setprio(1); _Pragma("unroll") for (int m = 0; m < 4; ++m) _Pragma("unroll") for (int n = 0; n < 2; ++n) { \
        if constexpr (FP8) acc[ai][bj][m][n] = __builtin_amdgcn_mfma_scale_f32_16x16x128_f8f6f4(Bt##8[n], At##8[m], acc[ai][bj][m][n], 0, 0, 0, 0, 0, 0); \
        else { _Pragma("unroll") for (int k = 0; k < 2; ++k) acc[ai][bj][m][n] = __builtin_amdgcn_mfma_f32_16x16x32_bf16(Bt[n][k], At[m][k], acc[ai][bj][m][n], 0, 0, 0); } } __builtin_amdgcn_s_setprio(0); } while (0)
#define PG8_WAIT_V(n) asm volatile("s_waitcnt vmcnt(" #n ")" ::: "memory")
#define PG8_WAIT_L(n) asm volatile("s_waitcnt lgkmcnt(" #n ")" ::: "memory")
#define PG8_BAR __builtin_amdgcn_s_barrier()
#define PG8_SCHED __builtin_amdgcn_sched_barrier(0)
    Unit cur, nxt; int ui = 0;
    if (!S.next(0, cur)) return;
    f32x4 acc[2][2][4][2];
#pragma unroll
    for (int a = 0; a < 2; ++a)
#pragma unroll
        for (int b = 0; b < 2; ++b)
#pragma unroll
            for (int m = 0; m < 4; ++m)
#pragma unroll
                for (int n = 0; n < 2; ++n) acc[a][b][m][n] = (f32x4){0.f, 0.f, 0.f, 0.f};
    bf16x8 At[4][2], B0[2][2], B1[2][2]; v8i_t At8[4], B08[2], B18[2];
    unsigned cA = a_base_of(S, cur, tstep), cB = (unsigned)cur.bt * tstep;
    unsigned gc[2][2] = {{0u, 0u}, {0u, 0u}};
    if constexpr (Sched::GATHER) S.rows(cur, gc);
    if constexpr (SP2) {
        PG8_STAGE(PG8_SB(0, 0), rsB, cB, voffB); PG8_STAGE(PG8_SB(0, 1), rsB, cB + hstep, voffB); PG8_STAGE_A(PG8_SA(0, 0), 0, cA, gc); PG8_STAGE_A(PG8_SA(0, 1), 1, cA, gc);
        if (wr == 1) PG8_BAR;
        PG8_WAIT_V(2); PG8_BAR;
        PG8_STAGE(PG8_SB(1, 0), rsB, cB + kstep, voffB); PG8_STAGE_A(PG8_SA(1, 0), 0, cA + kstep, gc); PG8_STAGE(PG8_SB(1, 1), rsB, cB + hstep + kstep, voffB);
        PG8_WAIT_V(6); PG8_BAR;
    } else {
        PG8_STAGE(PG8_SB(0, 0), rsB, cB, voffB); PG8_STAGE_A(PG8_SA(0, 0), 0, cA, gc); PG8_STAGE(PG8_SB(0, 1), rsB, cB + hstep, voffB); PG8_STAGE_A(PG8_SA(0, 1), 1, cA, gc);
        if (wr == 1) PG8_BAR;
        PG8_WAIT_V(4); PG8_BAR;
        PG8_STAGE(PG8_SB(1, 0), rsB, cB + kstep, voffB); PG8_STAGE_A(PG8_SA(1, 0), 0, cA + kstep, gc); PG8_STAGE(PG8_SB(1, 1), rsB, cB + hstep + kstep, voffB);
        PG8_WAIT_V(6); PG8_BAR;
    }
    for (;;) {
        const bool has_next = S.next(ui + 1, nxt);
        const unsigned nA = has_next ? a_base_of(S, nxt, tstep) : cA, nB = has_next ? (unsigned)nxt.bt * tstep : cB;
#pragma clang loop unroll(disable)
        for (int t = 0; t < nt; t += 2) {
            const bool last = (t == nt - 2);
            const unsigned a1 = cA + (unsigned)(t + 1) * kstep;
            const unsigned a2 = last ? nA : cA + (unsigned)(t + 2) * kstep, b2 = last ? nB : cB + (unsigned)(t + 2) * kstep;
            const unsigned a3 = a2 + kstep, b3 = b2 + kstep;
            unsigned g23[2][2] = {{gc[0][0], gc[0][1]}, {gc[1][0], gc[1][1]}};
            if constexpr (Sched::GATHER) { if (last && has_next) S.rows(nxt, g23); }
            if constexpr (SP2) {
            PG8_LDB(B0, 0, 0); PG8_LDB(B1, 0, 1); PG8_SCHED; PG8_LDA(At, 0, 0); PG8_STAGE_A(PG8_SA(1, 1), 1, a1, gc);
            PG8_WAIT_V(8); PG8_WAIT_L(0); PG8_BAR; PG8_MMA(0, 0, At, B0); PG8_MMA(0, 1, At, B1); PG8_BAR; PG8_SCHED;
            PG8_LDA(At, 0, 1); PG8_STAGE(PG8_SB(0, 0), rsB, b2, voffB); PG8_STAGE(PG8_SB(0, 1), rsB, b2 + hstep, voffB); PG8_STAGE_A(PG8_SA(0, 0), 0, a2, g23);
            PG8_WAIT_V(8); PG8_WAIT_L(0); PG8_BAR; PG8_MMA(1, 0, At, B0); PG8_MMA(1, 1, At, B1); PG8_BAR; PG8_SCHED;
            PG8_LDB(B0, 1, 0); PG8_LDB(B1, 1, 1); PG8_SCHED; PG8_LDA(At, 1, 0); PG8_STAGE_A(PG8_SA(0, 1), 1, a2, g23);
            PG8_WAIT_V(8); PG8_WAIT_L(0); PG8_BAR; PG8_MMA(0, 0, At, B0); PG8_MMA(0, 1, At, B1); PG8_BAR; PG8_SCHED;
            PG8_LDA(At, 1, 1); PG8_STAGE(PG8_SB(1, 0), rsB, b3, voffB); PG8_STAGE(PG8_SB(1, 1), rsB, b3 + hstep, voffB); PG8_STAGE_A(PG8_SA(1, 0), 0, a3, g23);
            PG8_WAIT_V(8); PG8_WAIT_L(0); PG8_BAR; PG8_MMA(1, 0, At, B0); PG8_MMA(1, 1, At, B1); PG8_BAR; PG8_SCHED;
            } else {
            PG8_LDB(B0, 0, 0); PG8_SCHED; PG8_LDA(At, 0, 0); PG8_STAGE_A(PG8_SA(1, 1), 1, a1, gc);
            PG8_WAIT_L(8); PG8_BAR; PG8_WAIT_L(0); PG8_MMA(0, 0, At, B0); PG8_BAR; PG8_SCHED;
            PG8_LDB(B1, 0, 1); PG8_STAGE(PG8_SB(0, 0), rsB, b2, voffB);
            PG8_BAR; PG8_WAIT_L(0); PG8_MMA(0, 1, At, B1); PG8_BAR;
            PG8_LDA(At, 0, 1); PG8_STAGE_A(PG8_SA(0, 0), 0, a2, g23);
            PG8_BAR; PG8_WAIT_L(0); PG8_MMA(1, 0, At, B0); PG8_BAR; PG8_SCHED;
            PG8_STAGE(PG8_SB(0, 1), rsB, b2 + hstep, voffB);
            PG8_WAIT_V(6); PG8_BAR; PG8_MMA(1, 1, At, B1); PG8_BAR;
            PG8_LDB(B0, 1, 0); PG8_SCHED; PG8_LDA(At, 1, 0); PG8_STAGE_A(PG8_SA(0, 1), 1, a2, g23);
            PG8_WAIT_L(8); PG8_BAR; PG8_WAIT_L(0); PG8_MMA(0, 0, At, B0); PG8_BAR; PG8_SCHED;
            PG8_LDB(B1, 1, 1); PG8_STAGE(PG8_SB(1, 0), rsB, b3, voffB);
            PG8_BAR; PG8_WAIT_L(0); PG8_MMA(0, 1, At, B1); PG8_BAR;
            PG8_LDA(At, 1, 1); PG8_STAGE_A(PG8_SA(1, 0), 0, a3, g23);
            PG8_BAR; PG8_WAIT_L(0); PG8_MMA(1, 0, At, B0); PG8_BAR; PG8_SCHED;
            PG8_STAGE(PG8_SB(1, 1), rsB, b3 + hstep, voffB);
            PG8_WAIT_V(6); PG8_BAR; PG8_MMA(1, 1, At, B1); PG8_BAR;
            }
        }
        if constexpr (ALIGN_EPI) { if (wr == 0) PG8_BAR; }
        if (!skip_epi) E(acc, cur, wr, wc, fr, fq); else asm volatile("" :: "v"(acc[0][0][0][0]), "v"(acc[1][1][3][1]), "v"(acc[0][1][2][0]), "v"(acc[1][0][1][1]));
        if (!has_next) break;
#pragma unroll
        for (int a = 0; a < 2; ++a)
#pragma unroll
            for (int b = 0; b < 2; ++b)
#pragma unroll
                for (int m = 0; m < 4; ++m)
#pragma unroll
                    for (int n = 0; n < 2; ++n) acc[a][b][m][n] = (f32x4){0.f, 0.f, 0.f, 0.f};
        cur = nxt; cA = nA; cB = nB; ++ui;
        if constexpr (Sched::GATHER) S.rows(cur, gc);
        if constexpr (ALIGN_EPI) { if (wr == 1) PG8_BAR; }
    }
    PG8_WAIT_V(0);
    if constexpr (!ALIGN_EPI) { if (wr == 0) PG8_BAR; }
    PG8_BAR;
#undef PG8_SA
#undef PG8_SB
#undef PG8_STAGE
#undef PG8_STAGE_A
#undef PG8_LDA
#undef PG8_LDB
#undef PG8_MMA
#undef PG8_WAIT_V
#undef PG8_WAIT_L
#undef PG8_BAR
#undef PG8_SCHED
}
}

namespace attn_body {
using bf16x8=__attribute__((ext_vector_type(8)))short;
using s16x4=__attribute__((ext_vector_type(4)))short;
using f32x16=__attribute__((ext_vector_type(16)))float;
using u32x4=__attribute__((ext_vector_type(4)))unsigned;
typedef unsigned short bf16r;
constexpr int D=64, QP=AW, KP=KVW, OP=DM;
constexpr int NW=8,QBLK=32,QB=QBLK*NW,KVBLK=64;
__device__ __forceinline__ int crow(int r,int hi){return (r&3)+8*(r>>2)+4*hi;}
#define SBAR() __builtin_amdgcn_sched_barrier(0)
constexpr int NSLOT=3, SLOTB=8192;
constexpr int LDS_K=0, LDS_V=NSLOT*SLOTB, LDS_WS=2*NSLOT*SLOTB, LDS_OST=LDS_WS+NW*64*4, LDS_BYTES_A=LDS_OST+NW*4096;
__device__ __forceinline__ void glds16(const void*gsrc,unsigned lds_dst){unsigned keep;
  asm volatile("s_mov_b32 %0, m0\n\ts_mov_b32 m0, %2\n\ts_nop 0\n\tglobal_load_lds_dwordx4 %1, off\n\ts_mov_b32 m0, %0":"=&s"(keep):"v"(gsrc),"s"(lds_dst):"memory");}
__device__ __forceinline__ float max3f(float a,float b,float c){float r;asm("v_max3_f32 %0, %1, %2, %3":"=v"(r):"v"(a),"v"(b),"v"(c));return r;}
__device__ __forceinline__ float max2f(float a,float b){float r;asm("v_max_f32_e32 %0, %1, %2":"=v"(r):"v"(a),"v"(b));return r;}
__device__ __forceinline__ float fadd_s(float a,float b){float r;asm("v_add_f32_e32 %0, %1, %2":"=v"(r):"v"(a),"v"(b));return r;}
__device__ __forceinline__ float fsub_s(float a,float b){float r;asm("v_sub_f32_e32 %0, %1, %2":"=v"(r):"v"(a),"v"(b));return r;}
typedef float f32x2_t __attribute__((ext_vector_type(2))); typedef __bf16 bf16x2_t __attribute__((ext_vector_type(2)));
__device__ __forceinline__ unsigned cvtpk_s(float lo,float hi){f32x2_t v={lo,hi};bf16x2_t b=__builtin_convertvector(v,bf16x2_t);return __builtin_bit_cast(unsigned,b);}
#define WAIT_BAR(N) asm volatile("s_waitcnt vmcnt(" #N ") lgkmcnt(0)\n\ts_barrier":::"memory")
__device__ __forceinline__ void qkt(f32x16&p0,f32x16&p1,const char*Kslot,const bf16x8*qr,const f32x16&negm,int r32,int hi){
  const char*kb=Kslot+hi*1024+r32*16;
  #pragma unroll
  for(int d0=0;d0<4;++d0){
    const bf16x8 b0=*reinterpret_cast<const bf16x8*>(kb+d0*2048);
    const bf16x8 b1=*reinterpret_cast<const bf16x8*>(kb+d0*2048+512);
    if(d0==0){p0=__builtin_amdgcn_mfma_f32_32x32x16_bf16(b0,qr[0],negm,0,0,0);p1=__builtin_amdgcn_mfma_f32_32x32x16_bf16(b1,qr[0],negm,0,0,0);}
    else{p0=__builtin_amdgcn_mfma_f32_32x32x16_bf16(b0,qr[d0],p0,0,0,0);p1=__builtin_amdgcn_mfma_f32_32x32x16_bf16(b1,qr[d0],p1,0,0,0);}}
}
typedef __attribute__((address_space(3))) const char* lds_cptr;
typedef short v4i16_t __attribute__((ext_vector_type(4)));
__device__ __forceinline__ void kload8(bf16x8*kf,lds_cptr kp){
  kf[0]=*(const __attribute__((address_space(3))) bf16x8*)(kp);      kf[1]=*(const __attribute__((address_space(3))) bf16x8*)(kp+512);
  kf[2]=*(const __attribute__((address_space(3))) bf16x8*)(kp+2048); kf[3]=*(const __attribute__((address_space(3))) bf16x8*)(kp+2560);
  kf[4]=*(const __attribute__((address_space(3))) bf16x8*)(kp+4096); kf[5]=*(const __attribute__((address_space(3))) bf16x8*)(kp+4608);
  kf[6]=*(const __attribute__((address_space(3))) bf16x8*)(kp+6144); kf[7]=*(const __attribute__((address_space(3))) bf16x8*)(kp+6656);
}
__device__ __forceinline__ void kload2(bf16x8*kf,lds_cptr kp,int j){ kf[2*j]=*(const __attribute__((address_space(3))) bf16x8*)(kp+j*2048); kf[2*j+1]=*(const __attribute__((address_space(3))) bf16x8*)(kp+j*2048+512); }
__device__ __forceinline__ s16x4 vtr(lds_cptr p){ return __builtin_bit_cast(s16x4,__builtin_amdgcn_ds_read_tr16_b64_v4i16((__attribute__((address_space(3))) v4i16_t*)p)); }
__device__ __forceinline__ float rowmax(const f32x16&p0,const f32x16&p1){
  float a=max3f(p0[0],p0[1],p1[0]),b=max3f(p0[2],p0[3],p1[1]);a=max3f(a,p1[2],p1[3]);
  #pragma unroll
  for(int r=4;r<16;r+=4){a=max3f(a,p0[r],p0[r+1]);b=max3f(b,p0[r+2],p0[r+3]);a=max3f(a,p1[r],p1[r+1]);b=max3f(b,p1[r+2],p1[r+3]);}
  const float m=max2f(a,b);
  auto rr=__builtin_amdgcn_permlane32_swap(__float_as_uint(m),__float_as_uint(m),false,false);
  return max2f(__uint_as_float(rr[0]),__uint_as_float(rr[1]));
}
__device__ __forceinline__ void pv(f32x16*o,int vb,bf16x8 pa0,bf16x8 pa1,bf16x8 pa2,bf16x8 pa3){
  #pragma unroll
  for(int d0=0;d0<2;++d0){s16x4 lo[4],hi[4];
    #pragma unroll
    for(int ks=0;ks<4;++ks){
      asm volatile("ds_read_b64_tr_b16 %0,%1 offset:%c2":"=&v"(lo[ks]):"v"(vb),"i"(d0*4096+ks*1024):"memory");
      asm volatile("ds_read_b64_tr_b16 %0,%1 offset:%c2":"=&v"(hi[ks]):"v"(vb),"i"(d0*4096+ks*1024+512):"memory");}
    asm volatile("s_waitcnt lgkmcnt(0)":::"memory");SBAR();
    #define PK(k) (bf16x8){lo[k][0],lo[k][1],lo[k][2],lo[k][3],hi[k][0],hi[k][1],hi[k][2],hi[k][3]}
    o[d0]=__builtin_amdgcn_mfma_f32_32x32x16_bf16(pa0,PK(0),o[d0],0,0,0);
    o[d0]=__builtin_amdgcn_mfma_f32_32x32x16_bf16(pa1,PK(1),o[d0],0,0,0);
    o[d0]=__builtin_amdgcn_mfma_f32_32x32x16_bf16(pa2,PK(2),o[d0],0,0,0);
    o[d0]=__builtin_amdgcn_mfma_f32_32x32x16_bf16(pa3,PK(3),o[d0],0,0,0);
    #undef PK
  }
}
template<int THRL> __device__ __forceinline__ void attn_unit(int b,int h,int qb,const bf16r*Q,const bf16r*__restrict__ K,const bf16r*__restrict__ V,bf16r*O,char*shm,bool pre_issued,bool issue_next){
  const int tid=threadIdx.x,lane=tid&63,r32=lane&31,hi=lane>>5; const int wid=__builtin_amdgcn_readfirstlane(tid>>6);
  const long rowbase=(long)b*SEQ; const int q0=qb*QB; const int hk=h>>2;
  const bf16r*Qw=Q+(rowbase+q0+wid*QBLK)*QP+h*D;
  const bf16r*Kh=K+rowbase*KP+hk*D,*Vh=V+rowbase*KP+hk*D;
  const unsigned lds0=(unsigned)(uintptr_t)shm;
  float*wsf=(float*)(shm+LDS_WS)+wid*64;
  const bf16r*ksrc=Kh+(long)lane*KP+wid*8;
  const bf16r*vsrc=Vh+(long)(16*(wid&3)+(lane>>2))*KP+(wid>>2)*32+(lane&3)*8;
  const unsigned kdst=lds0+LDS_K+wid*1024, vdst=lds0+LDS_V+wid*1024;
  #define DMA_K(t,slot) glds16(ksrc+(long)(t)*KVBLK*KP,(unsigned)__builtin_amdgcn_readfirstlane(kdst+(slot)))
  #define DMA_V(t,slot) glds16(vsrc+(long)(t)*KVBLK*KP,(unsigned)__builtin_amdgcn_readfirstlane(vdst+(slot)))
  const int vb0=(int)(lds0+LDS_V)+((lane>>4)&1)*32+(lane&3)*8+(4*hi+((lane&15)>>2))*64;
  const char*Kbase=shm+LDS_K; bf16x8 kf[8];
  const lds_cptr shm3=(lds_cptr)shm; const lds_cptr kp0=shm3+LDS_K+hi*1024+r32*16; const lds_cptr vp0=shm3+LDS_V+((lane>>4)&1)*32+(lane&3)*8+(4*hi+((lane&15)>>2))*64;
  constexpr int NT=SEQ/KVBLK;
  if(!pre_issued){DMA_K(0,0);DMA_V(0,0);DMA_K(1,SLOTB);}
  bf16x8 qr[4];
  #pragma unroll
  for(int d0=0;d0<4;++d0)qr[d0]=*reinterpret_cast<const bf16x8*>(&Qw[(long)r32*QP+d0*16+hi*8]);
  float mhat=0.f,l_reg=0.f;f32x16 o[2];o[0]=f32x16{};o[1]=f32x16{};f32x16 negm=f32x16{};asm volatile("":"+v"(negm));
  bool resc=false;
  #define START(P0,P1) do{ const float rm=rowmax(P0,P1); resc=false; \
    { const float dl=rm; mhat=fadd_s(mhat,dl); \
      _Pragma("unroll") for(int r=0;r<16;++r){P0[r]=fsub_s(P0[r],dl);P1[r]=fsub_s(P1[r],dl);} \
      _Pragma("unroll") for(int r=0;r<16;++r)negm[r]=-mhat; asm volatile("":"+v"(negm)); } \
    _Pragma("unroll") for(int r=0;r<16;++r)P0[r]=__builtin_amdgcn_exp2f(P0[r]); }while(0)
  #define RESC() do{ if(resc){ asm volatile("s_waitcnt lgkmcnt(0)":::"memory"); \
      _Pragma("unroll") for(int d_=0;d_<2;++d_) _Pragma("unroll") for(int r=0;r<16;++r)o[d_][r]*=wsf[crow(r,hi)]; } }while(0)
  f32x16 pA0,pA1,pB0,pB1;
  int sl_prev=0,sl_cur=0,sl_next=SLOTB;
  #define ROT() do{sl_prev=sl_cur;sl_cur=sl_next;sl_next=(sl_next==(NSLOT-1)*SLOTB)?0:sl_next+SLOTB;}while(0)
  if(!pre_issued){DMA_K(2,2*SLOTB);}
  WAIT_BAR(3);
  qkt(pA0,pA1,Kbase,qr,negm,r32,hi);asm volatile("s_nop 15\n\ts_nop 7":"+v"(pA0),"+v"(pA1));
  START(pA0,pA1);
  _Pragma("unroll") for(int r=0;r<16;++r)pA1[r]=__builtin_amdgcn_exp2f(pA1[r]);
  WAIT_BAR(0);
  DMA_K(3,0);DMA_V(1,SLOTB);
  ROT();
  kload8(kf,kp0+sl_cur);
  WAIT_BAR(2);
  s16x4 vlo[8],vhi[8]; u32x4 pw0,pw1,pw2,pw3;
  #define PKW(P,B) cvtpk_s(P[B],P[B+1])
  #define PAF(k) __builtin_bit_cast(bf16x8,pw##k)
  #define VFR(i) (bf16x8){vlo[i][0],vlo[i][1],vlo[i][2],vlo[i][3],vhi[i][0],vhi[i][1],vhi[i][2],vhi[i][3]}
  #define PIN(x) asm volatile("":"+v"(x))
  #define MX3(a,b,c) __builtin_fmaxf(__builtin_fmaxf((a),(b)),(c))
  #define GAPA(MF,A0,A1,A2,A3,W0,W1,PW) do{ MF; sacc+=A0; sacc+=A1; sacc+=A2; sacc+=A3; PIN(sacc); W0; W1; PIN(PW); SBAR(); }while(0)
  #define EX(v) __builtin_amdgcn_exp2f(v)
  #define GAPB(MF,X,B) do{ MF; X[B]=EX(X[B]); X[B+1]=EX(X[B+1]); X[B+2]=EX(X[B+2]); X[B+3]=EX(X[B+3]); PIN(X); SBAR(); }while(0)
  #define VRD(i) do{ vlo[i]=vtr(vp_+(((i)>>2)*4096+((i)&3)*1024)); vhi[i]=vtr(vp_+(((i)>>2)*4096+((i)&3)*1024+512)); }while(0)
  #define KRD(G,j) do{ if(G){ kload2(kf,kp0+sl_next,j); SBAR(); } }while(0)
  #define STEP(C0,C1,P0,P1,t,GK,GV,GL) do{ SBAR(); \
    const lds_cptr vp_=vp0+sl_prev; \
    VRD(0); SBAR(); float sacc=(P0[0]+P0[1]); \
    GAPA(C0=__builtin_amdgcn_mfma_f32_32x32x16_bf16(kf[0],qr[0],negm,0,0,0), P0[2],P0[3],P0[4],P0[5],     pw0[0]=PKW(P0,0), pw0[1]=PKW(P0,2), pw0); \
    VRD(4); SBAR(); GAPA(C1=__builtin_amdgcn_mfma_f32_32x32x16_bf16(kf[1],qr[0],negm,0,0,0), P0[6],P0[7],P0[8],P0[9],     pw0[2]=PKW(P0,4), pw0[3]=PKW(P0,6), pw0); \
    VRD(1); SBAR(); GAPA(C0=__builtin_amdgcn_mfma_f32_32x32x16_bf16(kf[2],qr[1],C0,0,0,0),   P0[10],P0[11],P0[12],P0[13], pw1[0]=PKW(P0,8), pw1[1]=PKW(P0,10), pw1); \
    VRD(5); SBAR(); GAPA(C1=__builtin_amdgcn_mfma_f32_32x32x16_bf16(kf[3],qr[1],C1,0,0,0),   P0[14],P0[15],P1[0],P1[1],   pw1[2]=PKW(P0,12),pw1[3]=PKW(P0,14), pw1); \
    VRD(2); SBAR(); GAPA(C0=__builtin_amdgcn_mfma_f32_32x32x16_bf16(kf[4],qr[2],C0,0,0,0),   P1[2],P1[3],P1[4],P1[5],     pw2[0]=PKW(P1,0), pw2[1]=PKW(P1,2), pw2); \
    VRD(6); SBAR(); GAPA(C1=__builtin_amdgcn_mfma_f32_32x32x16_bf16(kf[5],qr[2],C1,0,0,0),   P1[6],P1[7],P1[8],P1[9],     pw2[2]=PKW(P1,4), pw2[3]=PKW(P1,6), pw2); \
    VRD(3); SBAR(); GAPA(C0=__builtin_amdgcn_mfma_f32_32x32x16_bf16(kf[6],qr[3],C0,0,0,0),   P1[10],P1[11],P1[12],P1[13], pw3[0]=PKW(P1,8), pw3[1]=PKW(P1,10), pw3); \
    VRD(7); SBAR(); GAPA(C1=__builtin_amdgcn_mfma_f32_32x32x16_bf16(kf[7],qr[3],C1,0,0,0),   P1[14],P1[15],0.f,0.f,       pw3[2]=PKW(P1,12),pw3[3]=PKW(P1,14), pw3); \
    l_reg+=sacc; \
    if(GK){DMA_K((t)+3,sl_cur);} if(GV){DMA_V((t)+1,sl_next);} \
    { float a=MX3(C0[0],C0[1],C1[0]),b=MX3(C0[2],C0[3],C1[1]); a=MX3(a,C1[2],C1[3]); \
      _Pragma("unroll") for(int r=4;r<16;r+=4){a=MX3(a,C0[r],C0[r+1]);b=MX3(b,C0[r+2],C0[r+3]);a=MX3(a,C1[r],C1[r+1]);b=MX3(b,C1[r+2],C1[r+3]);} \
      float rm=__builtin_fmaxf(a,b); { auto rr=__builtin_amdgcn_permlane32_swap(__float_as_uint(rm),__float_as_uint(rm),false,false); rm=__builtin_fmaxf(__uint_as_float(rr[0]),__uint_as_float(rr[1])); } \
      resc=false; \
      if(__builtin_expect(__any(rm>(float)THRL),0)){ const float dl=__builtin_fmaxf(rm,0.f); mhat+=dl; \
        _Pragma("unroll") for(int r=0;r<16;++r){C0[r]-=dl;C1[r]-=dl;} \
        _Pragma("unroll") for(int r=0;r<16;++r)negm[r]=-mhat; asm volatile("":"+v"(negm)); \
        const float f=__builtin_amdgcn_exp2f(-dl); l_reg*=f; if(hi==0)wsf[r32]=f; resc=true; } } \
    SBAR(); \
    GAPB(o[0]=__builtin_amdgcn_mfma_f32_32x32x16_bf16(PAF(0),VFR(0),o[0],0,0,0), C0,0); \
    GAPB(o[1]=__builtin_amdgcn_mfma_f32_32x32x16_bf16(PAF(0),VFR(4),o[1],0,0,0), C0,4); \
    KRD(GL,0); GAPB(o[0]=__builtin_amdgcn_mfma_f32_32x32x16_bf16(PAF(1),VFR(1),o[0],0,0,0), C0,8); \
    KRD(GL,1); GAPB(o[1]=__builtin_amdgcn_mfma_f32_32x32x16_bf16(PAF(1),VFR(5),o[1],0,0,0), C0,12); \
    KRD(GL,2); GAPB(o[0]=__builtin_amdgcn_mfma_f32_32x32x16_bf16(PAF(2),VFR(2),o[0],0,0,0), C1,0); \
    KRD(GL,3); GAPB(o[1]=__builtin_amdgcn_mfma_f32_32x32x16_bf16(PAF(2),VFR(6),o[1],0,0,0), C1,4); \
    GAPB(o[0]=__builtin_amdgcn_mfma_f32_32x32x16_bf16(PAF(3),VFR(3),o[0],0,0,0), C1,8); \
    GAPB(o[1]=__builtin_amdgcn_mfma_f32_32x32x16_bf16(PAF(3),VFR(7),o[1],0,0,0), C1,12); \
    }while(0)
  int t=1;
  for(;t+5<NT;t+=2){
    STEP(pB0,pB1,pA0,pA1,t,true,true,true);     WAIT_BAR(2); RESC(); ROT();
    STEP(pA0,pA1,pB0,pB1,t+1,true,true,true);   WAIT_BAR(2); RESC(); ROT();
  }
  #define ENDW(tt) do{ if((tt)+3<NT){WAIT_BAR(2);} else if((tt)+2<NT){WAIT_BAR(1);} else {WAIT_BAR(0);} }while(0)
  for(;t+1<NT;t+=2){
    STEP(pB0,pB1,pA0,pA1,t,(t+3<NT),(t+1<NT),(t+1<NT));       ENDW(t);   RESC(); ROT();
    STEP(pA0,pA1,pB0,pB1,t+1,(t+4<NT),(t+2<NT),(t+2<NT));     ENDW(t+1); RESC(); ROT();
  }
  STEP(pB0,pB1,pA0,pA1,NT-1,false,false,false); RESC();
  { float sacc=pB0[0]+pB0[1]; _Pragma("unroll") for(int r=2;r<16;++r)sacc+=pB0[r]; _Pragma("unroll") for(int r=0;r<16;++r)sacc+=pB1[r]; l_reg+=sacc;
    pw0=(u32x4){PKW(pB0,0),PKW(pB0,2),PKW(pB0,4),PKW(pB0,6)};pw1=(u32x4){PKW(pB0,8),PKW(pB0,10),PKW(pB0,12),PKW(pB0,14)};pw2=(u32x4){PKW(pB1,0),PKW(pB1,2),PKW(pB1,4),PKW(pB1,6)};pw3=(u32x4){PKW(pB1,8),PKW(pB1,10),PKW(pB1,12),PKW(pB1,14)};
    SBAR(); pv(o,vb0+sl_cur,PAF(0),PAF(1),PAF(2),PAF(3)); }
  #undef PKW
  #undef PAF
  #undef VFR
  #undef PIN
  #undef MX3
  #undef GAPA
  #undef GAPB
  #undef EX
  #undef VRD
  #undef KRD
  #undef STEP
  #undef ENDW
  if(issue_next){ asm volatile("s_waitcnt lgkmcnt(0)\n\ts_barrier":::"memory");
    DMA_K(0,0);DMA_V(0,0);DMA_K(1,SLOTB);DMA_K(2,2*SLOTB); }
  {auto rr=__builtin_amdgcn_permlane32_swap(__float_as_uint(l_reg),__float_as_uint(l_reg),false,false);l_reg=__uint_as_float(rr[0])+__uint_as_float(rr[1]);}
  if(hi==0)wsf[32+r32]=l_reg;asm volatile("s_waitcnt lgkmcnt(0)":::"memory");
  float rli[16];
  #pragma unroll
  for(int r=0;r<16;++r)rli[r]=__builtin_amdgcn_rcpf(wsf[32+crow(r,hi)]);
  bf16r*Ow=O+(rowbase+q0+wid*QBLK)*OP+h*D;
  { __hip_bfloat16*stg=(__hip_bfloat16*)(shm+LDS_OST)+wid*2048;
    #pragma unroll
    for(int r=0;r<16;++r){const int orow=crow(r,hi);
      #pragma unroll
      for(int d0=0;d0<2;++d0)stg[orow*64+d0*32+r32]=__float2bfloat16(o[d0][r]*rli[r]);}
    asm volatile("s_waitcnt lgkmcnt(0)":::"memory");
    #pragma unroll
    for(int i=0;i<4;++i){const int row=i*8+(lane>>3),ch=lane&7; const u32x4 v=*(const u32x4*)(stg+row*64+ch*8); *(u32x4*)(Ow+(long)row*OP+ch*8)=v;} }
  asm volatile("s_waitcnt lgkmcnt(0)\n\ts_barrier":::"memory");
  #undef DMA_K
  #undef DMA_V
  #undef START
  #undef RESC
  #undef ROT
}
#undef SBAR
#undef WAIT_BAR
}

#define XB_TMO      128
#define XB_XCNT(j)  (256  + 64 * (j))
#define XB_XSUB(j)  (1280 + 64 * (j))
#define XB_XGEN(j)  (2304 + 64 * (j))
#define XB_TOP      3328
#define XB_TOPGEN   3392
#define XCD_BAR_WORDS 3456
#define XB_SPIN_CAP (1u << 18)

__device__ __forceinline__ unsigned xb_ld(unsigned* p)              { return __hip_atomic_load(p, __ATOMIC_RELAXED, __HIP_MEMORY_SCOPE_AGENT); }
__device__ __forceinline__ unsigned xb_add(unsigned* p, unsigned v) { return __hip_atomic_fetch_add(p, v, __ATOMIC_RELAXED, __HIP_MEMORY_SCOPE_AGENT); }
__device__ __forceinline__ unsigned xb_xcc_id() { return (unsigned)__builtin_amdgcn_s_getreg((3 << 11) | 20) & 0xFu; }
#define XB_SPIN(cond, bar) do { unsigned _sp = 0; while (cond) { __builtin_amdgcn_s_sleep(1); \
    if ((++_sp & 255u) == 0u) { if (xb_ld(&(bar)[XB_TMO])) break; if (_sp > XB_SPIN_CAP) { atomicAdd(&(bar)[XB_TMO], 1u); break; } } } } while (0)

struct XcdBarrier {
    unsigned* bar; unsigned x;
    volatile LAS unsigned* st;
};

__device__ __forceinline__ XcdBarrier xcd_barrier_post(unsigned* bar, volatile LAS unsigned* st) {
    XcdBarrier b; b.bar = bar; b.x = xb_xcc_id(); b.st = st;
    if (threadIdx.x == 0) (void)xb_add(&bar[XB_XCNT(b.x)], 1u);
    return b;
}
__device__ __forceinline__ void xcd_barrier_complete(unsigned* bar, unsigned x, unsigned& nloc, unsigned& nx) {
    const unsigned G = gridDim.x * gridDim.y * gridDim.z;
    unsigned sum, cnt, mine, sp = 0u;
    for (;;) {
        sum = 0u; cnt = 0u; mine = 0u;
#pragma unroll
        for (unsigned j = 0; j < 16; ++j) { const unsigned c = xb_ld(&bar[XB_XCNT(j)]); sum += c; cnt += (c > 0u) ? 1u : 0u; mine = (j == x) ? c : mine; }
        if (sum == G) break;
        __builtin_amdgcn_s_sleep(1);
        if ((++sp & 255u) == 0u) { if (xb_ld(&bar[XB_TMO])) break; if (sp > XB_SPIN_CAP) { atomicAdd(&bar[XB_TMO], 1u); break; } }
    }
    nloc = mine > 0u ? mine : 1u; nx = cnt > 0u ? cnt : 1u;
}

__device__ __forceinline__ void xcd_barrier(const XcdBarrier& b) {
    asm volatile("s_waitcnt vmcnt(0)" ::: "memory");
    __syncthreads();
    if (threadIdx.x == 0) {
        unsigned* bar = b.bar;
        __builtin_amdgcn_s_waitcnt(0);
        unsigned nloc = b.st[0], nx = b.st[1];
        if (nloc == 0u) { xcd_barrier_complete(bar, b.x, nloc, nx); b.st[0] = nloc; b.st[1] = nx; }
        const unsigned old = xb_add(&bar[XB_XSUB(b.x)], 1u);
        const unsigned gen = old / nloc;
        if (old + 1u == (gen + 1u) * nloc) {
            __builtin_amdgcn_fence(__ATOMIC_RELEASE, "agent");
            asm volatile("s_waitcnt vmcnt(0)" ::: "memory");
            const unsigned og = xb_add(&bar[XB_TOP], 1u);
            const unsigned tg = og / nx;
            if (og + 1u == (tg + 1u) * nx) xb_add(&bar[XB_TOPGEN], 1u);
            else XB_SPIN(xb_ld(&bar[XB_TOPGEN]) == tg, bar);
            __builtin_amdgcn_fence(__ATOMIC_ACQUIRE, "agent");
            xb_add(&bar[XB_XGEN(b.x)], 1u);
            asm volatile("s_waitcnt vmcnt(0)" ::: "memory");
        } else {
            XB_SPIN(xb_ld(&bar[XB_XGEN(b.x)]) == gen, bar);
            __builtin_amdgcn_fence(__ATOMIC_ACQUIRE, "agent");
            asm volatile("s_waitcnt vmcnt(0)" ::: "memory");
        }
    }
    __syncthreads();
}


struct Frame {
    LAS unsigned char* lds;
    int tid, lane, wave;
    int vcu, G;
    unsigned flags;
};
struct Args { const float* in[25]; float* out; unsigned char* ws; unsigned mask, pad; };

__device__ __forceinline__ void p0_transpose_item(const float* W, int K, int N, bf16* WT, int k0, int n0, int v0, LAS float* scr, int lane, const float* ksc = nullptr, int kmode = 0) {
#pragma unroll 8
    for (int i = 0; i < 32; ++i) { const int kk = 2 * i + (lane >> 5); float wv = W[(size_t)(k0 + kk) * N + n0 + (lane & 31)];
        if (ksc) { const float mv = ksc[k0 + kk]; wv *= (kmode == 1) ? (1.0f - mv) : (0.5f * mv); }
        scr[kk * 33 + (lane & 31)] = wv; }
    LDS_WAIT(); asm volatile("" ::: "memory");
    const int c = lane & 7;
#pragma unroll
    for (int j = 0; j < 4; ++j) { const int n = (lane >> 3) + 8 * j; const LAS float* s = scr + (8 * c) * 33 + n;
        v4u o; o.x = pk2(s[0 * 33], s[1 * 33]); o.y = pk2(s[2 * 33], s[3 * 33]); o.z = pk2(s[4 * 33], s[5 * 33]); o.w = pk2(s[6 * 33], s[7 * 33]);
        *(GAS v4u*)(WT + (size_t)(v0 + n) * K + k0 + 8 * c) = o; }
    LDS_WAIT(); asm volatile("" ::: "memory");
}
__device__ __forceinline__ void p0_transpose_item_fp8(const float* W, int K, int N, unsigned char* WT, int k0, int n0, int v0, LAS float* scr, int lane, float sc, bool remap16 = false) {
#pragma unroll 8
    for (int i = 0; i < 32; ++i) { const int kk = 2 * i + (lane >> 5); scr[kk * 33 + (lane & 31)] = W[(size_t)(k0 + kk) * N + n0 + (lane & 31)] * sc; }
    LDS_WAIT(); asm volatile("" ::: "memory");
    const int c = lane & 7;
#pragma unroll
    for (int j = 0; j < 4; ++j) { const int n = (lane >> 3) + 8 * j; const LAS float* s = scr + (8 * c) * 33 + n;
        unsigned w0 = 0u, w1 = 0u;
        w0 = cvt2_fp8(s[0 * 33], s[1 * 33], w0, false); w0 = cvt2_fp8(s[2 * 33], s[3 * 33], w0, true);
        w1 = cvt2_fp8(s[4 * 33], s[5 * 33], w1, false); w1 = cvt2_fp8(s[6 * 33], s[7 * 33], w1, true);
        v2u o; o.x = w0; o.y = w1;
        int vr = v0 + n;
        if (remap16) { const int t = (n0 & 255) + n, wc = t >> 6, fq = (t >> 4) & 3, bj = (t >> 3) & 1; vr = (n0 & ~255) + 128 * bj + 32 * wc + 8 * fq + (t & 7); }
        *(GAS v2u*)(WT + (size_t)vr * K + k0 + 8 * c) = o; }
    LDS_WAIT(); asm volatile("" ::: "memory");
}
__host__ __device__ __forceinline__ int win_virt32(int n0) { const int tile = n0 >> 8, t = n0 & 255, wc = t >> 6, bj = (t >> 5) & 1; return 256 * tile + 128 * bj + 32 * wc; }

__device__ __forceinline__ void p0_prologue(Frame& F, const Args& a) {
    unsigned char* ws = a.ws;
    if (F.vcu < 192) {
        LAS float* st = (LAS float*)F.lds;
        const float* c = a.in[1];
        for (int i = F.tid; i < NB * DM; i += 512) { const float v = c[i]; st[i] = v / (1.0f + __expf(-v)); }
        __syncthreads();
        const int cc = F.tid & 31, kg = F.tid >> 5, col0 = F.vcu * 32;
        const float* wa = a.in[2] + (size_t)(kg * 64) * (6 * DM) + col0 + cc;
        float acc[32];
#pragma unroll
        for (int b = 0; b < 32; ++b) acc[b] = 0.f;
        for (int k = 0; k < 64; ++k) {
            const float wv = wa[(size_t)k * (6 * DM)];
            const LAS float* sp = st + kg * 64 + k;
#pragma unroll
            for (int b = 0; b < 32; ++b) acc[b] += sp[b * DM] * wv;
        }
        __syncthreads();
        LAS float* part = (LAS float*)F.lds;
#pragma unroll
        for (int b = 0; b < 32; ++b) part[(kg * 32 + b) * 32 + cc] = acc[b];
        __syncthreads();
        float* mod = (float*)(ws + WS_MOD);
        for (int o = F.tid; o < 1024; o += 512) { const int b = o >> 5, c2 = o & 31; float s = a.in[3][col0 + c2];
#pragma unroll
            for (int g = 0; g < 16; ++g) s += part[(g * 32 + b) * 32 + c2];
            mod[b * (6 * DM) + col0 + c2] = s; }
        __syncthreads();
    } else {
        float* rope = (float*)(ws + WS_ROPE);
        for (int j = (F.vcu - 192) * 512 + F.tid; j < SEQ * 32; j += 64 * 512) {
            const int t = j >> 5, i = j & 31;
            const float pos = (i < 16) ? (float)(t >> 6) : (float)(t & 63);
            const float freq = powf(10000.0f, -(float)(i & 15) / 16.0f);
            const float ang = pos * freq;
            rope[2 * j] = cosf(ang); rope[2 * j + 1] = sinf(ang);
        }
    }
    LAS float* scr = (LAS float*)(F.lds + F.wave * 16384);
    const int gw = F.vcu * NWAVES + F.wave, NGW = F.G * NWAVES;
    constexpr int I_IN = (DM / 64) * (NIN / 32), I_OUT = (DM / 64) * (DM / 32), I_E = (DM / 64) * (FF / 32), I_GUP = (128 / 64) * (RW / 32);
    constexpr int I_LORA = 6 * (RW / 32);
    constexpr int NITEMS = I_IN + I_OUT + 3 * NE * I_E + I_GUP + I_LORA;
    for (int it = gw; it < NITEMS; it += NGW) {
        int r = it;
        if (r < I_IN) { const int nblk = NIN / 32, kb = r / nblk, nb = r % nblk; p0_transpose_item(a.in[5], DM, NIN, (bf16*)(ws + WS_WIN), 64 * kb, 32 * nb, win_virt32(32 * nb), scr, F.lane); continue; } r -= I_IN;
        if (r < I_OUT) { const int nblk = DM / 32, kb = r / nblk, nb = r % nblk; p0_transpose_item(a.in[19], DM, DM, (bf16*)(ws + WS_WOUT), 64 * kb, 32 * nb, 32 * nb, scr, F.lane); continue; } r -= I_OUT;
        if (r < 3 * NE * I_E) {
            const int mat = r / I_E, rr = r % I_E, which = mat / NE, e = mat % NE; const int nblk = FF / 32, kb = rr / nblk, nb = rr % nblk, n0 = 32 * nb;
            if (which == 0) p0_transpose_item_fp8(a.in[22] + (size_t)e * DM * FF, DM, FF, ws + WS_WGU + (size_t)e * 2 * FF * DM, 64 * kb, n0, 256 * (n0 >> 7) + (n0 & 127), scr, F.lane, 32.0f);
            else if (which == 1) p0_transpose_item_fp8(a.in[23] + (size_t)e * DM * FF, DM, FF, ws + WS_WGU + (size_t)e * 2 * FF * DM, 64 * kb, n0, 256 * (n0 >> 7) + 128 + (n0 & 127), scr, F.lane, 32.0f);
            else p0_transpose_item_fp8(a.in[24] + (size_t)e * FF * DM, FF, DM, ws + WS_WD + (size_t)e * DM * FF, 64 * kb, n0, n0, scr, F.lane, 32.0f, true);
            continue; } r -= 3 * NE * I_E;
        if (r < I_GUP) { const int nblk = RW / 32, kb = r / nblk, nb = r % nblk; p0_transpose_item(a.in[13], 128, RW, (bf16*)(ws + WS_GUPT), 64 * kb, 32 * nb, 32 * nb, scr, F.lane); continue; } r -= I_GUP;
        { const int nblk = RW / 32, md = r / nblk, nb = r % nblk, which = md >> 1, d = md & 1;
          if (which == 0) p0_transpose_item(a.in[10] + (size_t)d * 64 * RW, 64, RW, (bf16*)(ws + WS_WUPT) + (size_t)d * RW * 64, 0, 32 * nb, 32 * nb, scr, F.lane);
          else if (which == 1) p0_transpose_item(a.in[12] + (size_t)d * 64 * RW, 64, RW, (bf16*)(ws + WS_AUPT) + (size_t)d * RW * 64, 0, 32 * nb, 32 * nb, scr, F.lane); }
    }
}

__device__ __forceinline__ void p1_norm(Frame& F, const Args& a) {
    const float* mod = (const float*)(a.ws + WS_MOD); bf16* H = (bf16*)(a.ws + WS_H);
    const int gw = F.vcu * NWAVES + F.wave; const int b = F.vcu >> 3;
    f32x4 gs[4], sh[4];
#pragma unroll
    for (int j = 0; j < 4; ++j) { const int c = 4 * F.lane + 256 * j; const f32x4 g = *(const f32x4*)(a.in[4] + c); const f32x4 sc = *(const f32x4*)(mod + b * 6 * DM + DM + c);
        gs[j] = g * (sc + 1.0f); sh[j] = *(const f32x4*)(mod + b * 6 * DM + c); }
    f32x4 vn[4][4];
#pragma unroll
    for (int r = 0; r < 4; ++r) { const GAS f32x4* xr = (const GAS f32x4*)(a.in[0] + ((size_t)gw * 32 + r) * DM) + F.lane;
#pragma unroll
        for (int j = 0; j < 4; ++j) vn[r][j] = xr[64 * j]; }
    for (int i = 0; i < 32; i += 4) {
        const size_t row = (size_t)gw * 32 + i;
        f32x4 v[4][4]; float s2[4];
#pragma unroll
        for (int r = 0; r < 4; ++r)
#pragma unroll
            for (int j = 0; j < 4; ++j) v[r][j] = vn[r][j];
        if (i + 4 < 32) {
#pragma unroll
            for (int r = 0; r < 4; ++r) { const GAS f32x4* xr = (const GAS f32x4*)(a.in[0] + (row + 4 + r) * DM) + F.lane;
#pragma unroll
                for (int j = 0; j < 4; ++j) vn[r][j] = xr[64 * j]; } }
        asm volatile("" ::: "memory");
#pragma unroll
        for (int r = 0; r < 4; ++r) { float t = 0.f;
#pragma unroll
            for (int j = 0; j < 4; ++j) t += (v[r][j].x * v[r][j].x + v[r][j].y * v[r][j].y) + (v[r][j].z * v[r][j].z + v[r][j].w * v[r][j].w);
            s2[r] = t; }
#pragma unroll
        for (int r = 0; r < 4; ++r) s2[r] = wave_sum(s2[r]);
#pragma unroll
        for (int r = 0; r < 4; ++r) { const float rstd = 1.0f / sqrtf(s2[r] * (1.0f / DM) + NORM_EPS);
            GAS unsigned long long* o8 = (GAS unsigned long long*)(H + (row + r) * DM) + F.lane;
#pragma unroll
            for (int j = 0; j < 4; ++j) { const f32x4 y = v[r][j] * rstd * gs[j] + sh[j]; o8[64 * j] = (unsigned long long)pk2(y.x, y.y) | ((unsigned long long)pk2(y.z, y.w) << 32); } }
    }
}

struct EpiInProj {
    static constexpr bool PERM = true;
    bf16 *Q, *K, *V, *PR; const float *qn, *kn, *rope;
    __device__ __forceinline__ void operator()(const f32x4 (&acc)[2][2][4][2], const pg8::Unit& u, int wr, int wc, int fr, int fq) const {
        { int l_ = threadIdx.x; asm volatile("" : "+v"(l_)); fr = l_ & 15; fq = (l_ >> 4) & 3; }
        const int row0 = u.pm * 256 + wr * 64 + fr;
        if (u.pn >= 3) {
            const int col0 = 256 * (u.pn - 3) + 64 * wc + 8 * fq;
#pragma unroll
            for (int ai = 0; ai < 2; ++ai)
#pragma unroll
                for (int m = 0; m < 4; ++m) { bf16* rowp = PR + (size_t)(row0 + ai * 128 + m * 16) * NSH + col0;
#pragma unroll
                    for (int bj = 0; bj < 2; ++bj) { const f32x4 v0 = acc[ai][bj][m][0], v1 = acc[ai][bj][m][1];
                        v4u w; w.x = pk2(v0[0], v0[1]); w.y = pk2(v0[2], v0[3]); w.z = pk2(v1[0], v1[1]); w.w = pk2(v1[2], v1[3]);
                        *(v4u*)(rowp + 32 * bj) = w; } }
            return;
        }
        const bool isV = (u.pn == 2 && wc >= 2);
        if (isV) {
            const int col0 = 64 * (wc - 2) + 8 * fq;
#pragma unroll
            for (int ai = 0; ai < 2; ++ai)
#pragma unroll
                for (int m = 0; m < 4; ++m) { bf16* rowp = V + (size_t)(row0 + ai * 128 + m * 16) * KVW + col0;
#pragma unroll
                    for (int bj = 0; bj < 2; ++bj) { const f32x4 v0 = acc[ai][bj][m][0], v1 = acc[ai][bj][m][1];
                        v4u w; w.x = pk2(v0[0], v0[1]); w.y = pk2(v0[2], v0[3]); w.z = pk2(v1[0], v1[1]); w.w = pk2(v1[2], v1[3]);
                        *(v4u*)(rowp + 32 * bj) = w; } }
            return;
        }
        const bool isQ = (u.pn < 2);
        const float* gn = isQ ? qn : kn;
        bf16* dst = isQ ? (Q + 64 * (4 * u.pn + wc)) : (K + 64 * wc);
        const int pitch = isQ ? AW : KVW;
        const float osc = isQ ? QSCALE : 1.0f;
        f32x4 gv[2][2];
#pragma unroll
        for (int bj = 0; bj < 2; ++bj)
#pragma unroll
            for (int n = 0; n < 2; ++n) gv[bj][n] = *(const f32x4*)(gn + 32 * bj + 8 * fq + 4 * n);
#pragma unroll
        for (int ai = 0; ai < 2; ++ai) {
            f32x4 csv[4][2][2];
#pragma unroll
            for (int m = 0; m < 4; ++m) { const int t = (row0 + ai * 128 + m * 16) & (SEQ - 1);
#pragma unroll
                for (int bj = 0; bj < 2; ++bj)
#pragma unroll
                    for (int n = 0; n < 2; ++n) csv[m][bj][n] = *(const f32x4*)(rope + ((size_t)t * 32 + 16 * bj + 4 * fq + 2 * n) * 2); }
            asm volatile("" ::: "memory");
#pragma unroll
            for (int m = 0; m < 4; ++m) {
                const int row = row0 + ai * 128 + m * 16;
                float ss = 0.f;
#pragma unroll
                for (int bj = 0; bj < 2; ++bj)
#pragma unroll
                    for (int n = 0; n < 2; ++n) { const f32x4 x = acc[ai][bj][m][n]; ss += (x[0] * x[0] + x[1] * x[1]) + (x[2] * x[2] + x[3] * x[3]); }
                ss = xor32_sum(xor16_sum(ss));
                const float rstd = 1.0f / sqrtf(ss * (1.0f / 64.0f) + NORM_EPS);
                bf16* rowp = dst + (size_t)row * pitch + 8 * fq;
#pragma unroll
                for (int bj = 0; bj < 2; ++bj) {
                    unsigned w[4];
#pragma unroll
                    for (int n = 0; n < 2; ++n) {
                        const f32x4 x = acc[ai][bj][m][n] * rstd * gv[bj][n];
                        const f32x4 cs = csv[m][bj][n];
                        const float o0 = x[0] * cs[0] - x[1] * cs[1], o1 = x[0] * cs[1] + x[1] * cs[0];
                        const float o2 = x[2] * cs[2] - x[3] * cs[3], o3 = x[2] * cs[3] + x[3] * cs[2];
                        w[2 * n] = pk2(o0 * osc, o1 * osc); w[2 * n + 1] = pk2(o2 * osc, o3 * osc);
                    }
                    v4u wv; wv.x = w[0]; wv.y = w[1]; wv.z = w[2]; wv.w = w[3];
                    *(v4u*)(rowp + 32 * bj) = wv;
                }
            }
            asm volatile("" ::: "memory");
        }
    }
};

struct EpiOutProj {
    static constexpr bool PERM = true;
    const float* x; bf16* x1; const float* mod;
    __device__ __forceinline__ void operator()(const f32x4 (&acc)[2][2][4][2], const pg8::Unit& u, int wr, int wc, int fr, int fq) const {
        { int l_ = threadIdx.x; asm volatile("" : "+v"(l_)); fr = l_ & 15; fq = (l_ >> 4) & 3; }
        const int row0 = u.pm * 256 + wr * 64 + fr, col0 = u.pn * 256 + wc * 32 + 8 * fq; const int b = u.pm >> 3;
        f32x4 gt[2][2];
#pragma unroll
        for (int bj = 0; bj < 2; ++bj)
#pragma unroll
            for (int n = 0; n < 2; ++n) gt[bj][n] = *(const f32x4*)(mod + b * 6 * DM + 2 * DM + col0 + bj * 128 + n * 4);
#pragma unroll
        for (int ai = 0; ai < 2; ++ai) {
            f32x4 xv[4][2][2];
#pragma unroll
            for (int m = 0; m < 4; ++m) { const size_t off = (size_t)(row0 + ai * 128 + m * 16) * DM + col0;
#pragma unroll
                for (int bj = 0; bj < 2; ++bj)
#pragma unroll
                    for (int n = 0; n < 2; ++n) xv[m][bj][n] = *(const f32x4*)(x + off + bj * 128 + n * 4); }
            asm volatile("" ::: "memory");
#pragma unroll
            for (int m = 0; m < 4; ++m) { const size_t off = (size_t)(row0 + ai * 128 + m * 16) * DM + col0;
#pragma unroll
                for (int bj = 0; bj < 2; ++bj) { const f32x4 v0 = xv[m][bj][0] + gt[bj][0] * acc[ai][bj][m][0], v1 = xv[m][bj][1] + gt[bj][1] * acc[ai][bj][m][1];
                    v4u w; w.x = pk2(v0[0], v0[1]); w.y = pk2(v0[2], v0[3]); w.z = pk2(v1[0], v1[1]); w.w = pk2(v1[2], v1[3]);
                    *(v4u*)(x1 + off + bj * 128) = w; } }
            asm volatile("" ::: "memory");
        }
    }
};


__device__ __forceinline__ void prs_pass(Frame& F, const Args& a) {
    const bf16* __restrict__ PR = (const bf16*)(a.ws + WS_PR); bf16* __restrict__ RK = (bf16*)(a.ws + WS_RKVS); bf16* __restrict__ TD = (bf16*)(a.ws + WS_TDS);
    const float* __restrict__ mu = a.in[8];
    const int lane = F.lane; const int b = F.vcu >> 3;
    f32x4 mus[7];
#pragma unroll
    for (int cs = 0; cs < 7; ++cs) mus[cs] = *(const f32x4*)(mu + 256 * cs + 4 * lane);
    v2u xn[7][6];
#define PRS_LOAD(G) do { _Pragma("unroll") for (int r = 0; r < 6; ++r) { int t_ = 4 * (G) - 1 + r; t_ = t_ < 0 ? 0 : t_ > SEQ - 1 ? SEQ - 1 : t_; \
            const bf16* rp_ = PR + ((size_t)b * SEQ + t_) * NSH + 4 * lane; _Pragma("unroll") for (int cs = 0; cs < 7; ++cs) xn[cs][r] = *(const v2u*)(rp_ + 256 * cs); } } while (0)
    PRS_LOAD((F.vcu & 7) * 64 + F.wave * 8);
    for (int it = 0; it < 8; ++it) {
        const int g = (F.vcu & 7) * 64 + F.wave * 8 + it;
        const size_t row0 = (size_t)b * SEQ + 4 * g;
        v2u x[7][6];
#pragma unroll
        for (int cs = 0; cs < 7; ++cs)
#pragma unroll
            for (int r = 0; r < 6; ++r) x[cs][r] = xn[cs][r];
        if (it + 1 < 8) PRS_LOAD(g + 1);
        asm volatile("" ::: "memory");
        if (g == 0) {
#pragma unroll
            for (int cs = 0; cs < 7; ++cs) x[cs][0] = (v2u){0u, 0u}; }
        if (g == SEQ / 4 - 1) {
#pragma unroll
            for (int cs = 0; cs < 7; ++cs) x[cs][5] = (v2u){0u, 0u}; }
#pragma unroll
        for (int cs = 0; cs < 7; ++cs) {
            float y[4][4];
#pragma unroll
            for (int e = 0; e < 4; ++e) { const v2u c = x[cs][e + 1], p = x[cs][e], n = x[cs][e + 2];
                const float c0 = bflo(c.x), c1 = bfhi(c.x), c2 = bflo(c.y), c3 = bfhi(c.y);
                y[e][0] = c0 + mus[cs][0] * (0.5f * (bflo(p.x) + bflo(n.x)) - c0); y[e][1] = c1 + mus[cs][1] * (0.5f * (bfhi(p.x) + bfhi(n.x)) - c1);
                y[e][2] = c2 + mus[cs][2] * (0.5f * (bflo(p.y) + bflo(n.y)) - c2); y[e][3] = c3 + mus[cs][3] * (0.5f * (bfhi(p.y) + bfhi(n.y)) - c3); }
            if (cs < 6) {
                bf16* dst = RK + (((size_t)b * (SEQ / 4) + g) * 1536 + 256 * cs + 4 * lane) * 4;
                v4u w0, w1;
                w0.x = pk2(y[0][0], y[1][0]); w0.y = pk2(y[2][0], y[3][0]); w0.z = pk2(y[0][1], y[1][1]); w0.w = pk2(y[2][1], y[3][1]);
                w1.x = pk2(y[0][2], y[1][2]); w1.y = pk2(y[2][2], y[3][2]); w1.z = pk2(y[0][3], y[1][3]); w1.w = pk2(y[2][3], y[3][3]);
                *(v4u*)dst = w0; *(v4u*)(dst + 8) = w1;
            } else {
#pragma unroll
                for (int e = 0; e < 4; ++e) { float o[4];
#pragma unroll
                    for (int j = 0; j < 4; ++j) { const float v = y[e][j]; const float th = 1.0f - 2.0f * __builtin_amdgcn_rcpf(__expf(2.0f * v) + 1.0f), sg = __builtin_amdgcn_rcpf(1.0f + __expf(-v));
                        o[j] = lane < 16 ? th : lane < 32 ? v : sg; }
                    v2u w; w.x = pk2(o[0], o[1]); w.y = pk2(o[2], o[3]);
                    *(v2u*)(TD + (row0 + e) * 256 + 4 * lane) = w; }
            }
        }
    }
}

#undef PRS_LOAD
namespace wkv {
constexpr int SLOT = 12544, O_AT = 0, O_RT = 2048, O_BT = 4096, O_KT = 6144, O_VT = 8192, O_MAK = 10240, O_MTM = 10752, O_MRB = 11264, O_MRK = 11776, O_GC = 12288;
typedef short v4i16_t __attribute__((ext_vector_type(4)));
typedef __bf16 bf16x2_t __attribute__((ext_vector_type(2)));
__device__ __forceinline__ unsigned cvtpk(float lo, float hi) { f32x2 v = {lo, hi}; bf16x2_t b = __builtin_convertvector(v, bf16x2_t); return __builtin_bit_cast(unsigned, b); }
__device__ __forceinline__ v2u pack4(const f32x4 v) { v2u r; r.x = cvtpk(v[0], v[1]); r.y = cvtpk(v[2], v[3]); return r; }
__device__ __forceinline__ bf16x8 frag(v2u lo, v2u hi) { v4u w; w.x = lo.x; w.y = lo.y; w.z = hi.x; w.w = hi.y; return __builtin_bit_cast(bf16x8, w); }
__device__ __forceinline__ bf16x8 frag4(const f32x4 v) { return frag(pack4(v), (v2u){0u, 0u}); }
__device__ __forceinline__ v2u trrd(LAS const unsigned char* p) { return __builtin_bit_cast(v2u, __builtin_amdgcn_ds_read_tr16_b64_v4i16((LAS v4i16_t*)p)); }
__device__ __forceinline__ bf16x8 trop(LAS const unsigned char* arr, int m, int lane) {
    LAS const unsigned char* p = arr + (32 * m + 4 * (lane >> 4) + ((lane & 15) >> 2)) * 32 + (lane & 3) * 8;
    return frag(trrd(p), trrd(p + 16 * 32));
}
#define MFMA16(A, B, C) __builtin_amdgcn_mfma_f32_16x16x32_bf16((A), (B), (C), 0, 0, 0)
__device__ __forceinline__ void up8(const v4u w, float (&o)[8]) { o[0] = bflo(w.x); o[1] = bfhi(w.x); o[2] = bflo(w.y); o[3] = bfhi(w.y); o[4] = bflo(w.z); o[5] = bfhi(w.z); o[6] = bflo(w.w); o[7] = bfhi(w.w); }
__device__ __forceinline__ bf16x8 pack8(const float (&o)[8]) { v4u w; w.x = cvtpk(o[0], o[1]); w.y = cvtpk(o[2], o[3]); w.z = cvtpk(o[4], o[5]); w.w = cvtpk(o[6], o[7]); return __builtin_bit_cast(bf16x8, w); }
__device__ __forceinline__ float dppf(float v, int ctrl_tag);
#define WKV_DPP_ADD(v, CTRL) ((v) + __builtin_bit_cast(float, __builtin_amdgcn_update_dpp(0, __builtin_bit_cast(int, (v)), (CTRL), 0xf, 0xf, false)))
__device__ __forceinline__ float red16(float v) { v = WKV_DPP_ADD(v, 0xB1); v = WKV_DPP_ADD(v, 0x4E); v = WKV_DPP_ADD(v, 0x141); v = WKV_DPP_ADD(v, 0x140); return v; }
__device__ __forceinline__ float fsig(float x) { return __builtin_amdgcn_rcpf(1.0f + __expf(-x)); }
constexpr int NRAW = 10;
constexpr int LORA_OFF = 8 * SLOT + 12 * 64 * 4, LORA_ROW = 144, LORA_TAB = 64 * LORA_ROW;
constexpr int CST_OFF = 8 * SLOT;
__device__ __forceinline__ void prep_load(v4u (&raw)[NRAW], const bf16* RK, const bf16* TD, int b, int h, int dir, int c, int lane) {
    const int kl = lane & 15, q = lane >> 4;
    const int g = dir ? (SEQ / 4 - 1 - (4 * c + q)) : (4 * c + q);
    const bf16* rp = RK + (((size_t)b * (SEQ / 4) + g) * 1536 + 64 * h + kl) * 4;
#pragma unroll
    for (int X = 0; X < 3; ++X)
#pragma unroll
        for (int cp = 0; cp < 2; ++cp) { const v2u lo = *(const v2u*)(rp + (512 * X + 16 * (2 * cp)) * 4), hi = *(const v2u*)(rp + (512 * X + 16 * (2 * cp + 1)) * 4);
            raw[X * 2 + cp] = (v4u){lo.x, lo.y, hi.x, hi.y}; }
    const int s_i = c * 16 + kl; const int t_i = dir ? (SEQ - 1 - s_i) : s_i;
    const bf16* tp = TD + ((size_t)b * SEQ + t_i) * 256 + 8 * q;
#pragma unroll
    for (int m = 0; m < 2; ++m) { raw[6 + m] = *(const v4u*)(tp + 32 * m); raw[8 + m] = *(const v4u*)(tp + 64 + 32 * m); }
}
__device__ __forceinline__ f32x4 up4(unsigned w0, unsigned w1, bool rev) {
    const f32x4 t = (f32x4){bflo(w0), bfhi(w0), bflo(w1), bfhi(w1)};
    return rev ? (f32x4){t[3], t[2], t[1], t[0]} : t;
}

__device__ __forceinline__ void prep(const v4u (&raw)[NRAW], const Args& a, int b, int h, int dir, int c, LAS unsigned char* slot, LAS const float* cst, int lane, bool nostore) {
    const int kl = lane & 15, q = lane >> 4;
    LAS const unsigned char* lw_ = (LAS const unsigned char*)cst + (LORA_OFF - CST_OFF) + dir * 2 * LORA_TAB; LAS const unsigned char* la_ = lw_ + LORA_TAB;
    float* BON = (float*)(a.ws + WS_BON) + (size_t)dir * MT * 8;
    const f32x4 z4 = (f32x4){0.f, 0.f, 0.f, 0.f};
    const bool rev = dir != 0;
    f32x4 wp[4], ap[4], rx[4], kx[4], vx[4];
#pragma unroll
    for (int ct = 0; ct < 4; ++ct) { wp[ct] = z4; ap[ct] = z4;
#pragma unroll
        for (int m = 0; m < 2; ++m) { const int off = (16 * ct + kl) * LORA_ROW + (32 * m + 8 * q) * 2;
            wp[ct] = MFMA16(__builtin_bit_cast(bf16x8, raw[6 + m]), *(const LAS bf16x8*)(lw_ + off), wp[ct]); ap[ct] = MFMA16(__builtin_bit_cast(bf16x8, raw[8 + m]), *(const LAS bf16x8*)(la_ + off), ap[ct]); } }
    if (rev) {
#pragma unroll
        for (int cp = 0; cp < 2; ++cp) {
            rx[2 * cp] = up4(raw[0 + cp].x, raw[0 + cp].y, true); rx[2 * cp + 1] = up4(raw[0 + cp].z, raw[0 + cp].w, true);
            kx[2 * cp] = up4(raw[2 + cp].x, raw[2 + cp].y, true); kx[2 * cp + 1] = up4(raw[2 + cp].z, raw[2 + cp].w, true);
            vx[2 * cp] = up4(raw[4 + cp].x, raw[4 + cp].y, true); vx[2 * cp + 1] = up4(raw[4 + cp].z, raw[4 + cp].w, true); }
    } else {
#pragma unroll
        for (int cp = 0; cp < 2; ++cp) {
            rx[2 * cp] = up4(raw[0 + cp].x, raw[0 + cp].y, false); rx[2 * cp + 1] = up4(raw[0 + cp].z, raw[0 + cp].w, false);
            kx[2 * cp] = up4(raw[2 + cp].x, raw[2 + cp].y, false); kx[2 * cp + 1] = up4(raw[2 + cp].z, raw[2 + cp].w, false);
            vx[2 * cp] = up4(raw[4 + cp].x, raw[4 + cp].y, false); vx[2 * cp + 1] = up4(raw[4 + cp].z, raw[4 + cp].w, false); }
    }
    f32x4 n2 = z4, bsum = z4;
    f32x4 av[4], kd[4];
#pragma unroll
    for (int ct = 0; ct < 4; ++ct) { const int cj = 16 * ct + kl;
        const float a0 = cst[(5 + dir) * 64 + cj], kkg = cst[9 * 64 + cj], kag = cst[10 * 64 + cj], rkg = cst[11 * 64 + cj];
#pragma unroll
        for (int e = 0; e < 4; ++e) { av[ct][e] = fsig(ap[ct][e] + a0); const float kkv = kx[ct][e] * kkg; n2[e] += kkv * kkv;
            kd[ct][e] = kx[ct][e] * (1.0f + (av[ct][e] - 1.0f) * kag); bsum[e] += rx[ct][e] * kd[ct][e] * rkg; } }
#pragma unroll
    for (int e = 0; e < 4; ++e) { n2[e] = red16(n2[e]); bsum[e] = red16(bsum[e]); }
    if (kl == 0 && !nostore) {
        const int s0 = c * 16 + 4 * q; const int t0 = rev ? (SEQ - 1 - s0 - 3) : s0;
        *(f32x4*)(BON + ((size_t)b * 8 + h) * SEQ + t0) = rev ? (f32x4){bsum[3], bsum[2], bsum[1], bsum[0]} : bsum; }
    f32x4 rn;
#pragma unroll
    for (int e = 0; e < 4; ++e) rn[e] = __builtin_amdgcn_rsqf(fmaxf(n2[e], 1e-24f));
#pragma unroll
    for (int ct = 0; ct < 4; ++ct) { const int cj = 16 * ct + kl;
        const float w0 = cst[(7 + dir) * 64 + cj], kkg = cst[9 * 64 + cj];
        f32x4 L, lw;
#pragma unroll
        for (int e = 0; e < 4; ++e) lw[e] = -DECAY_SCALE * fsig(wp[ct][e] + w0);
        L[0] = lw[0]; L[1] = L[0] + lw[1]; L[2] = L[1] + lw[2]; L[3] = L[2] + lw[3];
        const float g = L[3];
        const auto ra = __builtin_amdgcn_permlane16_swap(__float_as_uint(g), __float_as_uint(g), false, false);
        const float pair = __uint_as_float(ra[0]) + __uint_as_float(ra[1]);
        const auto rb = __builtin_amdgcn_permlane32_swap(__float_as_uint(pair), __float_as_uint(pair), false, false);
        const float P = ((q & 1) ? __uint_as_float(ra[0]) : 0.f) + ((q & 2) ? __uint_as_float(rb[0]) : 0.f);
        const float Ltot = __uint_as_float(rb[0]) + __uint_as_float(rb[1]);
        f32x4 ah, bh, kh, rh;
#pragma unroll
        for (int e = 0; e < 4; ++e) { const float Le = L[e] + P; const float ep = __expf(Le), en = __expf(-Le), epv = __expf(Le - lw[e]);
            const float kk = kx[ct][e] * kkg * rn[e];
            ah[e] = -kk * epv; bh[e] = kk * av[ct][e] * en; kh[e] = kd[ct][e] * en; rh[e] = rx[ct][e] * ep; }
        const int ro = (16 * ct + kl) * 32 + q * 8;
        *(LAS v2u*)(slot + O_AT + ro) = pack4(ah); *(LAS v2u*)(slot + O_BT + ro) = pack4(bh); *(LAS v2u*)(slot + O_KT + ro) = pack4(kh); *(LAS v2u*)(slot + O_RT + ro) = pack4(rh);
        *(LAS v2u*)(slot + O_VT + ro) = pack4(vx[ct]);
        if (q == 0) *(LAS float*)(slot + O_GC + (16 * ct + kl) * 4) = __expf(Ltot);
    }
    LDS_WAIT();
    f32x4 OA = z4, OAT = z4, OAK = z4, ORB = z4, ORK = z4;
#pragma unroll
    for (int m = 0; m < 2; ++m) { const bf16x8 tA = trop(slot + O_AT, m, lane), tB = trop(slot + O_BT, m, lane), tK = trop(slot + O_KT, m, lane), tR = trop(slot + O_RT, m, lane);
        OA = MFMA16(tA, tB, OA); OAT = MFMA16(tB, tA, OAT); OAK = MFMA16(tK, tA, OAK); ORB = MFMA16(tB, tR, ORB); ORK = MFMA16(tK, tR, ORK); }
    f32x4 Z;
#pragma unroll
    for (int e = 0; e < 4; ++e) { const int rr = 4 * q + e;
        OA[e] = (kl < rr) ? OA[e] : 0.f;
        OAT[e] = (rr < kl) ? OAT[e] : 0.f;
        OAK[e] = (rr < kl) ? OAK[e] : 0.f; ORB[e] = (rr <= kl) ? ORB[e] : 0.f; ORK[e] = (rr <= kl) ? ORK[e] : 0.f;
        Z[e] = OAT[e] + ((rr == kl) ? 1.0f : 0.f); }
    *(LAS v2u*)(slot + O_MAK + lane * 8) = pack4(OAK); *(LAS v2u*)(slot + O_MRB + lane * 8) = pack4(ORB); *(LAS v2u*)(slot + O_MRK + lane * 8) = pack4(ORK);
    const bf16x8 pA = frag4(OA), pAT = frag4(OAT);
    const f32x4 OA2 = MFMA16(pAT, pA, z4), OA2T = MFMA16(pA, pAT, z4);
    const bf16x8 pA2 = frag4(OA2), pA2T = frag4(OA2T);
    const f32x4 OA4 = MFMA16(pA2T, pA2, z4), OA4T = MFMA16(pA2, pA2T, z4);
    const bf16x8 pA4 = frag4(OA4), pA4T = frag4(OA4T);
    const f32x4 OA8 = MFMA16(pA4T, pA4, z4);
    Z = MFMA16(pA2, frag4(Z), Z);
    Z = MFMA16(pA4, frag4(Z), Z);
    Z = MFMA16(frag4(OA8), frag4(Z), Z);
    *(LAS v2u*)(slot + O_MTM + lane * 8) = pack4(Z);
}

__device__ __forceinline__ void scan_chunk(f32x4 (&acc)[4], LAS const unsigned char* slot, int vs, int lane, bf16* Ygrp, bool rev, bool nostore) {
    const int kl = lane & 15, q = lane >> 4;
    const f32x4 z4 = (f32x4){0.f, 0.f, 0.f, 0.f}; const v2u z2 = (v2u){0u, 0u};
    const bf16x8 Sb0 = frag(pack4(acc[0]), pack4(acc[1])), Sb1 = frag(pack4(acc[2]), pack4(acc[3]));
    const v2u Vv = *(const LAS v2u*)(slot + O_VT + (16 * vs + kl) * 32 + q * 8);
    f32x4 X = MFMA16(frag(*(const LAS v2u*)(slot + O_MAK + lane * 8), z2), frag(Vv, z2), z4);
    X = MFMA16(trop(slot + O_AT, 0, lane), Sb0, X); X = MFMA16(trop(slot + O_AT, 1, lane), Sb1, X);
    const f32x4 Ut = MFMA16(frag(*(const LAS v2u*)(slot + O_MTM + lane * 8), z2), frag4(X), z4);
    const bf16x8 UV = frag(pack4(Ut), Vv);
    f32x4 Yt = MFMA16(trop(slot + O_RT, 0, lane), Sb0, z4); Yt = MFMA16(trop(slot + O_RT, 1, lane), Sb1, Yt);
    Yt = MFMA16(frag(*(const LAS v2u*)(slot + O_MRB + lane * 8), *(const LAS v2u*)(slot + O_MRK + lane * 8)), UV, Yt);
    if (!nostore) { v2u w; if (rev) { w.x = cvtpk(Yt[3], Yt[2]); w.y = cvtpk(Yt[1], Yt[0]); } else { w.x = cvtpk(Yt[0], Yt[1]); w.y = cvtpk(Yt[2], Yt[3]); } *(v2u*)Ygrp = w; }
#pragma unroll
    for (int kt = 0; kt < 4; ++kt) {
        const int ro = (16 * kt + kl) * 32 + q * 8;
        acc[kt] = MFMA16(frag(*(const LAS v2u*)(slot + O_BT + ro), *(const LAS v2u*)(slot + O_KT + ro)), UV, acc[kt]);
        acc[kt] = acc[kt] * *(const LAS f32x4*)(slot + O_GC + (16 * kt + 4 * q) * 4);
    }
}

__device__ __forceinline__ void phase(Frame& F, const Args& a) {
    const int b = F.vcu >> 3, h = F.vcu & 7; const int w = F.wave, lane = F.lane;
    const int dir = w >> 2, vs = w & 3;
    LAS unsigned char* slots = F.lds;
    LAS float* cst = (LAS float*)(F.lds + CST_OFF);
    for (int idx = F.tid; idx < 12 * 64; idx += 512) { const int arr = idx >> 6, j = idx & 63; float v = 0.f;
        if (arr < 5) v = 0.f;
        else if (arr < 7) v = a.in[11][(arr - 5) * RW + 64 * h + j];
        else if (arr < 9) v = a.in[9][(arr - 7) * RW + 64 * h + j];
        else v = a.in[14 + (arr - 9)][64 * h + j];
        cst[idx] = v; }
    {
        const bf16* WU = (const bf16*)(a.ws + WS_WUPT); const bf16* AU = (const bf16*)(a.ws + WS_AUPT);
        for (int idx = F.tid; idx < 4 * 64 * 8; idx += 512) { const int ch16 = idx & 7, row = (idx >> 3) & 63, tb = idx >> 9; const int d = tb >> 1;
            const bf16* src = ((tb & 1) ? AU : WU) + ((size_t)d * RW + 64 * h + row) * 64 + 8 * ch16;
            *(LAS v4u*)(F.lds + LORA_OFF + tb * LORA_TAB + row * LORA_ROW + ch16 * 16) = *(const v4u*)src; }
    }
    const bf16* RK = (const bf16*)(a.ws + WS_RKVS); const bf16* TD = (const bf16*)(a.ws + WS_TDS);
    bf16* Y = (bf16*)(a.ws + (dir ? WS_YB : WS_YF)) + ((size_t)b * 8 + h) * (SEQ / 4) * 64 * 4;
    f32x4 acc[4];
#pragma unroll
    for (int kt = 0; kt < 4; ++kt) acc[kt] = (f32x4){0.f, 0.f, 0.f, 0.f};
    const bool f_noscan = (F.flags >> 18) & 1u, f_noprep = (F.flags >> 19) & 1u, f_nostore = (F.flags >> 20) & 1u;
    v4u raw[NRAW];
    prep_load(raw, RK, TD, b, h, dir, vs, lane);
    LDS_WAIT(); __builtin_amdgcn_s_barrier(); asm volatile("" ::: "memory");
    for (int R = 0; R < SEQ / 64; ++R) {
        if (!f_noprep) prep(raw, a, b, h, dir, 4 * R + vs, slots + w * SLOT, cst, lane, f_nostore);
        else { unsigned x = 0;
#pragma unroll
            for (int i = 0; i < NRAW; ++i) x ^= raw[i].x ^ raw[i].y ^ raw[i].z ^ raw[i].w;
            asm volatile("" :: "v"(x)); }
        LDS_WAIT(); __builtin_amdgcn_s_barrier(); asm volatile("" ::: "memory");
        if (R + 1 < SEQ / 64) prep_load(raw, RK, TD, b, h, dir, 4 * (R + 1) + vs, lane);
        asm volatile("" ::: "memory");
        if (!f_noscan)
#pragma unroll
        for (int ci = 0; ci < 4; ++ci) {
            const int c = 4 * R + ci; const int g = dir ? (SEQ / 4 - 1 - (4 * c + (lane >> 4))) : (4 * c + (lane >> 4));
            scan_chunk(acc, slots + (dir * 4 + ci) * SLOT, vs, lane, Y + ((size_t)g * 64 + 16 * vs + (lane & 15)) * 4, dir != 0, f_nostore);
        }
        LDS_WAIT(); __builtin_amdgcn_s_barrier(); asm volatile("" ::: "memory");
    }
    if (f_nostore) { asm volatile("" :: "v"(acc[0]), "v"(acc[1]), "v"(acc[2]), "v"(acc[3])); }
}
#undef MFMA16
}

__device__ __forceinline__ void p4_finalize(Frame& F, const Args& a) {
    const bf16* __restrict__ RK = (const bf16*)(a.ws + WS_RKVS); const bf16* __restrict__ TD = (const bf16*)(a.ws + WS_TDS); const bf16* __restrict__ GT = (const bf16*)(a.ws + WS_GUPT);
    const bf16* __restrict__ YF = (const bf16*)(a.ws + WS_YF); const bf16* __restrict__ YB = (const bf16*)(a.ws + WS_YB);
    const float* __restrict__ BON = (const float*)(a.ws + WS_BON); bf16* __restrict__ MIX = (bf16*)(a.ws + WS_MIX);
    const float* __restrict__ ln_w = a.in[17]; const float* __restrict__ ln_b = a.in[18];
    const int gw = F.vcu * NWAVES + F.wave; const int kl = F.lane & 15, q = F.lane >> 4; const int b = F.vcu >> 3;
    LAS unsigned char* stg = F.lds + F.wave * (16 * 1040);
    for (int i = 0; i < 2; ++i) {
        const size_t row0 = (size_t)(gw * 2 + i) * 16; const int t0 = (int)(row0 & (SEQ - 1)); const int g = (t0 >> 2) + q;
        bf16x8 sg[4];
#pragma unroll
        for (int ks = 0; ks < 4; ++ks) sg[ks] = *(const bf16x8*)(TD + (row0 + kl) * 256 + 128 + 32 * ks + 8 * q);
        v2u n_yf[4], n_yb[4], n_vv[4]; f32x4 n_bf, n_bb; float n_lw[4], n_lb[4]; bf16x8 n_gt[4][4];
#define P4_LOAD(HH) do { _Pragma("unroll") for (int ct = 0; ct < 4; ++ct) { const int ch_ = 64 * (HH) + 16 * ct + kl; \
            const size_t yo_ = ((((size_t)b * 8 + (HH)) * (SEQ / 4) + g) * 64 + 16 * ct + kl) * 4; \
            n_yf[ct] = *(const v2u*)(YF + yo_); n_yb[ct] = *(const v2u*)(YB + yo_); \
            n_vv[ct] = *(const v2u*)(RK + (((size_t)b * (SEQ / 4) + g) * 1536 + 1024 + ch_) * 4); n_lw[ct] = ln_w[ch_]; n_lb[ct] = ln_b[ch_]; \
            _Pragma("unroll") for (int ks = 0; ks < 4; ++ks) n_gt[ct][ks] = *(const bf16x8*)(GT + (size_t)ch_ * 128 + 32 * ks + 8 * q); } \
            const size_t bo_ = ((size_t)b * 8 + (HH)) * SEQ + t0 + 4 * q; n_bf = *(const f32x4*)(BON + bo_); n_bb = *(const f32x4*)(BON + (size_t)MT * 8 + bo_); } while (0)
        P4_LOAD(0);
#pragma clang loop unroll(disable)
        for (int hh = 0; hh < 8; ++hh) {
            f32x4 acc[4], y[4], vs[4]; float lw[4], lb[4];
#pragma unroll
            for (int ct = 0; ct < 4; ++ct) {
                y[ct] = (f32x4){bflo(n_yf[ct].x) + bflo(n_yb[ct].x), bfhi(n_yf[ct].x) + bfhi(n_yb[ct].x), bflo(n_yf[ct].y) + bflo(n_yb[ct].y), bfhi(n_yf[ct].y) + bfhi(n_yb[ct].y)};
                vs[ct] = (f32x4){bflo(n_vv[ct].x), bfhi(n_vv[ct].x), bflo(n_vv[ct].y), bfhi(n_vv[ct].y)}; lw[ct] = n_lw[ct]; lb[ct] = n_lb[ct]; }
            const f32x4 bon = n_bf + n_bb;
#pragma unroll
            for (int ct = 0; ct < 4; ++ct) { acc[ct] = (f32x4){0.f, 0.f, 0.f, 0.f};
#pragma unroll
                for (int ks = 0; ks < 4; ++ks) acc[ct] = __builtin_amdgcn_mfma_f32_16x16x32_bf16(sg[ks], n_gt[ct][ks], acc[ct], 0, 0, 0); }
            if (hh + 1 < 8) P4_LOAD(hh + 1);
            f32x4 sm = (y[0] + y[1]) + (y[2] + y[3]);
#pragma unroll
            for (int e = 0; e < 4; ++e) sm[e] = wkv::red16(sm[e]);
            const f32x4 mean = sm * (1.0f / 64.0f); f32x4 vq = (f32x4){0.f, 0.f, 0.f, 0.f};
#pragma unroll
            for (int ct = 0; ct < 4; ++ct) { y[ct] = y[ct] - mean; vq += y[ct] * y[ct]; }
            f32x4 rstd;
#pragma unroll
            for (int e = 0; e < 4; ++e) rstd[e] = __builtin_amdgcn_rsqf(wkv::red16(vq[e]) * (1.0f / 64.0f) + GN_EPS);
#pragma unroll
            for (int ct = 0; ct < 4; ++ct) { const f32x4 o = ((y[ct] * rstd) * lw[ct] + lb[ct] + vs[ct] * bon) * acc[ct];
#pragma unroll
                for (int e = 0; e < 4; ++e) *(LAS unsigned short*)(stg + (4 * q + e) * 1040 + (64 * hh + 16 * ct + kl) * 2) = (unsigned short)f2bf(o[e]); }
        }
#undef P4_LOAD
        LDS_WAIT();
#pragma unroll
        for (int r = 0; r < 16; ++r) { const v4u w = *(const LAS v4u*)(stg + r * 1040 + F.lane * 16); *(v4u*)(MIX + (row0 + r) * DM + 512 + F.lane * 8) = w; }
        LDS_WAIT();
    }
}

__device__ __forceinline__ void p6_norm_router(Frame& F, const Args& a) {
    LAS float* wr = (LAS float*)F.lds;
    for (int i = F.tid; i < DM * NE; i += 512) { const int k = i >> 4, e = i & 15; wr[e * DM + k] = a.in[21][i]; }
    __syncthreads();
    const float* mod = (const float*)(a.ws + WS_MOD); unsigned char* H2 = a.ws + WS_H; float* AFF = (float*)(a.ws + WS_AFF);
    const int gw = F.vcu * NWAVES + F.wave; const int b = F.vcu >> 3; const int lane = F.lane;
    f32x4 gs[4], sh[4];
#pragma unroll
    for (int j = 0; j < 4; ++j) { const int c = 4 * lane + 256 * j; const f32x4 g = *(const f32x4*)(a.in[20] + c); const f32x4 sc = *(const f32x4*)(mod + b * 6 * DM + 4 * DM + c);
        gs[j] = g * (sc + 1.0f); sh[j] = *(const f32x4*)(mod + b * 6 * DM + 3 * DM + c); }
    const bf16* X1 = (const bf16*)(a.ws + WS_X1);
    v2u vn[4];
    { const GAS v2u* xr = (const GAS v2u*)(X1 + (size_t)gw * 32 * DM) + lane;
#pragma unroll
      for (int j = 0; j < 4; ++j) vn[j] = xr[64 * j]; }
    for (int i = 0; i < 32; ++i) {
        const size_t row = (size_t)gw * 32 + i;
        f32x4 v[4]; float s2 = 0.f;
#pragma unroll
        for (int j = 0; j < 4; ++j) { v[j] = (f32x4){bflo(vn[j].x), bfhi(vn[j].x), bflo(vn[j].y), bfhi(vn[j].y)}; s2 += (v[j].x * v[j].x + v[j].y * v[j].y) + (v[j].z * v[j].z + v[j].w * v[j].w); }
        if (i + 1 < 32) { const GAS v2u* xr = (const GAS v2u*)(X1 + (row + 1) * DM) + lane;
#pragma unroll
            for (int j = 0; j < 4; ++j) vn[j] = xr[64 * j]; }
        asm volatile("" ::: "memory");
        const float rstd = 1.0f / sqrtf(wave_sum(s2) * (1.0f / DM) + NORM_EPS);
        GAS unsigned* o4 = (GAS unsigned*)(H2 + row * DM) + lane;
#pragma unroll
        for (int j = 0; j < 4; ++j) { v[j] = v[j] * rstd * gs[j] + sh[j]; unsigned w = 0u;
            w = cvt2_fp8(v[j].x * 4.0f, v[j].y * 4.0f, w, false); w = cvt2_fp8(v[j].z * 4.0f, v[j].w * 4.0f, w, true); o4[64 * j] = w; }
        float d[16];
#pragma unroll
        for (int e = 0; e < 16; ++e) { float acc = 0.f;
#pragma unroll
            for (int j = 0; j < 4; ++j) { const f32x4 w = *(const LAS f32x4*)(wr + e * DM + 4 * lane + 256 * j); acc += (v[j].x * w.x + v[j].y * w.y) + (v[j].z * w.z + v[j].w * w.w); }
            d[e] = acc; asm volatile("" ::: "memory"); }
#pragma unroll
        for (int k = 0; k < 8; ++k) { auto r = __builtin_amdgcn_permlane32_swap(__float_as_uint(d[k]), __float_as_uint(d[k + 8]), false, false); d[k] = __uint_as_float(r[0]) + __uint_as_float(r[1]); }
#pragma unroll
        for (int k = 0; k < 4; ++k) { auto r = __builtin_amdgcn_permlane16_swap(__float_as_uint(d[k]), __float_as_uint(d[k + 4]), false, false); d[k] = __uint_as_float(r[0]) + __uint_as_float(r[1]); }
        { const bool up = (lane & 8) != 0;
#pragma unroll
          for (int k = 0; k < 2; ++k) { const float send = up ? d[k] : d[k + 2], keep = up ? d[k + 2] : d[k];
              d[k] = keep + __builtin_bit_cast(float, __builtin_amdgcn_update_dpp(0, __builtin_bit_cast(int, send), 0x128, 0xf, 0xf, false)); } }
        { const bool up = (lane & 4) != 0; const float send = up ? d[0] : d[1], keep = up ? d[1] : d[0]; d[0] = keep + __shfl_xor(send, 4); }
        float lg = d[0]; lg = DPP_ADD(lg, 0x4E); lg = DPP_ADD(lg, 0xB1);
        float mx = lg;
        mx = fmaxf(mx, __shfl_xor(mx, 4)); mx = fmaxf(mx, __builtin_bit_cast(float, __builtin_amdgcn_update_dpp(0, __builtin_bit_cast(int, mx), 0x128, 0xf, 0xf, false)));
        { auto r = __builtin_amdgcn_permlane16_swap(__float_as_uint(mx), __float_as_uint(mx), false, false); mx = fmaxf(__uint_as_float(r[0]), __uint_as_float(r[1])); }
        { auto r = __builtin_amdgcn_permlane32_swap(__float_as_uint(mx), __float_as_uint(mx), false, false); mx = fmaxf(__uint_as_float(r[0]), __uint_as_float(r[1])); }
        const float pe = expf(lg - mx); float sm = pe;
        sm += __shfl_xor(sm, 4); sm = DPP_ADD(sm, 0x128); sm = xor32_sum(xor16_sum(sm));
        if ((lane & 3) == 0) AFF[((size_t)b * NE + (lane >> 2)) * SEQ + (row & (SEQ - 1))] = pe / sm;
    }
    __syncthreads();
}

__device__ __forceinline__ void p7_topk_gather(Frame& F, const Args& a) {
    LAS unsigned* red = (LAS unsigned*)F.lds;
    const float* AFF = (const float*)(a.ws + WS_AFF); int* IDX = (int*)(a.ws + WS_IDX); float* VAL = (float*)(a.ws + WS_VAL); int* INV = (int*)(a.ws + WS_INV);
    const int tid = F.tid, lane = F.lane, wave = F.wave;
    f32x4 v[2]; unsigned u[2][4], T[2] = {0u, 0u};
#pragma unroll
    for (int pr = 0; pr < 2; ++pr) { v[pr] = *(const f32x4*)(AFF + (size_t)(F.vcu * 2 + pr) * SEQ + 4 * tid);
#pragma unroll
        for (int j = 0; j < 4; ++j) u[pr][j] = __float_as_uint(v[pr][j]); }
    int par = 0;
    for (int bit = 30; bit >= 0; --bit) {
        unsigned cand[2];
#pragma unroll
        for (int pr = 0; pr < 2; ++pr) { cand[pr] = T[pr] | (1u << bit);
            const int c = __builtin_popcountll(__ballot(u[pr][0] >= cand[pr])) + __builtin_popcountll(__ballot(u[pr][1] >= cand[pr])) + __builtin_popcountll(__ballot(u[pr][2] >= cand[pr])) + __builtin_popcountll(__ballot(u[pr][3] >= cand[pr]));
            if (lane == 0) red[(par * 2 + pr) * 8 + wave] = (unsigned)c; }
        __syncthreads();
#pragma unroll
        for (int pr = 0; pr < 2; ++pr) { unsigned tot = 0;
#pragma unroll
            for (int w = 0; w < 8; ++w) tot += red[(par * 2 + pr) * 8 + w];
            if (tot >= (unsigned)CAP) T[pr] = cand[pr]; }
        par ^= 1;
    }
    int pk[2], inc[2];
#pragma unroll
    for (int pr = 0; pr < 2; ++pr) {
        const int cg = (u[pr][0] > T[pr]) + (u[pr][1] > T[pr]) + (u[pr][2] > T[pr]) + (u[pr][3] > T[pr]), ce = (u[pr][0] == T[pr]) + (u[pr][1] == T[pr]) + (u[pr][2] == T[pr]) + (u[pr][3] == T[pr]);
        pk[pr] = cg | (ce << 16); inc[pr] = pk[pr];
#pragma unroll
        for (int o = 1; o < 64; o <<= 1) { const int n = __shfl_up(inc[pr], o); if (lane >= o) inc[pr] += n; }
        if (lane == 63) red[64 + 16 * pr + wave] = (unsigned)inc[pr]; }
    __syncthreads();
#pragma unroll
    for (int pr = 0; pr < 2; ++pr) {
        const int p = F.vcu * 2 + pr; const int b = p >> 4, e = p & 15;
        int base = 0, total = 0;
#pragma unroll
        for (int w = 0; w < 8; ++w) { const int tw = (int)red[64 + 16 * pr + w]; if (w < wave) base += tw; total += tw; }
        const int excl = base + inc[pr] - pk[pr];
        int gtb = excl & 0xffff, eqb = excl >> 16; const int need_eq = CAP - (total & 0xffff);
#pragma unroll
        for (int j = 0; j < 4; ++j) {
            const bool g = u[pr][j] > T[pr], q = u[pr][j] == T[pr]; const bool sel = g || (q && eqb < need_eq);
            const int slot = gtb + (eqb < need_eq ? eqb : need_eq); const int t = 4 * tid + j;
            if (sel) { IDX[p * CAP + slot] = t; VAL[p * CAP + slot] = v[pr][j]; }
            INV[((size_t)b * SEQ + t) * NE + e] = sel ? slot : -1;
            gtb += g ? 1 : 0; eqb += q ? 1 : 0;
        }
    }
    __syncthreads();
}

struct GuOrder { int vcu; const LAS unsigned short* lidx;
    static constexpr bool GATHER = true;
    __device__ __forceinline__ unsigned a_base(const pg8::Unit& u) const { return (unsigned)(u.pm >> 4) * (unsigned)(SEQ * DM); }
    __device__ __forceinline__ void rows(const pg8::Unit& u, unsigned (&g)[2][2]) const {
        int tid = threadIdx.x; asm volatile("" : "+v"(tid));
#pragma unroll
        for (int i = 0; i < 2; ++i) { int R, C; pg8::stage_rc(tid * 16 + i * 8192, R, C);
#pragma unroll
            for (int h = 0; h < 2; ++h) g[h][i] = (unsigned)lidx[(u.pm & 15) * CAP + 128 * h + R] * (unsigned)DM + (unsigned)C * 2u; } }
    __device__ __forceinline__ bool next(int i, pg8::Unit& u) const { if (i >= NE) return false; const int b = vcu >> 3, pn = vcu & 7; u.pm = b * NE + i; u.pn = pn; u.bt = i * 8 + pn; return true; } };
struct DownOrder { int vcu; static constexpr bool GATHER = false;
    __device__ __forceinline__ bool next(int i, pg8::Unit& u) const { if (i >= NE / 2) return false; const int b = vcu >> 3, j = vcu & 7, e = 2 * i + (j >> 2); u.pm = b * NE + e; u.pn = j & 3; u.bt = e * 4 + (j & 3); return true; } };
struct EpiSwiGLU {
    static constexpr bool PERM = true;
    unsigned char* HID;
    __device__ __forceinline__ void operator()(const f32x4 (&acc)[2][2][4][2], const pg8::Unit& u, int wr, int wc, int fr, int fq) const {
        { int l_ = threadIdx.x; asm volatile("" : "+v"(l_)); fr = l_ & 15; fq = (l_ >> 4) & 3; }
        const int row0 = u.pm * 256 + wr * 64 + fr, col0 = u.pn * 128 + wc * 32 + 8 * fq;
        const __amdgpu_buffer_rsrc_t hrs = __builtin_amdgcn_make_buffer_rsrc((void*)HID, 0, 0x7fffffff, 0x00020000);
#pragma unroll
        for (int ai = 0; ai < 2; ++ai)
#pragma unroll
            for (int m = 0; m < 4; ++m) {
                unsigned w[2];
#pragma unroll
                for (int n = 0; n < 2; ++n) { const f32x4 g = acc[ai][0][m][n], up = acc[ai][1][m][n]; f32x4 h;
#pragma unroll
                    for (int e = 0; e < 4; ++e) { const float gg = g[e] * (1.0f / 128.0f); h[e] = gg * __builtin_amdgcn_rcpf(1.0f + __expf(-gg)) * up[e] * (8.0f / 128.0f); }
                    unsigned x = 0u; x = cvt2_fp8(h[0], h[1], x, false); x = cvt2_fp8(h[2], h[3], x, true); w[n] = x; }
                v2u wv; wv.x = w[0]; wv.y = w[1];
                __builtin_amdgcn_raw_buffer_store_b64(wv, hrs, (unsigned)(row0 + ai * 128 + m * 16) * (unsigned)FF + (unsigned)col0, 0, 0);
            }
    }
};
struct EpiDown {
    static constexpr bool PERM = true;
    unsigned char* Y; const float* VAL; const float* mod;
    __device__ __forceinline__ void operator()(const f32x4 (&acc)[2][2][4][2], const pg8::Unit& u, int wr, int wc, int fr, int fq) const {
        { int l_ = threadIdx.x; asm volatile("" : "+v"(l_)); fr = l_ & 15; fq = (l_ >> 4) & 3; }
        const int row0 = u.pm * 256 + wr * 64 + fr, col0 = u.pn * 256 + wc * 64 + 16 * fq; const int b = u.pm >> 4;
        f32x4 gt[2][2];
#pragma unroll
        for (int bj = 0; bj < 2; ++bj)
#pragma unroll
            for (int n = 0; n < 2; ++n) gt[bj][n] = *(const f32x4*)(mod + b * 6 * DM + 5 * DM + col0 + 8 * bj + 4 * n);
        const __amdgpu_buffer_rsrc_t yrs = __builtin_amdgcn_make_buffer_rsrc((void*)Y, 0, 0x7fffffff, 0x00020000);
        float vls[2][4];
#pragma unroll
        for (int ai = 0; ai < 2; ++ai)
#pragma unroll
            for (int m = 0; m < 4; ++m) vls[ai][m] = VAL[row0 + ai * 128 + m * 16] * (64.0f / 256.0f);
#pragma unroll
        for (int ai = 0; ai < 2; ++ai)
#pragma unroll
            for (int m = 0; m < 4; ++m) { const int row = row0 + ai * 128 + m * 16; const float vl = vls[ai][m];
                unsigned w[4];
#pragma unroll
                for (int bj = 0; bj < 2; ++bj)
#pragma unroll
                    for (int n = 0; n < 2; ++n) { const f32x4 v = acc[ai][bj][m][n] * gt[bj][n] * vl; unsigned x = 0u;
                        x = cvt2_fp8(v[0], v[1], x, false); x = cvt2_fp8(v[2], v[3], x, true); w[2 * bj + n] = x; }
                v4u wv; wv.x = w[0]; wv.y = w[1]; wv.z = w[2]; wv.w = w[3];
                __builtin_amdgcn_raw_buffer_store_b128(wv, yrs, (unsigned)row * (unsigned)DM + (unsigned)col0, 0, 0); }
    }
};

__device__ __forceinline__ void p10_combine(Frame& F, const Args& a) {
    const int* INV = (const int*)(a.ws + WS_INV); const unsigned char* Y = a.ws + WS_Y;
    const int gw = F.vcu * NWAVES + F.wave; const int b = F.vcu >> 3; const int lane = F.lane;
    const bool nostore = (F.flags >> 20) & 1u;
    int inv_n[2];
#pragma unroll
    for (int r = 0; r < 2; ++r) inv_n[r] = INV[((size_t)gw * 32 + r) * NE + (lane & 15)];
    const bf16* X1 = (const bf16*)(a.ws + WS_X1);
    v2u vnx[2][4];
#pragma unroll
    for (int r = 0; r < 2; ++r) { const GAS v2u* xr = (const GAS v2u*)(X1 + ((size_t)gw * 32 + r) * DM) + lane;
#pragma unroll
        for (int j = 0; j < 4; ++j) vnx[r][j] = xr[64 * j]; }
    for (int i = 0; i < 32; i += 2) {
        const size_t row = (size_t)gw * 32 + i;
        int inv[2]; inv[0] = inv_n[0]; inv[1] = inv_n[1];
        if (i + 2 < 32) {
#pragma unroll
            for (int r = 0; r < 2; ++r) inv_n[r] = INV[(row + 2 + r) * NE + (lane & 15)]; }
        f32x4 v[2][4];
#pragma unroll
        for (int r = 0; r < 2; ++r)
#pragma unroll
            for (int j = 0; j < 4; ++j) v[r][j] = (f32x4){bflo(vnx[r][j].x), bfhi(vnx[r][j].x), bflo(vnx[r][j].y), bfhi(vnx[r][j].y)};
        if (i + 2 < 32) {
#pragma unroll
            for (int r = 0; r < 2; ++r) { const GAS v2u* xr = (const GAS v2u*)(X1 + (row + 2 + r) * DM) + lane;
#pragma unroll
                for (int j = 0; j < 4; ++j) vnx[r][j] = xr[64 * j]; } }
        unsigned m0 = (unsigned)(__ballot(inv[0] >= 0) & 0xffffull), m1 = (unsigned)(__ballot(inv[1] >= 0) & 0xffffull);
        while (m0 | m1) {
            unsigned w[2][3][4]; bool hit[2][3];
#pragma unroll
            for (int r = 0; r < 2; ++r)
#pragma unroll
                for (int k = 0; k < 3; ++k) { unsigned& mm = r ? m1 : m0; hit[r][k] = mm != 0u;
                    if (hit[r][k]) { const int e = __builtin_ctz(mm); mm &= mm - 1u; const int sl = __builtin_amdgcn_readlane(inv[r], e);
                        const unsigned char* yr = Y + ((size_t)(b * NE + e) * CAP + sl) * DM + 4 * lane;
#pragma unroll
                        for (int j = 0; j < 4; ++j) w[r][k][j] = *(const unsigned*)(yr + 256 * j); } }
#pragma unroll
            for (int r = 0; r < 2; ++r)
#pragma unroll
                for (int k = 0; k < 3; ++k) if (hit[r][k]) {
#pragma unroll
                    for (int j = 0; j < 4; ++j) { const f32x2 lo = __builtin_amdgcn_cvt_pk_f32_fp8(w[r][k][j], false), hi = __builtin_amdgcn_cvt_pk_f32_fp8(w[r][k][j], true);
                        v[r][j].x += lo.x * (1.0f / 64.0f); v[r][j].y += lo.y * (1.0f / 64.0f); v[r][j].z += hi.x * (1.0f / 64.0f); v[r][j].w += hi.y * (1.0f / 64.0f); } }
        }
        if (!nostore) {
#pragma unroll
            for (int r = 0; r < 2; ++r) { GAS f32x4* xr = (GAS f32x4*)(a.out + (row + r) * DM) + lane;
#pragma unroll
                for (int j = 0; j < 4; ++j) xr[64 * j] = v[r][j]; }
        } else asm volatile("" :: "v"(v[0][0]), "v"(v[0][1]), "v"(v[0][2]), "v"(v[0][3]), "v"(v[1][0]), "v"(v[1][1]), "v"(v[1][2]), "v"(v[1][3]));
    }
}

__global__ void __launch_bounds__(NWAVES * 64, 2) fwd_kernel(Args args) {
    extern __shared__ __attribute__((aligned(16))) unsigned char lds[];
    cg::grid_group grid = cg::this_grid();
    Frame F;
    F.lds = (LAS unsigned char*)lds;
    F.tid = threadIdx.x; F.lane = F.tid & 63; F.wave = __builtin_amdgcn_readfirstlane(F.tid >> 6);
    F.G = gridDim.x; { const int bx = blockIdx.x; F.vcu = (F.G % 8 == 0) ? (bx % 8) * (F.G / 8) + bx / 8 : bx; }
    unsigned char* ws = args.ws;
    const unsigned mask = args.mask; F.flags = mask;
    volatile LAS unsigned* MISC = (volatile LAS unsigned*)(F.lds + MISC_OFF);
    if (F.tid < 32) MISC[F.tid] = 0u;
    __syncthreads();
    XcdBarrier bar; bar.bar = (unsigned*)(ws + WS_CTL) + CW_BAR; bar.x = 0; bar.st = nullptr;
    const bool one_launch = __builtin_popcount(mask & 0x7ffu) > 1;
    if (one_launch) bar = xcd_barrier_post((unsigned*)(ws + WS_CTL) + CW_BAR, MISC + 8);
    if (one_launch) grid.sync();
#define REFRESH() do { F.tid = threadIdx.x; asm volatile("" : "+v"(F.tid)); F.lane = F.tid & 63; } while (0)
#define IN(k) ((mask >> (k)) & 1u)
#define SEAM(k) do { if (IN(k) && ((mask & 0x7ffu) >> ((k) + 1)) != 0u) xcd_barrier(bar); REFRESH(); } while (0)

    if (IN(0)) { p0_prologue(F, args); } SEAM(0);
    if (IN(1)) { p1_norm(F, args); } SEAM(1);
    if (IN(2)) {
        pg8::Gemm g{(const bf16*)(ws + WS_H), (const bf16*)(ws + WS_WIN), MT, NIN, DM}; pg8::StaticOrder S; S.init(MT, NIN, F.G, (int)blockIdx.x);
        EpiInProj E{(bf16*)(ws + WS_Q), (bf16*)(ws + WS_K), (bf16*)(ws + WS_V), (bf16*)(ws + WS_PR), args.in[6], args.in[7], (const float*)(ws + WS_ROPE)};
        pg8::gemm_phase<EpiInProj, pg8::StaticOrder, true, true>(F.lds, g, S, E, (mask >> 22) & 1u);
    } SEAM(2);
    if (IN(3)) {
        const int b = F.vcu >> 3, h = F.vcu & 7;
        if (!((mask >> 16) & 1u)) {
            prs_pass(F, args);
            REFRESH();
            for (int qb = 0; qb < 8; ++qb)
                attn_body::attn_unit<8>(b, h, qb, (const bf16*)(ws + WS_Q), (const bf16*)(ws + WS_K), (const bf16*)(ws + WS_V), (bf16*)(ws + WS_MIX), (char*)lds, qb > 0, true);
            __syncthreads();
        }
        if (one_launch) xcd_barrier(bar);
        REFRESH();
        if (!((mask >> 17) & 1u)) {
            wkv::phase(F, args);
        }
    } SEAM(3);
    if (IN(4)) { p4_finalize(F, args); } SEAM(4);
    if (IN(5)) {
        pg8::Gemm g{(const bf16*)(ws + WS_MIX), (const bf16*)(ws + WS_WOUT), MT, DM, DM}; pg8::StaticOrder S; S.init(MT, DM, F.G, (int)blockIdx.x);
        EpiOutProj E{args.in[0], (bf16*)(ws + WS_X1), (const float*)(ws + WS_MOD)};
        pg8::gemm_phase<EpiOutProj, pg8::StaticOrder, true, true>(F.lds, g, S, E, (mask >> 22) & 1u);
    } SEAM(5);
    if (IN(6)) { p6_norm_router(F, args); } SEAM(6);
    if (IN(7)) { p7_topk_gather(F, args); } SEAM(7);
    if (IN(8)) {
        LAS unsigned short* lidx = (LAS unsigned short*)(F.lds + LIDX_OFF);
        { const int* IDX = (const int*)(ws + WS_IDX) + (size_t)(F.vcu >> 3) * NE * CAP; for (int i = F.tid; i < NE * CAP; i += 512) lidx[i] = (unsigned short)IDX[i]; }
        __syncthreads();
        pg8::Gemm g{(const bf16*)(ws + WS_H), (const bf16*)(ws + WS_WGU), NGROUP * CAP, 2 * FF, DM / 2}; GuOrder S{F.vcu, lidx};
        EpiSwiGLU E{ws + WS_HID};
        pg8::gemm_phase<EpiSwiGLU, GuOrder, true, true, true>(F.lds, g, S, E, (mask >> 22) & 1u);
    } SEAM(8);
    if (IN(9)) {
        pg8::Gemm g{(const bf16*)(ws + WS_HID), (const bf16*)(ws + WS_WD), NGROUP * CAP, DM, FF / 2}; DownOrder S{F.vcu};
        EpiDown E{ws + WS_Y, (const float*)(ws + WS_VAL), (const float*)(ws + WS_MOD)};
        pg8::gemm_phase<EpiDown, DownOrder, true, true, true>(F.lds, g, S, E, (mask >> 22) & 1u);
    } SEAM(9);
    if (IN(10)) { p10_combine(F, args); }
#undef IN
#undef SEAM
}

extern "C" void kernel_launch(void* const* d_in, const int* in_sizes, int n_in, void* d_out, int out_size, void* d_ws, size_t ws_size, hipStream_t stream) {
    static int grid = 0;
    if (grid == 0) {
        if (n_in != 25 || out_size != MT * DM || ws_size < WS_END) { fprintf(stderr, "kernel_launch: unexpected shapes n_in %d out %d ws %zu\n", n_in, out_size, ws_size); grid = -1; return; }
        int dev = 0, cus = 0, per_cu = 0;
        (void)hipGetDevice(&dev); (void)hipDeviceGetAttribute(&cus, hipDeviceAttributeMultiprocessorCount, dev);
        (void)hipFuncSetAttribute((const void*)fwd_kernel, hipFuncAttributeMaxDynamicSharedMemorySize, LDS_BYTES);
        (void)hipOccupancyMaxActiveBlocksPerMultiprocessor(&per_cu, (const void*)fwd_kernel, NWAVES * 64, LDS_BYTES);
        (void)hipGetLastError();
        if (per_cu < 1) { fprintf(stderr, "kernel_launch: occupancy query says %d blocks per CU\n", per_cu); grid = -1; return; }
        if (cus != NB * 8) { fprintf(stderr, "kernel_launch: built for a %d-CU device (one workgroup per (batch, head)); found %d CUs; nothing launched\n", NB * 8, cus); grid = -1; return; }
        grid = cus;
    }
    if (grid < 0) return;
    (void)hipMemsetAsync((char*)d_ws + WS_CTL, 0, CTL_ZERO_BYTES, stream);
#if !((DBG_MASK >> 5) & 1)
    (void)hipMemcpyAsync(d_out, d_in[0], (size_t)MT * DM * 4, hipMemcpyDeviceToDevice, stream);
#endif
    Args a{};
    for (int i = 0; i < 25; ++i) a.in[i] = (const float*)d_in[i];
    a.out = (float*)d_out; a.ws = (unsigned char*)d_ws;
    constexpr int NPH = 11;
#if MK_N_LAUNCHES == 1
    a.mask = DBG_MASK;
    void* kargs[] = {&a};
    hipError_t e = hipLaunchCooperativeKernel((const void*)fwd_kernel, dim3(grid), dim3(NWAVES * 64), kargs, LDS_BYTES, stream);
    if (e != hipSuccess) fprintf(stderr, "cooperative launch failed: %s (grid %d)\n", hipGetErrorString(e), grid);
#else
    for (int p = 0; p < NPH; ++p) {
        if (!((DBG_MASK >> p) & 1)) continue;
        a.mask = 1u << p;
        if (p == 3) { a.mask |= 1u << 17; hipLaunchKernelGGL(fwd_kernel, dim3(grid), dim3(NWAVES * 64), LDS_BYTES, stream, a); a.mask = (1u << 3) | (1u << 16); }
        hipLaunchKernelGGL(fwd_kernel, dim3(grid), dim3(NWAVES * 64), LDS_BYTES, stream, a);
        const int rp = DBG_REPEAT;
        if (rp == p || ((rp == 31 || rp == 32 || rp == 33) && p == 3)) {
            if (rp == 31) a.mask = (1u << 3) | (1u << 17); if (rp == 32) a.mask = (1u << 3) | (1u << 16); if (rp == 33) a.mask = (1u << 3) | (1u << 16) | (1u << 17); a.mask |= DBG_XFLAGS;
            hipLaunchKernelGGL(fwd_kernel, dim3(grid), dim3(NWAVES * 64), LDS_BYTES, stream, a);
        }
    }
#endif
}
```

```cpp
#include <hip/hip_runtime.h>
#include <hip/hip_cooperative_groups.h>
#include <hip/hip_bf16.h>
#include <cstdio>
#include <cstdint>
#include <cmath>
namespace cg = cooperative_groups;

#ifndef MK_N_LAUNCHES
#define MK_N_LAUNCHES 1
#endif
#ifndef DBG_REPEAT
#define DBG_REPEAT -1
#endif
#ifndef GEMM_GLDS
#define GEMM_GLDS 0
#endif
#ifndef WKV_PREFETCH
#define WKV_PREFETCH 1
#endif
#ifndef DBG_XFLAGS
#define DBG_XFLAGS 0
#endif
#ifndef USE_VALU_SCAN
#define USE_VALU_SCAN 0
#endif
#ifndef DBG_MASK
#define DBG_MASK 0x7ff
#endif

constexpr int DM = 1024, NB = 32, SEQ = 2048, MT = NB * SEQ;
constexpr int NIN = 2560, AW = 512, KVW = 128, RW = 512, NSH = 1792;
constexpr int NE = 16, CAP = 256, FF = 1024;
constexpr int NGROUP = NB * NE;
constexpr float NORM_EPS = 1e-6f, GN_EPS = 64e-5f, DECAY_SCALE = 0.606531f;
constexpr float QSCALE = 0.125f * 1.4426950408889634f;

constexpr size_t MiB = 1u << 20;
constexpr size_t WS_CTL = 0, CTL_ZERO_BYTES = 64 * 1024;
constexpr int CW_BAR = 4096;
constexpr size_t WS_MOD = 1 * MiB;
constexpr size_t WS_ROPE = 2 * MiB;
constexpr size_t WS_AFF = 3 * MiB;
constexpr size_t WS_IDX = 7 * MiB;
constexpr size_t WS_VAL = 7 * MiB + 512 * 1024;
constexpr size_t WS_INV = 8 * MiB;
constexpr size_t WS_BON = 12 * MiB;
constexpr size_t WS_GUPT = 16 * MiB;
constexpr size_t WS_WUPT = 16 * MiB + 128 * 1024;
constexpr size_t WS_AUPT = 16 * MiB + 256 * 1024;
constexpr size_t WS_AUPT2 = 16 * MiB + 384 * 1024;
constexpr size_t WS_WIN = 17 * MiB;
constexpr size_t WS_WOUT = 22 * MiB;
constexpr size_t WS_WGU = 24 * MiB;
constexpr size_t WS_WD = 88 * MiB;
constexpr size_t WS_H = 120 * MiB;
constexpr size_t WS_Q = 248 * MiB;
constexpr size_t WS_K = 312 * MiB;
constexpr size_t WS_V = 328 * MiB;
constexpr size_t WS_PR = 344 * MiB;
constexpr size_t WS_XG = 248 * MiB;
constexpr size_t WS_Y = 248 * MiB;
constexpr size_t WS_MIX = 568 * MiB;
constexpr size_t WS_YF = 696 * MiB;
constexpr size_t WS_YB = 760 * MiB;
constexpr size_t WS_RKVS = 824 * MiB;
constexpr size_t WS_TDS = 120 * MiB;
constexpr size_t WS_HID = 568 * MiB;
constexpr size_t WS_X1 = 696 * MiB;
constexpr size_t WS_END = 1016 * MiB;

constexpr int RING_BYTES = 131072;
constexpr int LIDX_OFF = RING_BYTES + 512;
constexpr int LDS_BYTES = 147456;
constexpr int MISC_OFF = LDS_BYTES - 256;
constexpr int NWAVES = 8;

#define GAS __attribute__((address_space(1)))
#define LAS __attribute__((address_space(3)))
typedef unsigned short bf16;
typedef unsigned v4u __attribute__((ext_vector_type(4)));
typedef unsigned v2u __attribute__((ext_vector_type(2)));
typedef float f32x4 __attribute__((ext_vector_type(4)));
typedef float f32x2 __attribute__((ext_vector_type(2)));
typedef short bf16x8 __attribute__((ext_vector_type(8)));
#define LDS_WAIT() asm volatile("s_waitcnt lgkmcnt(0)" ::: "memory")
#define VM_WAIT() asm volatile("s_waitcnt vmcnt(0)" ::: "memory")
__device__ __forceinline__ unsigned cvt2_fp8(float a, float b, unsigned old, bool hi) { a = __builtin_amdgcn_fmed3f(a, -448.0f, 448.0f); b = __builtin_amdgcn_fmed3f(b, -448.0f, 448.0f); return hi ? __builtin_amdgcn_cvt_pk_fp8_f32(a, b, old, true) : __builtin_amdgcn_cvt_pk_fp8_f32(a, b, old, false); }
typedef __bf16 bf16x2_hw __attribute__((ext_vector_type(2)));
__device__ __forceinline__ unsigned pk2(float lo, float hi) { const f32x2 v = {lo, hi}; return __builtin_bit_cast(unsigned, __builtin_convertvector(v, bf16x2_hw)); }
__device__ __forceinline__ unsigned f2bf(float f) { return pk2(f, 0.f) & 0xffffu; }
__device__ __forceinline__ float bf2f(unsigned short h) { return __builtin_bit_cast(float, (unsigned)h << 16); }
__device__ __forceinline__ float bflo(unsigned w) { return __builtin_bit_cast(float, w << 16); }
__device__ __forceinline__ float bfhi(unsigned w) { return __builtin_bit_cast(float, w & 0xffff0000u); }
#define DPP_ADD(v, CTRL) ((v) + __builtin_bit_cast(float, __builtin_amdgcn_update_dpp(0, __builtin_bit_cast(int, (v)), (CTRL), 0xf, 0xf, false)))
__device__ __forceinline__ float xor16_sum(float v) { auto r = __builtin_amdgcn_permlane16_swap(__float_as_uint(v), __float_as_uint(v), false, false); return __uint_as_float(r[0]) + __uint_as_float(r[1]); }
__device__ __forceinline__ float xor32_sum(float v) { auto r = __builtin_amdgcn_permlane32_swap(__float_as_uint(v), __float_as_uint(v), false, false); return __uint_as_float(r[0]) + __uint_as_float(r[1]); }
__device__ __forceinline__ float wave_sum(float v) {
    v = DPP_ADD(v, 0xB1); v = DPP_ADD(v, 0x4E); v = DPP_ADD(v, 0x141); v = DPP_ADD(v, 0x140);
    return xor32_sum(xor16_sum(v));
}
__device__ __forceinline__ float sigmoidf_(float x) { return 1.0f / (1.0f + __expf(-x)); }

namespace pg8 {
#define PG8_LAS __attribute__((address_space(3)))
typedef unsigned short bf16_t;
typedef short bf16x8 __attribute__((ext_vector_type(8)));
typedef float f32x4 __attribute__((ext_vector_type(4)));
typedef unsigned u32x4 __attribute__((ext_vector_type(4)));
constexpr int BM = 256, BK = 64, HALF = 128, HTB = HALF * BK * 2, STAGE_BYTES = 8 * HTB, NXCD = 8, WGM = 8;

__host__ __device__ __forceinline__ int lds_byte(int r, int c) { const int st = (r >> 4) * 2 + (c >> 5), rr = r & 15, cc = c & 31, ob = rr * 64 + cc * 2; return st * 1024 + (ob ^ (((ob >> 9) & 1) << 5)); }
__host__ __device__ __forceinline__ void stage_rc(int b, int& R, int& C) { const int st = b / 1024, sb = b % 1024, swz = sb ^ (((sb >> 9) & 1) << 5); R = (st >> 1) * 16 + swz / 64; C = (st & 1) * 32 + (swz % 64) / 2; }
__host__ __device__ __forceinline__ int perm32(int rho) { const int n = rho >> 4, i = rho & 15; return 8 * (i >> 2) + 4 * n + (i & 3); }

struct Unit { int pm, pn, bt; };
struct Gemm { const bf16_t* A; const bf16_t* Bt; int M, N, K; };

struct StaticOrder {
    static constexpr bool GATHER = false;
    int nM, nN, nwg, G, c;
    __host__ __device__ void init(int M, int N, int G_, int c_) { nM = M / BM; nN = N / BM; nwg = nM * nN; G = G_; c = c_; }
    __host__ __device__ bool next(int i, Unit& u) const {
        const long L = (long)i * G + c; if (L >= nwg) return false;
        int wgid = (int)L; { const int q = nwg / NXCD, r = nwg % NXCD, xcd = wgid % NXCD, off = wgid / NXCD; wgid = (xcd < r ? xcd * (q + 1) : r * (q + 1) + (xcd - r) * q) + off; }
        const int nig = WGM * nN, gid = wgid / nig, fm = gid * WGM, gsz = (nM - fm) < WGM ? (nM - fm) : WGM;
        u.pm = fm + ((wgid % nig) % gsz); u.pn = (wgid % nig) / gsz; u.bt = u.pn; return true;
    }
};

__device__ __forceinline__ unsigned cvt_pk_bf16(float lo, float hi) { unsigned r; asm volatile("v_cvt_pk_bf16_f32 %0, %1, %2" : "=v"(r) : "v"(lo), "v"(hi)); return r; }

typedef int v8i_t __attribute__((ext_vector_type(8)));
typedef int v4i_t __attribute__((ext_vector_type(4)));
template <class Sched> __device__ __forceinline__ unsigned a_base_of(const Sched& S, const Unit& u, unsigned tstep) { if constexpr (Sched::GATHER) return S.a_base(u); else return (unsigned)u.pm * tstep; }
template <class Epi, class Sched, bool ALIGN_EPI = false, bool SP2 = false, bool FP8 = false>
__device__ __forceinline__ void gemm_phase(PG8_LAS unsigned char* lds, const Gemm g, const Sched& S, const Epi& E, const bool skip_epi = false) {
    const int tid = threadIdx.x, wid = __builtin_amdgcn_readfirstlane(tid >> 6), lane = tid & 63, wr = wid >> 2, wc = wid & 3, fr = lane & 15, fq = lane >> 4;
    int K = g.K; asm volatile("" : "+s"(K));
    const int nt = K / BK;
    unsigned voffA[2], voffB[2];
#pragma unroll
    for (int i = 0; i < 2; ++i) { int R, C; stage_rc(tid * 16 + i * 8192, R, C); const int Rb = Epi::PERM ? ((R & ~31) + perm32(R & 31)) : R;
        voffA[i] = (unsigned)(R * K + C) * 2u; voffB[i] = (unsigned)(Rb * K + C) * 2u; }
    const unsigned kstep = (unsigned)(BK * 2);
    const unsigned hstep = (unsigned)HALF * (unsigned)K * 2u;
    const unsigned tstep = 2u * hstep;
    const unsigned ldsw = (unsigned)wid * 1024u;
    const int aoff = lds_byte(wr * 64 + fr, fq * 8), boff = lds_byte(wc * 32 + fr, fq * 8);
    const __amdgpu_buffer_rsrc_t rsA = __builtin_amdgcn_make_buffer_rsrc((void*)g.A, 0, 0x7fffffff, 0x00020000), rsB = __builtin_amdgcn_make_buffer_rsrc((void*)g.Bt, 0, 0x7fffffff, 0x00020000);
#define PG8_SA(b, h) (((b) * 2 + (h)) * HTB)
#define PG8_SB(b, h) ((4 + (b) * 2 + (h)) * HTB)
#if GEMM_GLDS
#define PG8_STAGE(bufoff, rs, soff, voff) do { _Pragma("unroll") for (int _i = 0; _i < 2; ++_i) { \
        if constexpr (FP8) __builtin_amdgcn_raw_ptr_buffer_load_lds(rs, (PG8_LAS void*)(lds + (bufoff) + ldsw + _i * 8192), 16, (int)(voff)[_i], (int)(soff), 0, 0); \
        else __builtin_amdgcn_global_load_lds((const unsigned*)((&rs == &rsA ? (const char*)g.A : (const char*)g.Bt) + (size_t)(soff) + (voff)[_i]), (PG8_LAS unsigned*)(lds + (bufoff) + ldsw + _i * 8192), 16, 0, 0); } } while (0)
#else
#define PG8_STAGE(bufoff, rs, soff, voff) do { _Pragma("unroll") for (int _i = 0; _i < 2; ++_i) \
        __builtin_amdgcn_raw_ptr_buffer_load_lds(rs, (PG8_LAS void*)(lds + (bufoff) + ldsw + _i * 8192), 16, (int)(voff)[_i], (int)(soff), 0, 0); } while (0)
#endif
#define PG8_STAGE_A(bufoff, half, soff, gsel) do { if constexpr (Sched::GATHER) { PG8_STAGE(bufoff, rsA, soff, gsel[half]); } else { PG8_STAGE(bufoff, rsA, (soff) + (half) * hstep, voffA); } } while (0)
#define PG8_LDA(dst, b, h) do { if constexpr (FP8) { _Pragma("unroll") for (int m = 0; m < 4; ++m) { const v4i_t _lo = *(const PG8_LAS v4i_t*)(lds + PG8_SA(b, h) + aoff + m * 2048), _hi = *(const PG8_LAS v4i_t*)(lds + PG8_SA(b, h) + aoff + m * 2048 + 1024); dst##8[m] = __builtin_shufflevector(_lo, _hi, 0, 1, 2, 3, 4, 5, 6, 7); } } \
    else { _Pragma("unroll") for (int m = 0; m < 4; ++m) _Pragma("unroll") for (int k = 0; k < 2; ++k) dst[m][k] = *(const PG8_LAS bf16x8*)(lds + PG8_SA(b, h) + aoff + m * 2048 + k * 1024); } } while (0)
#define PG8_LDB(dst, b, h) do { if constexpr (FP8) { _Pragma("unroll") for (int n = 0; n < 2; ++n) { const v4i_t _lo = *(const PG8_LAS v4i_t*)(lds + PG8_SB(b, h) + boff + n * 2048), _hi = *(const PG8_LAS v4i_t*)(lds + PG8_SB(b, h) + boff + n * 2048 + 1024); dst##8[n] = __builtin_shufflevector(_lo, _hi, 0, 1, 2, 3, 4, 5, 6, 7); } } \
    else { _Pragma("unroll") for (int n = 0; n < 2; ++n) _Pragma("unroll") for (int k = 0; k < 2; ++k) dst[n][k] = *(const PG8_LAS bf16x8*)(lds + PG8_SB(b, h) + boff + n * 2048 + k * 1024); } } while (0)
#define PG8_MMA(ai, bj, At, Bt) do { __builtin_amdgcn_s_setprio(1); _Pragma("unroll") for (int m = 0; m < 4; ++m) _Pragma("unroll") for (int n = 0; n < 2; ++n) { \
        if constexpr (FP8) acc[ai][bj][m][n] = __builtin_amdgcn_mfma_scale_f32_16x16x128_f8f6f4(Bt##8[n], At##8[m], acc[ai][bj][m][n], 0, 0, 0, 0, 0, 0); \
        else { _Pragma("unroll") for (int k = 0; k < 2; ++k) acc[ai][bj][m][n] = __builtin_amdgcn_mfma_f32_16x16x32_bf16(Bt[n][k], At[m][k], acc[ai][bj][m][n], 0, 0, 0); } } __builtin_amdgcn_s_setprio(0); } while (0)
#define PG8_WAIT_V(n) asm volatile("s_waitcnt vmcnt(" #n ")" ::: "memory")
#define PG8_WAIT_L(n) asm volatile("s_waitcnt lgkmcnt(" #n ")" ::: "memory")
#define PG8_BAR __builtin_amdgcn_s_barrier()
#define PG8_SCHED __builtin_amdgcn_sched_barrier(0)
    Unit cur, nxt; int ui = 0;
    if (!S.next(0, cur)) return;
    f32x4 acc[2][2][4][2];
#pragma unroll
    for (int a = 0; a < 2; ++a)
#pragma unroll
        for (int b = 0; b < 2; ++b)
#pragma unroll
            for (int m = 0; m < 4; ++m)
#pragma unroll
                for (int n = 0; n < 2; ++n) acc[a][b][m][n] = (f32x4){0.f, 0.f, 0.f, 0.f};
    bf16x8 At[4][2], B0[2][2], B1[2][2]; v8i_t At8[4], B08[2], B18[2];
    unsigned cA = a_base_of(S, cur, tstep), cB = (unsigned)cur.bt * tstep;
    unsigned gc[2][2] = {{0u, 0u}, {0u, 0u}};
    if constexpr (Sched::GATHER) S.rows(cur, gc);
    if constexpr (SP2) {
        PG8_STAGE(PG8_SB(0, 0), rsB, cB, voffB); PG8_STAGE(PG8_SB(0, 1), rsB, cB + hstep, voffB); PG8_STAGE_A(PG8_SA(0, 0), 0, cA, gc); PG8_STAGE_A(PG8_SA(0, 1), 1, cA, gc);
        if (wr == 1) PG8_BAR;
        PG8_WAIT_V(2); PG8_BAR;
        PG8_STAGE(PG8_SB(1, 0), rsB, cB + kstep, voffB); PG8_STAGE_A(PG8_SA(1, 0), 0, cA + kstep, gc); PG8_STAGE(PG8_SB(1, 1), rsB, cB + hstep + kstep, voffB);
        PG8_WAIT_V(6); PG8_BAR;
    } else {
        PG8_STAGE(PG8_SB(0, 0), rsB, cB, voffB); PG8_STAGE_A(PG8_SA(0, 0), 0, cA, gc); PG8_STAGE(PG8_SB(0, 1), rsB, cB + hstep, voffB); PG8_STAGE_A(PG8_SA(0, 1), 1, cA, gc);
        if (wr == 1) PG8_BAR;
        PG8_WAIT_V(4); PG8_BAR;
        PG8_STAGE(PG8_SB(1, 0), rsB, cB + kstep, voffB); PG8_STAGE_A(PG8_SA(1, 0), 0, cA + kstep, gc); PG8_STAGE(PG8_SB(1, 1), rsB, cB + hstep + kstep, voffB);
        PG8_WAIT_V(6); PG8_BAR;
    }
    for (;;) {
        const bool has_next = S.next(ui + 1, nxt);
        const unsigned nA = has_next ? a_base_of(S, nxt, tstep) : cA, nB = has_next ? (unsigned)nxt.bt * tstep : cB;
#pragma clang loop unroll(disable)
        for (int t = 0; t < nt; t += 2) {
            const bool last = (t == nt - 2);
            const unsigned a1 = cA + (unsigned)(t + 1) * kstep;
            const unsigned a2 = last ? nA : cA + (unsigned)(t + 2) * kstep, b2 = last ? nB : cB + (unsigned)(t + 2) * kstep;
            const unsigned a3 = a2 + kstep, b3 = b2 + kstep;
            unsigned g23[2][2] = {{gc[0][0], gc[0][1]}, {gc[1][0], gc[1][1]}};
            if constexpr (Sched::GATHER) { if (last && has_next) S.rows(nxt, g23); }
            if constexpr (SP2) {
            PG8_LDB(B0, 0, 0); PG8_LDB(B1, 0, 1); PG8_SCHED; PG8_LDA(At, 0, 0); PG8_STAGE_A(PG8_SA(1, 1), 1, a1, gc);
            PG8_WAIT_V(8); PG8_WAIT_L(0); PG8_BAR; PG8_MMA(0, 0, At, B0); PG8_MMA(0, 1, At, B1); PG8_BAR; PG8_SCHED;
            PG8_LDA(At, 0, 1); PG8_STAGE(PG8_SB(0, 0), rsB, b2, voffB); PG8_STAGE(PG8_SB(0, 1), rsB, b2 + hstep, voffB); PG8_STAGE_A(PG8_SA(0, 0), 0, a2, g23);
            PG8_WAIT_V(8); PG8_WAIT_L(0); PG8_BAR; PG8_MMA(1, 0, At, B0); PG8_MMA(1, 1, At, B1); PG8_BAR; PG8_SCHED;
            PG8_LDB(B0, 1, 0); PG8_LDB(B1, 1, 1); PG8_SCHED; PG8_LDA(At, 1, 0); PG8_STAGE_A(PG8_SA(0, 1), 1, a2, g23);
            PG8_WAIT_V(8); PG8_WAIT_L(0); PG8_BAR; PG8_MMA(0, 0, At, B0); PG8_MMA(0, 1, At, B1); PG8_BAR; PG8_SCHED;
            PG8_LDA(At, 1, 1); PG8_STAGE(PG8_SB(1, 0), rsB, b3, voffB); PG8_STAGE(PG8_SB(1, 1), rsB, b3 + hstep, voffB); PG8_STAGE_A(PG8_SA(1, 0), 0, a3, g23);
            PG8_WAIT_V(8); PG8_WAIT_L(0); PG8_BAR; PG8_MMA(1, 0, At, B0); PG8_MMA(1, 1, At, B1); PG8_BAR; PG8_SCHED;
            } else {
            PG8_LDB(B0, 0, 0); PG8_SCHED; PG8_LDA(At, 0, 0); PG8_STAGE_A(PG8_SA(1, 1), 1, a1, gc);
            PG8_WAIT_L(8); PG8_BAR; PG8_WAIT_L(0); PG8_MMA(0, 0, At, B0); PG8_BAR; PG8_SCHED;
            PG8_LDB(B1, 0, 1); PG8_STAGE(PG8_SB(0, 0), rsB, b2, voffB);
            PG8_BAR; PG8_WAIT_L(0); PG8_MMA(0, 1, At, B1); PG8_BAR;
            PG8_LDA(At, 0, 1); PG8_STAGE_A(PG8_SA(0, 0), 0, a2, g23);
            PG8_BAR; PG8_WAIT_L(0); PG8_MMA(1, 0, At, B0); PG8_BAR; PG8_SCHED;
            PG8_STAGE(PG8_SB(0, 1), rsB, b2 + hstep, voffB);
            PG8_WAIT_V(6); PG8_BAR; PG8_MMA(1, 1, At, B1); PG8_BAR;
            PG8_LDB(B0, 1, 0); PG8_SCHED; PG8_LDA(At, 1, 0); PG8_STAGE_A(PG8_SA(0, 1), 1, a2, g23);
            PG8_WAIT_L(8); PG8_BAR; PG8_WAIT_L(0); PG8_MMA(0, 0, At, B0); PG8_BAR; PG8_SCHED;
            PG8_LDB(B1, 1, 1); PG8_STAGE(PG8_SB(1, 0), rsB, b3, voffB);
            PG8_BAR; PG8_WAIT_L(0); PG8_MMA(0, 1, At, B1); PG8_BAR;
            PG8_LDA(At, 1, 1); PG8_STAGE_A(PG8_SA(1, 0), 0, a3, g23);
            PG8_BAR; PG8_WAIT_L(0); PG8_MMA(1, 0, At, B0); PG8_BAR; PG8_SCHED;
            PG8_STAGE(PG8_SB(1, 1), rsB, b3 + hstep, voffB);
            PG8_WAIT_V(6); PG8_BAR; PG8_MMA(1, 1, At, B1); PG8_BAR;
            }
        }
        if constexpr (ALIGN_EPI) { if (wr == 0) PG8_BAR; }
        if (!skip_epi) E(acc, cur, wr, wc, fr, fq); else asm volatile("" :: "v"(acc[0][0][0][0]), "v"(acc[1][1][3][1]), "v"(acc[0][1][2][0]), "v"(acc[1][0][1][1]));
        if (!has_next) break;
#pragma unroll
        for (int a = 0; a < 2; ++a)
#pragma unroll
            for (int b = 0; b < 2; ++b)
#pragma unroll
                for (int m = 0; m < 4; ++m)
#pragma unroll
                    for (int n = 0; n < 2; ++n) acc[a][b][m][n] = (f32x4){0.f, 0.f, 0.f, 0.f};
        cur = nxt; cA = nA; cB = nB; ++ui;
        if constexpr (Sched::GATHER) S.rows(cur, gc);
        if constexpr (ALIGN_EPI) { if (wr == 1) PG8_BAR; }
    }
    PG8_WAIT_V(0);
    if constexpr (!ALIGN_EPI) { if (wr == 0) PG8_BAR; }
    PG8_BAR;
#undef PG8_SA
#undef PG8_SB
#undef PG8_STAGE
#undef PG8_STAGE_A
#undef PG8_LDA
#undef PG8_LDB
#undef PG8_MMA
#undef PG8_WAIT_V
#undef PG8_WAIT_L
#undef PG8_BAR
#undef PG8_SCHED
}
}

namespace attn_body {
using bf16x8=__attribute__((ext_vector_type(8)))short;
using s16x4=__attribute__((ext_vector_type(4)))short;
using f32x16=__attribute__((ext_vector_type(16)))float;
using u32x4=__attribute__((ext_vector_type(4)))unsigned;
typedef unsigned short bf16r;
constexpr int D=64, QP=AW, KP=KVW, OP=DM;
constexpr int NW=8,QBLK=32,QB=QBLK*NW,KVBLK=64;
__device__ __forceinline__ int crow(int r,int hi){return (r&3)+8*(r>>2)+4*hi;}
#define SBAR() __builtin_amdgcn_sched_barrier(0)
constexpr int NSLOT=3, SLOTB=8192;
constexpr int LDS_K=0, LDS_V=NSLOT*SLOTB, LDS_WS=2*NSLOT*SLOTB, LDS_OST=LDS_WS+NW*64*4, LDS_BYTES_A=LDS_OST+NW*4096;
__device__ __forceinline__ void glds16(const void*gsrc,unsigned lds_dst){unsigned keep;
  asm volatile("s_mov_b32 %0, m0\n\ts_mov_b32 m0, %2\n\ts_nop 0\n\tglobal_load_lds_dwordx4 %1, off\n\ts_mov_b32 m0, %0":"=&s"(keep):"v"(gsrc),"s"(lds_dst):"memory");}
__device__ __forceinline__ float max3f(float a,float b,float c){float r;asm("v_max3_f32 %0, %1, %2, %3":"=v"(r):"v"(a),"v"(b),"v"(c));return r;}
__device__ __forceinline__ float max2f(float a,float b){float r;asm("v_max_f32_e32 %0, %1, %2":"=v"(r):"v"(a),"v"(b));return r;}
__device__ __forceinline__ float fadd_s(float a,float b){float r;asm("v_add_f32_e32 %0, %1, %2":"=v"(r):"v"(a),"v"(b));return r;}
__device__ __forceinline__ float fsub_s(float a,float b){float r;asm("v_sub_f32_e32 %0, %1, %2":"=v"(r):"v"(a),"v"(b));return r;}
typedef float f32x2_t __attribute__((ext_vector_type(2))); typedef __bf16 bf16x2_t __attribute__((ext_vector_type(2)));
__device__ __forceinline__ unsigned cvtpk_s(float lo,float hi){f32x2_t v={lo,hi};bf16x2_t b=__builtin_convertvector(v,bf16x2_t);return __builtin_bit_cast(unsigned,b);}
#define WAIT_BAR(N) asm volatile("s_waitcnt vmcnt(" #N ") lgkmcnt(0)\n\ts_barrier":::"memory")
__device__ __forceinline__ void qkt(f32x16&p0,f32x16&p1,const char*Kslot,const bf16x8*qr,const f32x16&negm,int r32,int hi){
  const char*kb=Kslot+hi*1024+r32*16;
  #pragma unroll
  for(int d0=0;d0<4;++d0){
    const bf16x8 b0=*reinterpret_cast<const bf16x8*>(kb+d0*2048);
    const bf16x8 b1=*reinterpret_cast<const bf16x8*>(kb+d0*2048+512);
    if(d0==0){p0=__builtin_amdgcn_mfma_f32_32x32x16_bf16(b0,qr[0],negm,0,0,0);p1=__builtin_amdgcn_mfma_f32_32x32x16_bf16(b1,qr[0],negm,0,0,0);}
    else{p0=__builtin_amdgcn_mfma_f32_32x32x16_bf16(b0,qr[d0],p0,0,0,0);p1=__builtin_amdgcn_mfma_f32_32x32x16_bf16(b1,qr[d0],p1,0,0,0);}}
}
typedef __attribute__((address_space(3))) const char* lds_cptr;
typedef short v4i16_t __attribute__((ext_vector_type(4)));
__device__ __forceinline__ void kload8(bf16x8*kf,lds_cptr kp){
  kf[0]=*(const __attribute__((address_space(3))) bf16x8*)(kp);      kf[1]=*(const __attribute__((address_space(3))) bf16x8*)(kp+512);
  kf[2]=*(const __attribute__((address_space(3))) bf16x8*)(kp+2048); kf[3]=*(const __attribute__((address_space(3))) bf16x8*)(kp+2560);
  kf[4]=*(const __attribute__((address_space(3))) bf16x8*)(kp+4096); kf[5]=*(const __attribute__((address_space(3))) bf16x8*)(kp+4608);
  kf[6]=*(const __attribute__((address_space(3))) bf16x8*)(kp+6144); kf[7]=*(const __attribute__((address_space(3))) bf16x8*)(kp+6656);
}
__device__ __forceinline__ void kload2(bf16x8*kf,lds_cptr kp,int j){ kf[2*j]=*(const __attribute__((address_space(3))) bf16x8*)(kp+j*2048); kf[2*j+1]=*(const __attribute__((address_space(3))) bf16x8*)(kp+j*2048+512); }
__device__ __forceinline__ s16x4 vtr(lds_cptr p){ return __builtin_bit_cast(s16x4,__builtin_amdgcn_ds_read_tr16_b64_v4i16((__attribute__((address_space(3))) v4i16_t*)p)); }
__device__ __forceinline__ float rowmax(const f32x16&p0,const f32x16&p1){
  float a=max3f(p0[0],p0[1],p1[0]),b=max3f(p0[2],p0[3],p1[1]);a=max3f(a,p1[2],p1[3]);
  #pragma unroll
  for(int r=4;r<16;r+=4){a=max3f(a,p0[r],p0[r+1]);b=max3f(b,p0[r+2],p0[r+3]);a=max3f(a,p1[r],p1[r+1]);b=max3f(b,p1[r+2],p1[r+3]);}
  const float m=max2f(a,b);
  auto rr=__builtin_amdgcn_permlane32_swap(__float_as_uint(m),__float_as_uint(m),false,false);
  return max2f(__uint_as_float(rr[0]),__uint_as_float(rr[1]));
}
__device__ __forceinline__ void pv(f32x16*o,int vb,bf16x8 pa0,bf16x8 pa1,bf16x8 pa2,bf16x8 pa3){
  #pragma unroll
  for(int d0=0;d0<2;++d0){s16x4 lo[4],hi[4];
    #pragma unroll
    for(int ks=0;ks<4;++ks){
      asm volatile("ds_read_b64_tr_b16 %0,%1 offset:%c2":"=&v"(lo[ks]):"v"(vb),"i"(d0*4096+ks*1024):"memory");
      asm volatile("ds_read_b64_tr_b16 %0,%1 offset:%c2":"=&v"(hi[ks]):"v"(vb),"i"(d0*4096+ks*1024+512):"memory");}
    asm volatile("s_waitcnt lgkmcnt(0)":::"memory");SBAR();
    #define PK(k) (bf16x8){lo[k][0],lo[k][1],lo[k][2],lo[k][3],hi[k][0],hi[k][1],hi[k][2],hi[k][3]}
    o[d0]=__builtin_amdgcn_mfma_f32_32x32x16_bf16(pa0,PK(0),o[d0],0,0,0);
    o[d0]=__builtin_amdgcn_mfma_f32_32x32x16_bf16(pa1,PK(1),o[d0],0,0,0);
    o[d0]=__builtin_amdgcn_mfma_f32_32x32x16_bf16(pa2,PK(2),o[d0],0,0,0);
    o[d0]=__builtin_amdgcn_mfma_f32_32x32x16_bf16(pa3,PK(3),o[d0],0,0,0);
    #undef PK
  }
}
template<int THRL> __device__ __forceinline__ void attn_unit(int b,int h,int qb,const bf16r*Q,const bf16r*__restrict__ K,const bf16r*__restrict__ V,bf16r*O,char*shm,bool pre_issued,bool issue_next,float bref){
  const int tid=threadIdx.x,lane=tid&63,r32=lane&31,hi=lane>>5; const int wid=__builtin_amdgcn_readfirstlane(tid>>6);
  const long rowbase=(long)b*SEQ; const int q0=qb*QB; const int hk=h>>2;
  const bf16r*Qw=Q+(rowbase+q0+wid*QBLK)*QP+h*D;
  const bf16r*Kh=K+rowbase*KP+hk*D,*Vh=V+rowbase*KP+hk*D;
  const unsigned lds0=(unsigned)(uintptr_t)shm;
  float*wsf=(float*)(shm+LDS_WS)+wid*64;
  const bf16r*ksrc=Kh+(long)lane*KP+wid*8;
  const bf16r*vsrc=Vh+(long)(16*(wid&3)+(lane>>2))*KP+(wid>>2)*32+(lane&3)*8;
  const unsigned kdst=lds0+LDS_K+wid*1024, vdst=lds0+LDS_V+wid*1024;
  #define DMA_K(t,slot) glds16(ksrc+(long)(t)*KVBLK*KP,(unsigned)__builtin_amdgcn_readfirstlane(kdst+(slot)))
  #define DMA_V(t,slot) glds16(vsrc+(long)(t)*KVBLK*KP,(unsigned)__builtin_amdgcn_readfirstlane(vdst+(slot)))
  const int vb0=(int)(lds0+LDS_V)+((lane>>4)&1)*32+(lane&3)*8+(4*hi+((lane&15)>>2))*64;
  const char*Kbase=shm+LDS_K; bf16x8 kf[8];
  const lds_cptr shm3=(lds_cptr)shm; const lds_cptr kp0=shm3+LDS_K+hi*1024+r32*16; const lds_cptr vp0=shm3+LDS_V+((lane>>4)&1)*32+(lane&3)*8+(4*hi+((lane&15)>>2))*64;
  constexpr int NT=SEQ/KVBLK;
  if(!pre_issued){DMA_K(0,0);DMA_V(0,0);DMA_K(1,SLOTB);}
  bf16x8 qr[4];
  #pragma unroll
  for(int d0=0;d0<4;++d0)qr[d0]=*reinterpret_cast<const bf16x8*>(&Qw[(long)r32*QP+d0*16+hi*8]);
  float l_reg=0.f;f32x16 o[2];o[0]=f32x16{};o[1]=f32x16{};f32x16 negm;
  _Pragma("unroll") for(int r=0;r<16;++r)negm[r]=-bref; asm volatile("":"+v"(negm));
  bool resc=false;
  #define START(P0,P1) do{ _Pragma("unroll") for(int r=0;r<16;++r)P0[r]=__builtin_amdgcn_exp2f(P0[r]); }while(0)
  #define RESC() do{ if(resc){ asm volatile("s_waitcnt lgkmcnt(0)":::"memory"); \
      _Pragma("unroll") for(int d_=0;d_<2;++d_) _Pragma("unroll") for(int r=0;r<16;++r)o[d_][r]*=wsf[crow(r,hi)]; } }while(0)
  f32x16 pA0,pA1,pB0,pB1;
  int sl_prev=0,sl_cur=0,sl_next=SLOTB;
  #define ROT() do{sl_prev=sl_cur;sl_cur=sl_next;sl_next=(sl_next==(NSLOT-1)*SLOTB)?0:sl_next+SLOTB;}while(0)
  if(!pre_issued){DMA_K(2,2*SLOTB);}
  WAIT_BAR(3);
  qkt(pA0,pA1,Kbase,qr,negm,r32,hi);asm volatile("s_nop 15\n\ts_nop 7":"+v"(pA0),"+v"(pA1));
  START(pA0,pA1);
  _Pragma("unroll") for(int r=0;r<16;++r)pA1[r]=__builtin_amdgcn_exp2f(pA1[r]);
  WAIT_BAR(0);
  DMA_K(3,0);DMA_V(1,SLOTB);
  ROT();
  kload8(kf,kp0+sl_cur);
  WAIT_BAR(2);
  s16x4 vlo[8],vhi[8]; u32x4 pw0,pw1,pw2,pw3;
  #define PKW(P,B) cvtpk_s(P[B],P[B+1])
  #define PAF(k) __builtin_bit_cast(bf16x8,pw##k)
  #define VFR(i) (bf16x8){vlo[i][0],vlo[i][1],vlo[i][2],vlo[i][3],vhi[i][0],vhi[i][1],vhi[i][2],vhi[i][3]}
  #define PIN(x) asm volatile("":"+v"(x))
  #define MX3(a,b,c) __builtin_fmaxf(__builtin_fmaxf((a),(b)),(c))
  #define GAPA(MF,A0,A1,A2,A3,W0,W1,PW) do{ MF; sacc+=A0; sacc+=A1; sacc+=A2; sacc+=A3; PIN(sacc); W0; W1; PIN(PW); SBAR(); }while(0)
  #define EX(v) __builtin_amdgcn_exp2f(v)
  #define GAPB(MF,X,B) do{ MF; X[B]=EX(X[B]); X[B+1]=EX(X[B+1]); X[B+2]=EX(X[B+2]); X[B+3]=EX(X[B+3]); PIN(X); SBAR(); }while(0)
  #define VRD(i) do{ vlo[i]=vtr(vp_+(((i)>>2)*4096+((i)&3)*1024)); vhi[i]=vtr(vp_+(((i)>>2)*4096+((i)&3)*1024+512)); }while(0)
  #define KRD(G,j) do{ if(G){ kload2(kf,kp0+sl_next,j); SBAR(); } }while(0)
  #define STEP(C0,C1,P0,P1,t,GK,GV,GL) do{ SBAR(); \
    const lds_cptr vp_=vp0+sl_prev; \
    VRD(0); SBAR(); float sacc=(P0[0]+P0[1]); \
    GAPA(C0=__builtin_amdgcn_mfma_f32_32x32x16_bf16(kf[0],qr[0],negm,0,0,0), P0[2],P0[3],P0[4],P0[5],     pw0[0]=PKW(P0,0), pw0[1]=PKW(P0,2), pw0); \
    VRD(4); SBAR(); GAPA(C1=__builtin_amdgcn_mfma_f32_32x32x16_bf16(kf[1],qr[0],negm,0,0,0), P0[6],P0[7],P0[8],P0[9],     pw0[2]=PKW(P0,4), pw0[3]=PKW(P0,6), pw0); \
    VRD(1); SBAR(); GAPA(C0=__builtin_amdgcn_mfma_f32_32x32x16_bf16(kf[2],qr[1],C0,0,0,0),   P0[10],P0[11],P0[12],P0[13], pw1[0]=PKW(P0,8), pw1[1]=PKW(P0,10), pw1); \
    VRD(5); SBAR(); GAPA(C1=__builtin_amdgcn_mfma_f32_32x32x16_bf16(kf[3],qr[1],C1,0,0,0),   P0[14],P0[15],P1[0],P1[1],   pw1[2]=PKW(P0,12),pw1[3]=PKW(P0,14), pw1); \
    VRD(2); SBAR(); GAPA(C0=__builtin_amdgcn_mfma_f32_32x32x16_bf16(kf[4],qr[2],C0,0,0,0),   P1[2],P1[3],P1[4],P1[5],     pw2[0]=PKW(P1,0), pw2[1]=PKW(P1,2), pw2); \
    VRD(6); SBAR(); GAPA(C1=__builtin_amdgcn_mfma_f32_32x32x16_bf16(kf[5],qr[2],C1,0,0,0),   P1[6],P1[7],P1[8],P1[9],     pw2[2]=PKW(P1,4), pw2[3]=PKW(P1,6), pw2); \
    VRD(3); SBAR(); GAPA(C0=__builtin_amdgcn_mfma_f32_32x32x16_bf16(kf[6],qr[3],C0,0,0,0),   P1[10],P1[11],P1[12],P1[13], pw3[0]=PKW(P1,8), pw3[1]=PKW(P1,10), pw3); \
    VRD(7); SBAR(); GAPA(C1=__builtin_amdgcn_mfma_f32_32x32x16_bf16(kf[7],qr[3],C1,0,0,0),   P1[14],P1[15],0.f,0.f,       pw3[2]=PKW(P1,12),pw3[3]=PKW(P1,14), pw3); \
    l_reg+=sacc; \
    if(GK){DMA_K((t)+3,sl_cur);} if(GV){DMA_V((t)+1,sl_next);} \
    SBAR(); \
    GAPB(o[0]=__builtin_amdgcn_mfma_f32_32x32x16_bf16(PAF(0),VFR(0),o[0],0,0,0), C0,0); \
    GAPB(o[1]=__builtin_amdgcn_mfma_f32_32x32x16_bf16(PAF(0),VFR(4),o[1],0,0,0), C0,4); \
    KRD(GL,0); GAPB(o[0]=__builtin_amdgcn_mfma_f32_32x32x16_bf16(PAF(1),VFR(1),o[0],0,0,0), C0,8); \
    KRD(GL,1); GAPB(o[1]=__builtin_amdgcn_mfma_f32_32x32x16_bf16(PAF(1),VFR(5),o[1],0,0,0), C0,12); \
    KRD(GL,2); GAPB(o[0]=__builtin_amdgcn_mfma_f32_32x32x16_bf16(PAF(2),VFR(2),o[0],0,0,0), C1,0); \
    KRD(GL,3); GAPB(o[1]=__builtin_amdgcn_mfma_f32_32x32x16_bf16(PAF(2),VFR(6),o[1],0,0,0), C1,4); \
    GAPB(o[0]=__builtin_amdgcn_mfma_f32_32x32x16_bf16(PAF(3),VFR(3),o[0],0,0,0), C1,8); \
    GAPB(o[1]=__builtin_amdgcn_mfma_f32_32x32x16_bf16(PAF(3),VFR(7),o[1],0,0,0), C1,12); \
    }while(0)
  int t=1;
  for(;t+5<NT;t+=2){
    STEP(pB0,pB1,pA0,pA1,t,true,true,true);     WAIT_BAR(2); RESC(); ROT();
    STEP(pA0,pA1,pB0,pB1,t+1,true,true,true);   WAIT_BAR(2); RESC(); ROT();
  }
  #define ENDW(tt) do{ if((tt)+3<NT){WAIT_BAR(2);} else if((tt)+2<NT){WAIT_BAR(1);} else {WAIT_BAR(0);} }while(0)
  for(;t+1<NT;t+=2){
    STEP(pB0,pB1,pA0,pA1,t,(t+3<NT),(t+1<NT),(t+1<NT));       ENDW(t);   RESC(); ROT();
    STEP(pA0,pA1,pB0,pB1,t+1,(t+4<NT),(t+2<NT),(t+2<NT));     ENDW(t+1); RESC(); ROT();
  }
  STEP(pB0,pB1,pA0,pA1,NT-1,false,false,false); RESC();
  { float sacc=pB0[0]+pB0[1]; _Pragma("unroll") for(int r=2;r<16;++r)sacc+=pB0[r]; _Pragma("unroll") for(int r=0;r<16;++r)sacc+=pB1[r]; l_reg+=sacc;
    pw0=(u32x4){PKW(pB0,0),PKW(pB0,2),PKW(pB0,4),PKW(pB0,6)};pw1=(u32x4){PKW(pB0,8),PKW(pB0,10),PKW(pB0,12),PKW(pB0,14)};pw2=(u32x4){PKW(pB1,0),PKW(pB1,2),PKW(pB1,4),PKW(pB1,6)};pw3=(u32x4){PKW(pB1,8),PKW(pB1,10),PKW(pB1,12),PKW(pB1,14)};
    SBAR(); pv(o,vb0+sl_cur,PAF(0),PAF(1),PAF(2),PAF(3)); }
  #undef PKW
  #undef PAF
  #undef VFR
  #undef PIN
  #undef MX3
  #undef GAPA
  #undef GAPB
  #undef EX
  #undef VRD
  #undef KRD
  #undef STEP
  #undef ENDW
  if(issue_next){ asm volatile("s_waitcnt lgkmcnt(0)\n\ts_barrier":::"memory");
    DMA_K(0,0);DMA_V(0,0);DMA_K(1,SLOTB);DMA_K(2,2*SLOTB); }
  {auto rr=__builtin_amdgcn_permlane32_swap(__float_as_uint(l_reg),__float_as_uint(l_reg),false,false);l_reg=__uint_as_float(rr[0])+__uint_as_float(rr[1]);}
  if(hi==0)wsf[32+r32]=l_reg;asm volatile("s_waitcnt lgkmcnt(0)":::"memory");
  float rli[16];
  #pragma unroll
  for(int r=0;r<16;++r)rli[r]=__builtin_amdgcn_rcpf(wsf[32+crow(r,hi)]);
  bf16r*Ow=O+(rowbase+q0+wid*QBLK)*OP+h*D;
  { __hip_bfloat16*stg=(__hip_bfloat16*)(shm+LDS_OST)+wid*2048;
    #pragma unroll
    for(int r=0;r<16;++r){const int orow=crow(r,hi);
      #pragma unroll
      for(int d0=0;d0<2;++d0)stg[orow*64+d0*32+r32]=__float2bfloat16(o[d0][r]*rli[r]);}
    asm volatile("s_waitcnt lgkmcnt(0)":::"memory");
    #pragma unroll
    for(int i=0;i<4;++i){const int row=i*8+(lane>>3),ch=lane&7; const u32x4 v=*(const u32x4*)(stg+row*64+ch*8); *(u32x4*)(Ow+(long)row*OP+ch*8)=v;} }
  asm volatile("s_waitcnt lgkmcnt(0)\n\ts_barrier":::"memory");
  #undef DMA_K
  #undef DMA_V
  #undef START
  #undef RESC
  #undef ROT
}
#undef SBAR
#undef WAIT_BAR
}

#define XB_TMO      128
#define XB_XCNT(j)  (256  + 64 * (j))
#define XB_XSUB(j)  (1280 + 64 * (j))
#define XB_XGEN(j)  (2304 + 64 * (j))
#define XB_TOP      3328
#define XB_TOPGEN   3392
#define XCD_BAR_WORDS 3456
#define XB_SPIN_CAP (1u << 18)

__device__ __forceinline__ unsigned xb_ld(unsigned* p)              { return __hip_atomic_load(p, __ATOMIC_RELAXED, __HIP_MEMORY_SCOPE_AGENT); }
__device__ __forceinline__ unsigned xb_add(unsigned* p, unsigned v) { return __hip_atomic_fetch_add(p, v, __ATOMIC_RELAXED, __HIP_MEMORY_SCOPE_AGENT); }
__device__ __forceinline__ unsigned xb_xcc_id() { return (unsigned)__builtin_amdgcn_s_getreg((3 << 11) | 20) & 0xFu; }
#define XB_SPIN(cond, bar) do { unsigned _sp = 0; while (cond) { __builtin_amdgcn_s_sleep(1); \
    if ((++_sp & 255u) == 0u) { if (xb_ld(&(bar)[XB_TMO])) break; if (_sp > XB_SPIN_CAP) { atomicAdd(&(bar)[XB_TMO], 1u); break; } } } } while (0)

struct XcdBarrier {
    unsigned* bar; unsigned x;
    volatile LAS unsigned* st;
};

__device__ __forceinline__ XcdBarrier xcd_barrier_post(unsigned* bar, volatile LAS unsigned* st) {
    XcdBarrier b; b.bar = bar; b.x = xb_xcc_id(); b.st = st;
    if (threadIdx.x == 0) (void)xb_add(&bar[XB_XCNT(b.x)], 1u);
    return b;
}
__device__ __forceinline__ void xcd_barrier_complete(unsigned* bar, unsigned x, unsigned& nloc, unsigned& nx) {
    const unsigned G = gridDim.x * gridDim.y * gridDim.z;
    unsigned sum, cnt, mine, sp = 0u;
    for (;;) {
        sum = 0u; cnt = 0u; mine = 0u;
#pragma unroll
        for (unsigned j = 0; j < 16; ++j) { const unsigned c = xb_ld(&bar[XB_XCNT(j)]); sum += c; cnt += (c > 0u) ? 1u : 0u; mine = (j == x) ? c : mine; }
        if (sum == G) break;
        __builtin_amdgcn_s_sleep(1);
        if ((++sp & 255u) == 0u) { if (xb_ld(&bar[XB_TMO])) break; if (sp > XB_SPIN_CAP) { atomicAdd(&bar[XB_TMO], 1u); break; } }
    }
    nloc = mine > 0u ? mine : 1u; nx = cnt > 0u ? cnt : 1u;
}

__device__ __forceinline__ void xcd_barrier(const XcdBarrier& b) {
    asm volatile("s_waitcnt vmcnt(0)" ::: "memory");
    __syncthreads();
    if (threadIdx.x == 0) {
        unsigned* bar = b.bar;
        __builtin_amdgcn_s_waitcnt(0);
        unsigned nloc = b.st[0], nx = b.st[1];
        if (nloc == 0u) { xcd_barrier_complete(bar, b.x, nloc, nx); b.st[0] = nloc; b.st[1] = nx; }
        const unsigned old = xb_add(&bar[XB_XSUB(b.x)], 1u);
        const unsigned gen = old / nloc;
        if (old + 1u == (gen + 1u) * nloc) {
            __builtin_amdgcn_fence(__ATOMIC_RELEASE, "agent");
            asm volatile("s_waitcnt vmcnt(0)" ::: "memory");
            const unsigned og = xb_add(&bar[XB_TOP], 1u);
            const unsigned tg = og / nx;
            if (og + 1u == (tg + 1u) * nx) xb_add(&bar[XB_TOPGEN], 1u);
            else XB_SPIN(xb_ld(&bar[XB_TOPGEN]) == tg, bar);
            __builtin_amdgcn_fence(__ATOMIC_ACQUIRE, "agent");
            xb_add(&bar[XB_XGEN(b.x)], 1u);
            asm volatile("s_waitcnt vmcnt(0)" ::: "memory");
        } else {
            XB_SPIN(xb_ld(&bar[XB_XGEN(b.x)]) == gen, bar);
            __builtin_amdgcn_fence(__ATOMIC_ACQUIRE, "agent");
            asm volatile("s_waitcnt vmcnt(0)" ::: "memory");
        }
    }
    __syncthreads();
}


struct Frame {
    LAS unsigned char* lds;
    int tid, lane, wave;
    int vcu, G;
    unsigned flags;
};
struct Args { const float* in[25]; float* out; unsigned char* ws; unsigned mask, pad; };

__device__ __forceinline__ void p0_transpose_item(const float* W, int K, int N, bf16* WT, int k0, int n0, int v0, LAS float* scr, int lane, const float* ksc = nullptr, int kmode = 0) {
#pragma unroll 8
    for (int i = 0; i < 32; ++i) { const int kk = 2 * i + (lane >> 5); float wv = W[(size_t)(k0 + kk) * N + n0 + (lane & 31)];
        if (ksc) { const float mv = ksc[k0 + kk]; wv *= (kmode == 1) ? (1.0f - mv) : (0.5f * mv); }
        scr[kk * 33 + (lane & 31)] = wv; }
    LDS_WAIT(); asm volatile("" ::: "memory");
    const int c = lane & 7;
#pragma unroll
    for (int j = 0; j < 4; ++j) { const int n = (lane >> 3) + 8 * j; const LAS float* s = scr + (8 * c) * 33 + n;
        v4u o; o.x = pk2(s[0 * 33], s[1 * 33]); o.y = pk2(s[2 * 33], s[3 * 33]); o.z = pk2(s[4 * 33], s[5 * 33]); o.w = pk2(s[6 * 33], s[7 * 33]);
        *(GAS v4u*)(WT + (size_t)(v0 + n) * K + k0 + 8 * c) = o; }
    LDS_WAIT(); asm volatile("" ::: "memory");
}
__device__ __forceinline__ void p0_transpose_item_fp8(const float* W, int K, int N, unsigned char* WT, int k0, int n0, int v0, LAS float* scr, int lane, float sc, bool remap16 = false) {
#pragma unroll 8
    for (int i = 0; i < 32; ++i) { const int kk = 2 * i + (lane >> 5); scr[kk * 33 + (lane & 31)] = W[(size_t)(k0 + kk) * N + n0 + (lane & 31)] * sc; }
    LDS_WAIT(); asm volatile("" ::: "memory");
    const int c = lane & 7;
#pragma unroll
    for (int j = 0; j < 4; ++j) { const int n = (lane >> 3) + 8 * j; const LAS float* s = scr + (8 * c) * 33 + n;
        unsigned w0 = 0u, w1 = 0u;
        w0 = cvt2_fp8(s[0 * 33], s[1 * 33], w0, false); w0 = cvt2_fp8(s[2 * 33], s[3 * 33], w0, true);
        w1 = cvt2_fp8(s[4 * 33], s[5 * 33], w1, false); w1 = cvt2_fp8(s[6 * 33], s[7 * 33], w1, true);
        v2u o; o.x = w0; o.y = w1;
        int vr = v0 + n;
        if (remap16) { const int t = (n0 & 255) + n, wc = t >> 6, fq = (t >> 4) & 3, bj = (t >> 3) & 1; vr = (n0 & ~255) + 128 * bj + 32 * wc + 8 * fq + (t & 7); }
        *(GAS v2u*)(WT + (size_t)vr * K + k0 + 8 * c) = o; }
    LDS_WAIT(); asm volatile("" ::: "memory");
}
__host__ __device__ __forceinline__ int win_virt32(int n0) { const int tile = n0 >> 8, t = n0 & 255, wc = t >> 6, bj = (t >> 5) & 1; return 256 * tile + 128 * bj + 32 * wc; }

__device__ __forceinline__ void p0_prologue(Frame& F, const Args& a) {
    unsigned char* ws = a.ws;
    if (F.vcu < 192) {
        LAS float* st = (LAS float*)F.lds;
        const float* c = a.in[1];
        for (int i = F.tid; i < NB * DM; i += 512) { const float v = c[i]; st[i] = v / (1.0f + __expf(-v)); }
        __syncthreads();
        const int cc = F.tid & 31, kg = F.tid >> 5, col0 = F.vcu * 32;
        const float* wa = a.in[2] + (size_t)(kg * 64) * (6 * DM) + col0 + cc;
        float acc[32];
#pragma unroll
        for (int b = 0; b < 32; ++b) acc[b] = 0.f;
        for (int k = 0; k < 64; ++k) {
            const float wv = wa[(size_t)k * (6 * DM)];
            const LAS float* sp = st + kg * 64 + k;
#pragma unroll
            for (int b = 0; b < 32; ++b) acc[b] += sp[b * DM] * wv;
        }
        __syncthreads();
        LAS float* part = (LAS float*)F.lds;
#pragma unroll
        for (int b = 0; b < 32; ++b) part[(kg * 32 + b) * 32 + cc] = acc[b];
        __syncthreads();
        float* mod = (float*)(ws + WS_MOD);
        for (int o = F.tid; o < 1024; o += 512) { const int b = o >> 5, c2 = o & 31; float s = a.in[3][col0 + c2];
#pragma unroll
            for (int g = 0; g < 16; ++g) s += part[(g * 32 + b) * 32 + c2];
            mod[b * (6 * DM) + col0 + c2] = s; }
        __syncthreads();
    } else {
        float* rope = (float*)(ws + WS_ROPE);
        for (int j = (F.vcu - 192) * 512 + F.tid; j < SEQ * 32; j += 64 * 512) {
            const int t = j >> 5, i = j & 31;
            const float pos = (i < 16) ? (float)(t >> 6) : (float)(t & 63);
            const float freq = powf(10000.0f, -(float)(i & 15) / 16.0f);
            const float ang = pos * freq;
            rope[2 * j] = cosf(ang); rope[2 * j + 1] = sinf(ang);
        }
    }
    LAS float* scr = (LAS float*)(F.lds + F.wave * 16384);
    const int gw = F.vcu * NWAVES + F.wave, NGW = F.G * NWAVES;
    constexpr int I_IN = (DM / 64) * (NIN / 32), I_OUT = (DM / 64) * (DM / 32), I_E = (DM / 64) * (FF / 32), I_GUP = (128 / 64) * (RW / 32);
    constexpr int I_LORA = 6 * (RW / 32);
    constexpr int NITEMS = I_IN + I_OUT + 3 * NE * I_E + I_GUP + I_LORA;
    for (int it = gw; it < NITEMS; it += NGW) {
        int r = it;
        if (r < I_IN) { const int nblk = NIN / 32, kb = r / nblk, nb = r % nblk; p0_transpose_item(a.in[5], DM, NIN, (bf16*)(ws + WS_WIN), 64 * kb, 32 * nb, win_virt32(32 * nb), scr, F.lane); continue; } r -= I_IN;
        if (r < I_OUT) { const int nblk = DM / 32, kb = r / nblk, nb = r % nblk; p0_transpose_item(a.in[19], DM, DM, (bf16*)(ws + WS_WOUT), 64 * kb, 32 * nb, 32 * nb, scr, F.lane); continue; } r -= I_OUT;
        if (r < 3 * NE * I_E) {
            const int mat = r / I_E, rr = r % I_E, which = mat / NE, e = mat % NE; const int nblk = FF / 32, kb = rr / nblk, nb = rr % nblk, n0 = 32 * nb;
            if (which == 0) p0_transpose_item_fp8(a.in[22] + (size_t)e * DM * FF, DM, FF, ws + WS_WGU + (size_t)e * 2 * FF * DM, 64 * kb, n0, 256 * (n0 >> 7) + (n0 & 127), scr, F.lane, 32.0f);
            else if (which == 1) p0_transpose_item_fp8(a.in[23] + (size_t)e * DM * FF, DM, FF, ws + WS_WGU + (size_t)e * 2 * FF * DM, 64 * kb, n0, 256 * (n0 >> 7) + 128 + (n0 & 127), scr, F.lane, 32.0f);
            else p0_transpose_item_fp8(a.in[24] + (size_t)e * FF * DM, FF, DM, ws + WS_WD + (size_t)e * DM * FF, 64 * kb, n0, n0, scr, F.lane, 32.0f, true);
            continue; } r -= 3 * NE * I_E;
        if (r < I_GUP) { const int nblk = RW / 32, kb = r / nblk, nb = r % nblk; p0_transpose_item(a.in[13], 128, RW, (bf16*)(ws + WS_GUPT), 64 * kb, 32 * nb, 32 * nb, scr, F.lane); continue; } r -= I_GUP;
        { const int nblk = RW / 32, md = r / nblk, nb = r % nblk, which = md >> 1, d = md & 1;
          if (which == 0) p0_transpose_item(a.in[10] + (size_t)d * 64 * RW, 64, RW, (bf16*)(ws + WS_WUPT) + (size_t)d * RW * 64, 0, 32 * nb, 32 * nb, scr, F.lane);
          else if (which == 1) p0_transpose_item(a.in[12] + (size_t)d * 64 * RW, 64, RW, (bf16*)(ws + WS_AUPT) + (size_t)d * RW * 64, 0, 32 * nb, 32 * nb, scr, F.lane); }
    }
}

__device__ __forceinline__ void p1_norm(Frame& F, const Args& a) {
    const float* mod = (const float*)(a.ws + WS_MOD); bf16* H = (bf16*)(a.ws + WS_H);
    const int gw = F.vcu * NWAVES + F.wave; const int b = F.vcu >> 3;
    f32x4 gs[4], sh[4];
#pragma unroll
    for (int j = 0; j < 4; ++j) { const int c = 4 * F.lane + 256 * j; const f32x4 g = *(const f32x4*)(a.in[4] + c); const f32x4 sc = *(const f32x4*)(mod + b * 6 * DM + DM + c);
        gs[j] = g * (sc + 1.0f); sh[j] = *(const f32x4*)(mod + b * 6 * DM + c); }
    f32x4 vn[4][4];
#pragma unroll
    for (int r = 0; r < 4; ++r) { const GAS f32x4* xr = (const GAS f32x4*)(a.in[0] + ((size_t)gw * 32 + r) * DM) + F.lane;
#pragma unroll
        for (int j = 0; j < 4; ++j) vn[r][j] = xr[64 * j]; }
    for (int i = 0; i < 32; i += 4) {
        const size_t row = (size_t)gw * 32 + i;
        f32x4 v[4][4]; float s2[4];
#pragma unroll
        for (int r = 0; r < 4; ++r)
#pragma unroll
            for (int j = 0; j < 4; ++j) v[r][j] = vn[r][j];
        if (i + 4 < 32) {
#pragma unroll
            for (int r = 0; r < 4; ++r) { const GAS f32x4* xr = (const GAS f32x4*)(a.in[0] + (row + 4 + r) * DM) + F.lane;
#pragma unroll
                for (int j = 0; j < 4; ++j) vn[r][j] = xr[64 * j]; } }
        asm volatile("" ::: "memory");
#pragma unroll
        for (int r = 0; r < 4; ++r) { float t = 0.f;
#pragma unroll
            for (int j = 0; j < 4; ++j) t += (v[r][j].x * v[r][j].x + v[r][j].y * v[r][j].y) + (v[r][j].z * v[r][j].z + v[r][j].w * v[r][j].w);
            s2[r] = t; }
#pragma unroll
        for (int r = 0; r < 4; ++r) s2[r] = wave_sum(s2[r]);
#pragma unroll
        for (int r = 0; r < 4; ++r) { const float rstd = 1.0f / sqrtf(s2[r] * (1.0f / DM) + NORM_EPS);
            GAS unsigned long long* o8 = (GAS unsigned long long*)(H + (row + r) * DM) + F.lane;
#pragma unroll
            for (int j = 0; j < 4; ++j) { const f32x4 y = v[r][j] * rstd * gs[j] + sh[j]; o8[64 * j] = (unsigned long long)pk2(y.x, y.y) | ((unsigned long long)pk2(y.z, y.w) << 32); } }
    }
}

struct EpiInProj {
    static constexpr bool PERM = true;
    bf16 *Q, *K, *V, *PR; const float *qn, *kn, *rope;
    __device__ __forceinline__ void operator()(const f32x4 (&acc)[2][2][4][2], const pg8::Unit& u, int wr, int wc, int fr, int fq) const {
        { int l_ = threadIdx.x; asm volatile("" : "+v"(l_)); fr = l_ & 15; fq = (l_ >> 4) & 3; }
        const int row0 = u.pm * 256 + wr * 64 + fr;
        if (u.pn >= 3) {
            const int col0 = 256 * (u.pn - 3) + 64 * wc + 8 * fq;
#pragma unroll
            for (int ai = 0; ai < 2; ++ai)
#pragma unroll
                for (int m = 0; m < 4; ++m) { bf16* rowp = PR + (size_t)(row0 + ai * 128 + m * 16) * NSH + col0;
#pragma unroll
                    for (int bj = 0; bj < 2; ++bj) { const f32x4 v0 = acc[ai][bj][m][0], v1 = acc[ai][bj][m][1];
                        v4u w; w.x = pk2(v0[0], v0[1]); w.y = pk2(v0[2], v0[3]); w.z = pk2(v1[0], v1[1]); w.w = pk2(v1[2], v1[3]);
                        *(v4u*)(rowp + 32 * bj) = w; } }
            return;
        }
        const bool isV = (u.pn == 2 && wc >= 2);
        if (isV) {
            const int col0 = 64 * (wc - 2) + 8 * fq;
#pragma unroll
            for (int ai = 0; ai < 2; ++ai)
#pragma unroll
                for (int m = 0; m < 4; ++m) { bf16* rowp = V + (size_t)(row0 + ai * 128 + m * 16) * KVW + col0;
#pragma unroll
                    for (int bj = 0; bj < 2; ++bj) { const f32x4 v0 = acc[ai][bj][m][0], v1 = acc[ai][bj][m][1];
                        v4u w; w.x = pk2(v0[0], v0[1]); w.y = pk2(v0[2], v0[3]); w.z = pk2(v1[0], v1[1]); w.w = pk2(v1[2], v1[3]);
                        *(v4u*)(rowp + 32 * bj) = w; } }
            return;
        }
        const bool isQ = (u.pn < 2);
        const float* gn = isQ ? qn : kn;
        bf16* dst = isQ ? (Q + 64 * (4 * u.pn + wc)) : (K + 64 * wc);
        const int pitch = isQ ? AW : KVW;
        const float osc = isQ ? QSCALE : 1.0f;
        f32x4 gv[2][2];
#pragma unroll
        for (int bj = 0; bj < 2; ++bj)
#pragma unroll
            for (int n = 0; n < 2; ++n) gv[bj][n] = *(const f32x4*)(gn + 32 * bj + 8 * fq + 4 * n);
#pragma unroll
        for (int ai = 0; ai < 2; ++ai) {
            f32x4 csv[4][2][2];
#pragma unroll
            for (int m = 0; m < 4; ++m) { const int t = (row0 + ai * 128 + m * 16) & (SEQ - 1);
#pragma unroll
                for (int bj = 0; bj < 2; ++bj)
#pragma unroll
                    for (int n = 0; n < 2; ++n) csv[m][bj][n] = *(const f32x4*)(rope + ((size_t)t * 32 + 16 * bj + 4 * fq + 2 * n) * 2); }
            asm volatile("" ::: "memory");
#pragma unroll
            for (int m = 0; m < 4; ++m) {
                const int row = row0 + ai * 128 + m * 16;
                float ss = 0.f;
#pragma unroll
                for (int bj = 0; bj < 2; ++bj)
#pragma unroll
                    for (int n = 0; n < 2; ++n) { const f32x4 x = acc[ai][bj][m][n]; ss += (x[0] * x[0] + x[1] * x[1]) + (x[2] * x[2] + x[3] * x[3]); }
                ss = xor32_sum(xor16_sum(ss));
                const float rstd = 1.0f / sqrtf(ss * (1.0f / 64.0f) + NORM_EPS);
                bf16* rowp = dst + (size_t)row * pitch + 8 * fq;
#pragma unroll
                for (int bj = 0; bj < 2; ++bj) {
                    unsigned w[4];
#pragma unroll
                    for (int n = 0; n < 2; ++n) {
                        const f32x4 x = acc[ai][bj][m][n] * rstd * gv[bj][n];
                        const f32x4 cs = csv[m][bj][n];
                        const float o0 = x[0] * cs[0] - x[1] * cs[1], o1 = x[0] * cs[1] + x[1] * cs[0];
                        const float o2 = x[2] * cs[2] - x[3] * cs[3], o3 = x[2] * cs[3] + x[3] * cs[2];
                        w[2 * n] = pk2(o0 * osc, o1 * osc); w[2 * n + 1] = pk2(o2 * osc, o3 * osc);
                    }
                    v4u wv; wv.x = w[0]; wv.y = w[1]; wv.z = w[2]; wv.w = w[3];
                    *(v4u*)(rowp + 32 * bj) = wv;
                }
            }
            asm volatile("" ::: "memory");
        }
    }
};

struct EpiOutProj {
    static constexpr bool PERM = true;
    const float* x; bf16* x1; const float* mod;
    __device__ __forceinline__ void operator()(const f32x4 (&acc)[2][2][4][2], const pg8::Unit& u, int wr, int wc, int fr, int fq) const {
        { int l_ = threadIdx.x; asm volatile("" : "+v"(l_)); fr = l_ & 15; fq = (l_ >> 4) & 3; }
        const int row0 = u.pm * 256 + wr * 64 + fr, col0 = u.pn * 256 + wc * 32 + 8 * fq; const int b = u.pm >> 3;
        f32x4 gt[2][2];
#pragma unroll
        for (int bj = 0; bj < 2; ++bj)
#pragma unroll
            for (int n = 0; n < 2; ++n) gt[bj][n] = *(const f32x4*)(mod + b * 6 * DM + 2 * DM + col0 + bj * 128 + n * 4);
#pragma unroll
        for (int ai = 0; ai < 2; ++ai) {
            f32x4 xv[4][2][2];
#pragma unroll
            for (int m = 0; m < 4; ++m) { const size_t off = (size_t)(row0 + ai * 128 + m * 16) * DM + col0;
#pragma unroll
                for (int bj = 0; bj < 2; ++bj)
#pragma unroll
                    for (int n = 0; n < 2; ++n) xv[m][bj][n] = *(const f32x4*)(x + off + bj * 128 + n * 4); }
            asm volatile("" ::: "memory");
#pragma unroll
            for (int m = 0; m < 4; ++m) { const size_t off = (size_t)(row0 + ai * 128 + m * 16) * DM + col0;
#pragma unroll
                for (int bj = 0; bj < 2; ++bj) { const f32x4 v0 = xv[m][bj][0] + gt[bj][0] * acc[ai][bj][m][0], v1 = xv[m][bj][1] + gt[bj][1] * acc[ai][bj][m][1];
                    v4u w; w.x = pk2(v0[0], v0[1]); w.y = pk2(v0[2], v0[3]); w.z = pk2(v1[0], v1[1]); w.w = pk2(v1[2], v1[3]);
                    *(v4u*)(x1 + off + bj * 128) = w; } }
            asm volatile("" ::: "memory");
        }
    }
};


__device__ __forceinline__ void prs_pass(Frame& F, const Args& a) {
    const bf16* __restrict__ PR = (const bf16*)(a.ws + WS_PR); bf16* __restrict__ RK = (bf16*)(a.ws + WS_RKVS); bf16* __restrict__ TD = (bf16*)(a.ws + WS_TDS);
    const float* __restrict__ mu = a.in[8];
    const int lane = F.lane; const int b = F.vcu >> 3;
    f32x4 mus[7];
#pragma unroll
    for (int cs = 0; cs < 7; ++cs) mus[cs] = *(const f32x4*)(mu + 256 * cs + 4 * lane);
    v2u xn[7][6];
#define PRS_LOAD(G) do { _Pragma("unroll") for (int r = 0; r < 6; ++r) { int t_ = 4 * (G) - 1 + r; t_ = t_ < 0 ? 0 : t_ > SEQ - 1 ? SEQ - 1 : t_; \
            const bf16* rp_ = PR + ((size_t)b * SEQ + t_) * NSH + 4 * lane; _Pragma("unroll") for (int cs = 0; cs < 7; ++cs) xn[cs][r] = *(const v2u*)(rp_ + 256 * cs); } } while (0)
    PRS_LOAD((F.vcu & 7) * 64 + F.wave * 8);
    for (int it = 0; it < 8; ++it) {
        const int g = (F.vcu & 7) * 64 + F.wave * 8 + it;
        const size_t row0 = (size_t)b * SEQ + 4 * g;
        v2u x[7][6];
#pragma unroll
        for (int cs = 0; cs < 7; ++cs)
#pragma unroll
            for (int r = 0; r < 6; ++r) x[cs][r] = xn[cs][r];
        if (it + 1 < 8) PRS_LOAD(g + 1);
        asm volatile("" ::: "memory");
        if (g == 0) {
#pragma unroll
            for (int cs = 0; cs < 7; ++cs) x[cs][0] = (v2u){0u, 0u}; }
        if (g == SEQ / 4 - 1) {
#pragma unroll
            for (int cs = 0; cs < 7; ++cs) x[cs][5] = (v2u){0u, 0u}; }
#pragma unroll
        for (int cs = 0; cs < 7; ++cs) {
            float y[4][4];
#pragma unroll
            for (int e = 0; e < 4; ++e) { const v2u c = x[cs][e + 1], p = x[cs][e], n = x[cs][e + 2];
                const float c0 = bflo(c.x), c1 = bfhi(c.x), c2 = bflo(c.y), c3 = bfhi(c.y);
                y[e][0] = c0 + mus[cs][0] * (0.5f * (bflo(p.x) + bflo(n.x)) - c0); y[e][1] = c1 + mus[cs][1] * (0.5f * (bfhi(p.x) + bfhi(n.x)) - c1);
                y[e][2] = c2 + mus[cs][2] * (0.5f * (bflo(p.y) + bflo(n.y)) - c2); y[e][3] = c3 + mus[cs][3] * (0.5f * (bfhi(p.y) + bfhi(n.y)) - c3); }
            if (cs < 6) {
                bf16* dst = RK + (((size_t)b * (SEQ / 4) + g) * 1536 + 256 * cs + 4 * lane) * 4;
                v4u w0, w1;
                w0.x = pk2(y[0][0], y[1][0]); w0.y = pk2(y[2][0], y[3][0]); w0.z = pk2(y[0][1], y[1][1]); w0.w = pk2(y[2][1], y[3][1]);
                w1.x = pk2(y[0][2], y[1][2]); w1.y = pk2(y[2][2], y[3][2]); w1.z = pk2(y[0][3], y[1][3]); w1.w = pk2(y[2][3], y[3][3]);
                *(v4u*)dst = w0; *(v4u*)(dst + 8) = w1;
            } else {
#pragma unroll
                for (int e = 0; e < 4; ++e) { float o[4];
#pragma unroll
                    for (int j = 0; j < 4; ++j) { const float v = y[e][j]; const float th = 1.0f - 2.0f * __builtin_amdgcn_rcpf(__expf(2.0f * v) + 1.0f), sg = __builtin_amdgcn_rcpf(1.0f + __expf(-v));
                        o[j] = lane < 16 ? th : lane < 32 ? v : sg; }
                    v2u w; w.x = pk2(o[0], o[1]); w.y = pk2(o[2], o[3]);
                    *(v2u*)(TD + (row0 + e) * 256 + 4 * lane) = w; }
            }
        }
    }
}

#undef PRS_LOAD
namespace wkv {
constexpr int SLOT = 12544, O_AT = 0, O_RT = 2048, O_BT = 4096, O_KT = 6144, O_VT = 8192, O_MAK = 10240, O_MTM = 10752, O_MRB = 11264, O_MRK = 11776, O_GC = 12288;
typedef short v4i16_t __attribute__((ext_vector_type(4)));
typedef __bf16 bf16x2_t __attribute__((ext_vector_type(2)));
__device__ __forceinline__ unsigned cvtpk(float lo, float hi) { f32x2 v = {lo, hi}; bf16x2_t b = __builtin_convertvector(v, bf16x2_t); return __builtin_bit_cast(unsigned, b); }
__device__ __forceinline__ v2u pack4(const f32x4 v) { v2u r; r.x = cvtpk(v[0], v[1]); r.y = cvtpk(v[2], v[3]); return r; }
__device__ __forceinline__ bf16x8 frag(v2u lo, v2u hi) { v4u w; w.x = lo.x; w.y = lo.y; w.z = hi.x; w.w = hi.y; return __builtin_bit_cast(bf16x8, w); }
__device__ __forceinline__ bf16x8 frag4(const f32x4 v) { return frag(pack4(v), (v2u){0u, 0u}); }
__device__ __forceinline__ v2u trrd(LAS const unsigned char* p) { return __builtin_bit_cast(v2u, __builtin_amdgcn_ds_read_tr16_b64_v4i16((LAS v4i16_t*)p)); }
__device__ __forceinline__ bf16x8 trop(LAS const unsigned char* arr, int m, int lane) {
    LAS const unsigned char* p = arr + (32 * m + 4 * (lane >> 4) + ((lane & 15) >> 2)) * 32 + (lane & 3) * 8;
    return frag(trrd(p), trrd(p + 16 * 32));
}
#define MFMA16(A, B, C) __builtin_amdgcn_mfma_f32_16x16x32_bf16((A), (B), (C), 0, 0, 0)
__device__ __forceinline__ void up8(const v4u w, float (&o)[8]) { o[0] = bflo(w.x); o[1] = bfhi(w.x); o[2] = bflo(w.y); o[3] = bfhi(w.y); o[4] = bflo(w.z); o[5] = bfhi(w.z); o[6] = bflo(w.w); o[7] = bfhi(w.w); }
__device__ __forceinline__ bf16x8 pack8(const float (&o)[8]) { v4u w; w.x = cvtpk(o[0], o[1]); w.y = cvtpk(o[2], o[3]); w.z = cvtpk(o[4], o[5]); w.w = cvtpk(o[6], o[7]); return __builtin_bit_cast(bf16x8, w); }
__device__ __forceinline__ float dppf(float v, int ctrl_tag);
#define WKV_DPP_ADD(v, CTRL) ((v) + __builtin_bit_cast(float, __builtin_amdgcn_update_dpp(0, __builtin_bit_cast(int, (v)), (CTRL), 0xf, 0xf, false)))
__device__ __forceinline__ float red16(float v) { v = WKV_DPP_ADD(v, 0xB1); v = WKV_DPP_ADD(v, 0x4E); v = WKV_DPP_ADD(v, 0x141); v = WKV_DPP_ADD(v, 0x140); return v; }
__device__ __forceinline__ float fsig(float x) { return __builtin_amdgcn_rcpf(1.0f + __expf(-x)); }
constexpr int NRAW = 10;
constexpr int LORA_OFF = 8 * SLOT + 12 * 64 * 4, LORA_ROW = 144, LORA_TAB = 64 * LORA_ROW;
constexpr int CST_OFF = 8 * SLOT;
__device__ __forceinline__ void prep_load(v4u (&raw)[NRAW], const bf16* RK, const bf16* TD, int b, int h, int dir, int c, int lane) {
    const int kl = lane & 15, q = lane >> 4;
    const int g = dir ? (SEQ / 4 - 1 - (4 * c + q)) : (4 * c + q);
    const bf16* rp = RK + (((size_t)b * (SEQ / 4) + g) * 1536 + 64 * h + kl) * 4;
#pragma unroll
    for (int X = 0; X < 3; ++X)
#pragma unroll
        for (int cp = 0; cp < 2; ++cp) { const v2u lo = *(const v2u*)(rp + (512 * X + 16 * (2 * cp)) * 4), hi = *(const v2u*)(rp + (512 * X + 16 * (2 * cp + 1)) * 4);
            raw[X * 2 + cp] = (v4u){lo.x, lo.y, hi.x, hi.y}; }
    const int s_i = c * 16 + kl; const int t_i = dir ? (SEQ - 1 - s_i) : s_i;
    const bf16* tp = TD + ((size_t)b * SEQ + t_i) * 256 + 8 * q;
#pragma unroll
    for (int m = 0; m < 2; ++m) { raw[6 + m] = *(const v4u*)(tp + 32 * m); raw[8 + m] = *(const v4u*)(tp + 64 + 32 * m); }
}
__device__ __forceinline__ f32x4 up4(unsigned w0, unsigned w1, bool rev) {
    const f32x4 t = (f32x4){bflo(w0), bfhi(w0), bflo(w1), bfhi(w1)};
    return rev ? (f32x4){t[3], t[2], t[1], t[0]} : t;
}

__device__ __forceinline__ void prep(const v4u (&raw)[NRAW], const Args& a, int b, int h, int dir, int c, LAS unsigned char* slot, LAS const float* cst, int lane, bool nostore) {
    const int kl = lane & 15, q = lane >> 4;
    LAS const unsigned char* lw_ = (LAS const unsigned char*)cst + (LORA_OFF - CST_OFF) + dir * 2 * LORA_TAB; LAS const unsigned char* la_ = lw_ + LORA_TAB;
    float* BON = (float*)(a.ws + WS_BON) + (size_t)dir * MT * 8;
    const f32x4 z4 = (f32x4){0.f, 0.f, 0.f, 0.f};
    const bool rev = dir != 0;
    f32x4 wp[4], ap[4], rx[4], kx[4], vx[4];
#pragma unroll
    for (int ct = 0; ct < 4; ++ct) { wp[ct] = z4; ap[ct] = z4;
#pragma unroll
        for (int m = 0; m < 2; ++m) { const int off = (16 * ct + kl) * LORA_ROW + (32 * m + 8 * q) * 2;
            wp[ct] = MFMA16(__builtin_bit_cast(bf16x8, raw[6 + m]), *(const LAS bf16x8*)(lw_ + off), wp[ct]); ap[ct] = MFMA16(__builtin_bit_cast(bf16x8, raw[8 + m]), *(const LAS bf16x8*)(la_ + off), ap[ct]); } }
    if (rev) {
#pragma unroll
        for (int cp = 0; cp < 2; ++cp) {
            rx[2 * cp] = up4(raw[0 + cp].x, raw[0 + cp].y, true); rx[2 * cp + 1] = up4(raw[0 + cp].z, raw[0 + cp].w, true);
            kx[2 * cp] = up4(raw[2 + cp].x, raw[2 + cp].y, true); kx[2 * cp + 1] = up4(raw[2 + cp].z, raw[2 + cp].w, true);
            vx[2 * cp] = up4(raw[4 + cp].x, raw[4 + cp].y, true); vx[2 * cp + 1] = up4(raw[4 + cp].z, raw[4 + cp].w, true); }
    } else {
#pragma unroll
        for (int cp = 0; cp < 2; ++cp) {
            rx[2 * cp] = up4(raw[0 + cp].x, raw[0 + cp].y, false); rx[2 * cp + 1] = up4(raw[0 + cp].z, raw[0 + cp].w, false);
            kx[2 * cp] = up4(raw[2 + cp].x, raw[2 + cp].y, false); kx[2 * cp + 1] = up4(raw[2 + cp].z, raw[2 + cp].w, false);
            vx[2 * cp] = up4(raw[4 + cp].x, raw[4 + cp].y, false); vx[2 * cp + 1] = up4(raw[4 + cp].z, raw[4 + cp].w, false); }
    }
    f32x4 n2 = z4, bsum = z4;
    f32x4 av[4], kd[4];
#pragma unroll
    for (int ct = 0; ct < 4; ++ct) { const int cj = 16 * ct + kl;
        const float a0 = cst[(5 + dir) * 64 + cj], kkg = cst[9 * 64 + cj], kag = cst[10 * 64 + cj], rkg = cst[11 * 64 + cj];
#pragma unroll
        for (int e = 0; e < 4; ++e) { av[ct][e] = fsig(ap[ct][e] + a0); const float kkv = kx[ct][e] * kkg; n2[e] += kkv * kkv;
            kd[ct][e] = kx[ct][e] * (1.0f + (av[ct][e] - 1.0f) * kag); bsum[e] += rx[ct][e] * kd[ct][e] * rkg; } }
#pragma unroll
    for (int e = 0; e < 4; ++e) { n2[e] = red16(n2[e]); bsum[e] = red16(bsum[e]); }
    if (kl == 0 && !nostore) {
        const int s0 = c * 16 + 4 * q; const int t0 = rev ? (SEQ - 1 - s0 - 3) : s0;
        *(f32x4*)(BON + ((size_t)b * 8 + h) * SEQ + t0) = rev ? (f32x4){bsum[3], bsum[2], bsum[1], bsum[0]} : bsum; }
    f32x4 rn;
#pragma unroll
    for (int e = 0; e < 4; ++e) rn[e] = __builtin_amdgcn_rsqf(fmaxf(n2[e], 1e-24f));
#pragma unroll
    for (int ct = 0; ct < 4; ++ct) { const int cj = 16 * ct + kl;
        const float w0 = cst[(7 + dir) * 64 + cj], kkg = cst[9 * 64 + cj];
        f32x4 L, lw;
#pragma unroll
        for (int e = 0; e < 4; ++e) lw[e] = -DECAY_SCALE * fsig(wp[ct][e] + w0);
        L[0] = lw[0]; L[1] = L[0] + lw[1]; L[2] = L[1] + lw[2]; L[3] = L[2] + lw[3];
        const float g = L[3];
        const auto ra = __builtin_amdgcn_permlane16_swap(__float_as_uint(g), __float_as_uint(g), false, false);
        const float pair = __uint_as_float(ra[0]) + __uint_as_float(ra[1]);
        const auto rb = __builtin_amdgcn_permlane32_swap(__float_as_uint(pair), __float_as_uint(pair), false, false);
        const float P = ((q & 1) ? __uint_as_float(ra[0]) : 0.f) + ((q & 2) ? __uint_as_float(rb[0]) : 0.f);
        const float Ltot = __uint_as_float(rb[0]) + __uint_as_float(rb[1]);
        f32x4 ah, bh, kh, rh;
#pragma unroll
        for (int e = 0; e < 4; ++e) { const float Le = L[e] + P; const float ep = __expf(Le), en = __expf(-Le), epv = __expf(Le - lw[e]);
            const float kk = kx[ct][e] * kkg * rn[e];
            ah[e] = -kk * epv; bh[e] = kk * av[ct][e] * en; kh[e] = kd[ct][e] * en; rh[e] = rx[ct][e] * ep; }
        const int ro = (16 * ct + kl) * 32 + q * 8;
        *(LAS v2u*)(slot + O_AT + ro) = pack4(ah); *(LAS v2u*)(slot + O_BT + ro) = pack4(bh); *(LAS v2u*)(slot + O_KT + ro) = pack4(kh); *(LAS v2u*)(slot + O_RT + ro) = pack4(rh);
        *(LAS v2u*)(slot + O_VT + ro) = pack4(vx[ct]);
        if (q == 0) *(LAS float*)(slot + O_GC + (16 * ct + kl) * 4) = __expf(Ltot);
    }
    LDS_WAIT();
    f32x4 OA = z4, OAT = z4, OAK = z4, ORB = z4, ORK = z4;
#pragma unroll
    for (int m = 0; m < 2; ++m) { const bf16x8 tA = trop(slot + O_AT, m, lane), tB = trop(slot + O_BT, m, lane), tK = trop(slot + O_KT, m, lane), tR = trop(slot + O_RT, m, lane);
        OA = MFMA16(tA, tB, OA); OAT = MFMA16(tB, tA, OAT); OAK = MFMA16(tK, tA, OAK); ORB = MFMA16(tB, tR, ORB); ORK = MFMA16(tK, tR, ORK); }
    f32x4 Z;
#pragma unroll
    for (int e = 0; e < 4; ++e) { const int rr = 4 * q + e;
        OA[e] = (kl < rr) ? OA[e] : 0.f;
        OAT[e] = (rr < kl) ? OAT[e] : 0.f;
        OAK[e] = (rr < kl) ? OAK[e] : 0.f; ORB[e] = (rr <= kl) ? ORB[e] : 0.f; ORK[e] = (rr <= kl) ? ORK[e] : 0.f;
        Z[e] = OAT[e] + ((rr == kl) ? 1.0f : 0.f); }
    *(LAS v2u*)(slot + O_MAK + lane * 8) = pack4(OAK); *(LAS v2u*)(slot + O_MRB + lane * 8) = pack4(ORB); *(LAS v2u*)(slot + O_MRK + lane * 8) = pack4(ORK);
    const bf16x8 pA = frag4(OA), pAT = frag4(OAT);
    const f32x4 OA2 = MFMA16(pAT, pA, z4), OA2T = MFMA16(pA, pAT, z4);
    const bf16x8 pA2 = frag4(OA2), pA2T = frag4(OA2T);
    const f32x4 OA4 = MFMA16(pA2T, pA2, z4), OA4T = MFMA16(pA2, pA2T, z4);
    const bf16x8 pA4 = frag4(OA4), pA4T = frag4(OA4T);
    const f32x4 OA8 = MFMA16(pA4T, pA4, z4);
    Z = MFMA16(pA2, frag4(Z), Z);
    Z = MFMA16(pA4, frag4(Z), Z);
    Z = MFMA16(frag4(OA8), frag4(Z), Z);
    *(LAS v2u*)(slot + O_MTM + lane * 8) = pack4(Z);
}

__device__ __forceinline__ void scan_chunk(f32x4 (&acc)[4], LAS const unsigned char* slot, int vs, int lane, bf16* Ygrp, bool rev, bool nostore) {
    const int kl = lane & 15, q = lane >> 4;
    const f32x4 z4 = (f32x4){0.f, 0.f, 0.f, 0.f}; const v2u z2 = (v2u){0u, 0u};
    const bf16x8 Sb0 = frag(pack4(acc[0]), pack4(acc[1])), Sb1 = frag(pack4(acc[2]), pack4(acc[3]));
    const v2u Vv = *(const LAS v2u*)(slot + O_VT + (16 * vs + kl) * 32 + q * 8);
    f32x4 X = MFMA16(frag(*(const LAS v2u*)(slot + O_MAK + lane * 8), z2), frag(Vv, z2), z4);
    X = MFMA16(trop(slot + O_AT, 0, lane), Sb0, X); X = MFMA16(trop(slot + O_AT, 1, lane), Sb1, X);
    const f32x4 Ut = MFMA16(frag(*(const LAS v2u*)(slot + O_MTM + lane * 8), z2), frag4(X), z4);
    const bf16x8 UV = frag(pack4(Ut), Vv);
    f32x4 Yt = MFMA16(trop(slot + O_RT, 0, lane), Sb0, z4); Yt = MFMA16(trop(slot + O_RT, 1, lane), Sb1, Yt);
    Yt = MFMA16(frag(*(const LAS v2u*)(slot + O_MRB + lane * 8), *(const LAS v2u*)(slot + O_MRK + lane * 8)), UV, Yt);
    if (!nostore) { v2u w; if (rev) { w.x = cvtpk(Yt[3], Yt[2]); w.y = cvtpk(Yt[1], Yt[0]); } else { w.x = cvtpk(Yt[0], Yt[1]); w.y = cvtpk(Yt[2], Yt[3]); } *(v2u*)Ygrp = w; }
#pragma unroll
    for (int kt = 0; kt < 4; ++kt) {
        const int ro = (16 * kt + kl) * 32 + q * 8;
        acc[kt] = MFMA16(frag(*(const LAS v2u*)(slot + O_BT + ro), *(const LAS v2u*)(slot + O_KT + ro)), UV, acc[kt]);
        acc[kt] = acc[kt] * *(const LAS f32x4*)(slot + O_GC + (16 * kt + 4 * q) * 4);
    }
}

__device__ __forceinline__ void phase(Frame& F, const Args& a) {
    const int b = F.vcu >> 3, h = F.vcu & 7; const int w = F.wave, lane = F.lane;
    const int dir = w >> 2, vs = w & 3;
    LAS unsigned char* slots = F.lds;
    LAS float* cst = (LAS float*)(F.lds + CST_OFF);
    for (int idx = F.tid; idx < 12 * 64; idx += 512) { const int arr = idx >> 6, j = idx & 63; float v = 0.f;
        if (arr < 5) v = 0.f;
        else if (arr < 7) v = a.in[11][(arr - 5) * RW + 64 * h + j];
        else if (arr < 9) v = a.in[9][(arr - 7) * RW + 64 * h + j];
        else v = a.in[14 + (arr - 9)][64 * h + j];
        cst[idx] = v; }
    {
        const bf16* WU = (const bf16*)(a.ws + WS_WUPT); const bf16* AU = (const bf16*)(a.ws + WS_AUPT);
        for (int idx = F.tid; idx < 4 * 64 * 8; idx += 512) { const int ch16 = idx & 7, row = (idx >> 3) & 63, tb = idx >> 9; const int d = tb >> 1;
            const bf16* src = ((tb & 1) ? AU : WU) + ((size_t)d * RW + 64 * h + row) * 64 + 8 * ch16;
            *(LAS v4u*)(F.lds + LORA_OFF + tb * LORA_TAB + row * LORA_ROW + ch16 * 16) = *(const v4u*)src; }
    }
    const bf16* RK = (const bf16*)(a.ws + WS_RKVS); const bf16* TD = (const bf16*)(a.ws + WS_TDS);
    bf16* Y = (bf16*)(a.ws + (dir ? WS_YB : WS_YF)) + ((size_t)b * 8 + h) * (SEQ / 4) * 64 * 4;
    f32x4 acc[4];
#pragma unroll
    for (int kt = 0; kt < 4; ++kt) acc[kt] = (f32x4){0.f, 0.f, 0.f, 0.f};
    const bool f_noscan = (F.flags >> 18) & 1u, f_noprep = (F.flags >> 19) & 1u, f_nostore = (F.flags >> 20) & 1u;
    v4u raw[NRAW];
    prep_load(raw, RK, TD, b, h, dir, vs, lane);
    LDS_WAIT(); __builtin_amdgcn_s_barrier(); asm volatile("" ::: "memory");
    for (int R = 0; R < SEQ / 64; ++R) {
        if (!f_noprep) prep(raw, a, b, h, dir, 4 * R + vs, slots + w * SLOT, cst, lane, f_nostore);
        else { unsigned x = 0;
#pragma unroll
            for (int i = 0; i < NRAW; ++i) x ^= raw[i].x ^ raw[i].y ^ raw[i].z ^ raw[i].w;
            asm volatile("" :: "v"(x)); }
        LDS_WAIT(); __builtin_amdgcn_s_barrier(); asm volatile("" ::: "memory");
        if (R + 1 < SEQ / 64) prep_load(raw, RK, TD, b, h, dir, 4 * (R + 1) + vs, lane);
        asm volatile("" ::: "memory");
        if (!f_noscan)
        for (int ci = 0; ci < 4; ++ci) {
            const int c = 4 * R + ci; const int g = dir ? (SEQ / 4 - 1 - (4 * c + (lane >> 4))) : (4 * c + (lane >> 4));
            scan_chunk(acc, slots + (dir * 4 + ci) * SLOT, vs, lane, Y + ((size_t)g * 64 + 16 * vs + (lane & 15)) * 4, dir != 0, f_nostore);
        }
        LDS_WAIT(); __builtin_amdgcn_s_barrier(); asm volatile("" ::: "memory");
    }
    if (f_nostore) { asm volatile("" :: "v"(acc[0]), "v"(acc[1]), "v"(acc[2]), "v"(acc[3])); }
}
#undef MFMA16
}

__device__ __forceinline__ void p4_finalize(Frame& F, const Args& a) {
    const bf16* __restrict__ RK = (const bf16*)(a.ws + WS_RKVS); const bf16* __restrict__ TD = (const bf16*)(a.ws + WS_TDS); const bf16* __restrict__ GT = (const bf16*)(a.ws + WS_GUPT);
    const bf16* __restrict__ YF = (const bf16*)(a.ws + WS_YF); const bf16* __restrict__ YB = (const bf16*)(a.ws + WS_YB);
    const float* __restrict__ BON = (const float*)(a.ws + WS_BON); bf16* __restrict__ MIX = (bf16*)(a.ws + WS_MIX);
    const float* __restrict__ ln_w = a.in[17]; const float* __restrict__ ln_b = a.in[18];
    const int gw = F.vcu * NWAVES + F.wave; const int kl = F.lane & 15, q = F.lane >> 4; const int b = F.vcu >> 3;
    LAS unsigned char* stg = F.lds + F.wave * (16 * 1040);
    for (int i = 0; i < 2; ++i) {
        const size_t row0 = (size_t)(gw * 2 + i) * 16; const int t0 = (int)(row0 & (SEQ - 1)); const int g = (t0 >> 2) + q;
        bf16x8 sg[4];
#pragma unroll
        for (int ks = 0; ks < 4; ++ks) sg[ks] = *(const bf16x8*)(TD + (row0 + kl) * 256 + 128 + 32 * ks + 8 * q);
        v2u n_yf[4], n_yb[4], n_vv[4]; f32x4 n_bf, n_bb; float n_lw[4], n_lb[4]; bf16x8 n_gt[4][4];
#define P4_LOAD(HH) do { _Pragma("unroll") for (int ct = 0; ct < 4; ++ct) { const int ch_ = 64 * (HH) + 16 * ct + kl; \
            const size_t yo_ = ((((size_t)b * 8 + (HH)) * (SEQ / 4) + g) * 64 + 16 * ct + kl) * 4; \
            n_yf[ct] = *(const v2u*)(YF + yo_); n_yb[ct] = *(const v2u*)(YB + yo_); \
            n_vv[ct] = *(const v2u*)(RK + (((size_t)b * (SEQ / 4) + g) * 1536 + 1024 + ch_) * 4); n_lw[ct] = ln_w[ch_]; n_lb[ct] = ln_b[ch_]; \
            _Pragma("unroll") for (int ks = 0; ks < 4; ++ks) n_gt[ct][ks] = *(const bf16x8*)(GT + (size_t)ch_ * 128 + 32 * ks + 8 * q); } \
            const size_t bo_ = ((size_t)b * 8 + (HH)) * SEQ + t0 + 4 * q; n_bf = *(const f32x4*)(BON + bo_); n_bb = *(const f32x4*)(BON + (size_t)MT * 8 + bo_); } while (0)
        P4_LOAD(0);
#pragma clang loop unroll(disable)
        for (int hh = 0; hh < 8; ++hh) {
            f32x4 acc[4], y[4], vs[4]; float lw[4], lb[4];
#pragma unroll
            for (int ct = 0; ct < 4; ++ct) {
                y[ct] = (f32x4){bflo(n_yf[ct].x) + bflo(n_yb[ct].x), bfhi(n_yf[ct].x) + bfhi(n_yb[ct].x), bflo(n_yf[ct].y) + bflo(n_yb[ct].y), bfhi(n_yf[ct].y) + bfhi(n_yb[ct].y)};
                vs[ct] = (f32x4){bflo(n_vv[ct].x), bfhi(n_vv[ct].x), bflo(n_vv[ct].y), bfhi(n_vv[ct].y)}; lw[ct] = n_lw[ct]; lb[ct] = n_lb[ct]; }
            const f32x4 bon = n_bf + n_bb;
#pragma unroll
            for (int ct = 0; ct < 4; ++ct) { acc[ct] = (f32x4){0.f, 0.f, 0.f, 0.f};
#pragma unroll
                for (int ks = 0; ks < 4; ++ks) acc[ct] = __builtin_amdgcn_mfma_f32_16x16x32_bf16(sg[ks], n_gt[ct][ks], acc[ct], 0, 0, 0); }
            if (hh + 1 < 8) P4_LOAD(hh + 1);
            f32x4 sm = (y[0] + y[1]) + (y[2] + y[3]);
#pragma unroll
            for (int e = 0; e < 4; ++e) sm[e] = wkv::red16(sm[e]);
            const f32x4 mean = sm * (1.0f / 64.0f); f32x4 vq = (f32x4){0.f, 0.f, 0.f, 0.f};
#pragma unroll
            for (int ct = 0; ct < 4; ++ct) { y[ct] = y[ct] - mean; vq += y[ct] * y[ct]; }
            f32x4 rstd;
#pragma unroll
            for (int e = 0; e < 4; ++e) rstd[e] = __builtin_amdgcn_rsqf(wkv::red16(vq[e]) * (1.0f / 64.0f) + GN_EPS);
#pragma unroll
            for (int ct = 0; ct < 4; ++ct) { const f32x4 o = ((y[ct] * rstd) * lw[ct] + lb[ct] + vs[ct] * bon) * acc[ct];
#pragma unroll
                for (int e = 0; e < 4; ++e) *(LAS unsigned short*)(stg + (4 * q + e) * 1040 + (64 * hh + 16 * ct + kl) * 2) = (unsigned short)f2bf(o[e]); }
        }
#undef P4_LOAD
        LDS_WAIT();
#pragma unroll
        for (int r = 0; r < 16; ++r) { const v4u w = *(const LAS v4u*)(stg + r * 1040 + F.lane * 16); *(v4u*)(MIX + (row0 + r) * DM + 512 + F.lane * 8) = w; }
        LDS_WAIT();
    }
}

__device__ __forceinline__ void p6_norm_router(Frame& F, const Args& a) {
    LAS float* wr = (LAS float*)F.lds;
    for (int i = F.tid; i < DM * NE; i += 512) { const int k = i >> 4, e = i & 15; wr[e * DM + k] = a.in[21][i]; }
    __syncthreads();
    const float* mod = (const float*)(a.ws + WS_MOD); unsigned char* H2 = a.ws + WS_H; float* AFF = (float*)(a.ws + WS_AFF);
    const int gw = F.vcu * NWAVES + F.wave; const int b = F.vcu >> 3; const int lane = F.lane;
    f32x4 gs[4], sh[4];
#pragma unroll
    for (int j = 0; j < 4; ++j) { const int c = 4 * lane + 256 * j; const f32x4 g = *(const f32x4*)(a.in[20] + c); const f32x4 sc = *(const f32x4*)(mod + b * 6 * DM + 4 * DM + c);
        gs[j] = g * (sc + 1.0f); sh[j] = *(const f32x4*)(mod + b * 6 * DM + 3 * DM + c); }
    const bf16* X1 = (const bf16*)(a.ws + WS_X1);
    v2u vn[4];
    { const GAS v2u* xr = (const GAS v2u*)(X1 + (size_t)gw * 32 * DM) + lane;
#pragma unroll
      for (int j = 0; j < 4; ++j) vn[j] = xr[64 * j]; }
    for (int i = 0; i < 32; ++i) {
        const size_t row = (size_t)gw * 32 + i;
        f32x4 v[4]; float s2 = 0.f;
#pragma unroll
        for (int j = 0; j < 4; ++j) { v[j] = (f32x4){bflo(vn[j].x), bfhi(vn[j].x), bflo(vn[j].y), bfhi(vn[j].y)}; s2 += (v[j].x * v[j].x + v[j].y * v[j].y) + (v[j].z * v[j].z + v[j].w * v[j].w); }
        if (i + 1 < 32) { const GAS v2u* xr = (const GAS v2u*)(X1 + (row + 1) * DM) + lane;
#pragma unroll
            for (int j = 0; j < 4; ++j) vn[j] = xr[64 * j]; }
        asm volatile("" ::: "memory");
        const float rstd = 1.0f / sqrtf(wave_sum(s2) * (1.0f / DM) + NORM_EPS);
        GAS unsigned* o4 = (GAS unsigned*)(H2 + row * DM) + lane;
#pragma unroll
        for (int j = 0; j < 4; ++j) { v[j] = v[j] * rstd * gs[j] + sh[j]; unsigned w = 0u;
            w = cvt2_fp8(v[j].x * 4.0f, v[j].y * 4.0f, w, false); w = cvt2_fp8(v[j].z * 4.0f, v[j].w * 4.0f, w, true); o4[64 * j] = w; }
        float d[16];
#pragma unroll
        for (int e = 0; e < 16; ++e) { float acc = 0.f;
#pragma unroll
            for (int j = 0; j < 4; ++j) { const f32x4 w = *(const LAS f32x4*)(wr + e * DM + 4 * lane + 256 * j); acc += (v[j].x * w.x + v[j].y * w.y) + (v[j].z * w.z + v[j].w * w.w); }
            d[e] = acc; asm volatile("" ::: "memory"); }
#pragma unroll
        for (int k = 0; k < 8; ++k) { auto r = __builtin_amdgcn_permlane32_swap(__float_as_uint(d[k]), __float_as_uint(d[k + 8]), false, false); d[k] = __uint_as_float(r[0]) + __uint_as_float(r[1]); }
#pragma unroll
        for (int k = 0; k < 4; ++k) { auto r = __builtin_amdgcn_permlane16_swap(__float_as_uint(d[k]), __float_as_uint(d[k + 4]), false, false); d[k] = __uint_as_float(r[0]) + __uint_as_float(r[1]); }
        { const bool up = (lane & 8) != 0;
#pragma unroll
          for (int k = 0; k < 2; ++k) { const float send = up ? d[k] : d[k + 2], keep = up ? d[k + 2] : d[k];
              d[k] = keep + __builtin_bit_cast(float, __builtin_amdgcn_update_dpp(0, __builtin_bit_cast(int, send), 0x128, 0xf, 0xf, false)); } }
        { const bool up = (lane & 4) != 0; const float send = up ? d[0] : d[1], keep = up ? d[1] : d[0]; d[0] = keep + __shfl_xor(send, 4); }
        float lg = d[0]; lg = DPP_ADD(lg, 0x4E); lg = DPP_ADD(lg, 0xB1);
        float mx = lg;
        mx = fmaxf(mx, __shfl_xor(mx, 4)); mx = fmaxf(mx, __builtin_bit_cast(float, __builtin_amdgcn_update_dpp(0, __builtin_bit_cast(int, mx), 0x128, 0xf, 0xf, false)));
        { auto r = __builtin_amdgcn_permlane16_swap(__float_as_uint(mx), __float_as_uint(mx), false, false); mx = fmaxf(__uint_as_float(r[0]), __uint_as_float(r[1])); }
        { auto r = __builtin_amdgcn_permlane32_swap(__float_as_uint(mx), __float_as_uint(mx), false, false); mx = fmaxf(__uint_as_float(r[0]), __uint_as_float(r[1])); }
        const float pe = expf(lg - mx); float sm = pe;
        sm += __shfl_xor(sm, 4); sm = DPP_ADD(sm, 0x128); sm = xor32_sum(xor16_sum(sm));
        if ((lane & 3) == 0) AFF[((size_t)b * NE + (lane >> 2)) * SEQ + (row & (SEQ - 1))] = pe / sm;
    }
    __syncthreads();
}

__device__ __forceinline__ void p7_topk_gather(Frame& F, const Args& a) {
    LAS unsigned* red = (LAS unsigned*)F.lds;
    const float* AFF = (const float*)(a.ws + WS_AFF); int* IDX = (int*)(a.ws + WS_IDX); float* VAL = (float*)(a.ws + WS_VAL); int* INV = (int*)(a.ws + WS_INV);
    const int tid = F.tid, lane = F.lane, wave = F.wave;
    f32x4 v[2]; unsigned u[2][4], T[2] = {0u, 0u};
#pragma unroll
    for (int pr = 0; pr < 2; ++pr) { v[pr] = *(const f32x4*)(AFF + (size_t)(F.vcu * 2 + pr) * SEQ + 4 * tid);
#pragma unroll
        for (int j = 0; j < 4; ++j) u[pr][j] = __float_as_uint(v[pr][j]); }
    int par = 0;
    for (int bit = 30; bit >= 0; --bit) {
        unsigned cand[2];
#pragma unroll
        for (int pr = 0; pr < 2; ++pr) { cand[pr] = T[pr] | (1u << bit);
            const int c = __builtin_popcountll(__ballot(u[pr][0] >= cand[pr])) + __builtin_popcountll(__ballot(u[pr][1] >= cand[pr])) + __builtin_popcountll(__ballot(u[pr][2] >= cand[pr])) + __builtin_popcountll(__ballot(u[pr][3] >= cand[pr]));
            if (lane == 0) red[(par * 2 + pr) * 8 + wave] = (unsigned)c; }
        __syncthreads();
#pragma unroll
        for (int pr = 0; pr < 2; ++pr) { unsigned tot = 0;
#pragma unroll
            for (int w = 0; w < 8; ++w) tot += red[(par * 2 + pr) * 8 + w];
            if (tot >= (unsigned)CAP) T[pr] = cand[pr]; }
        par ^= 1;
    }
    int pk[2], inc[2];
#pragma unroll
    for (int pr = 0; pr < 2; ++pr) {
        const int cg = (u[pr][0] > T[pr]) + (u[pr][1] > T[pr]) + (u[pr][2] > T[pr]) + (u[pr][3] > T[pr]), ce = (u[pr][0] == T[pr]) + (u[pr][1] == T[pr]) + (u[pr][2] == T[pr]) + (u[pr][3] == T[pr]);
        pk[pr] = cg | (ce << 16); inc[pr] = pk[pr];
#pragma unroll
        for (int o = 1; o < 64; o <<= 1) { const int n = __shfl_up(inc[pr], o); if (lane >= o) inc[pr] += n; }
        if (lane == 63) red[64 + 16 * pr + wave] = (unsigned)inc[pr]; }
    __syncthreads();
#pragma unroll
    for (int pr = 0; pr < 2; ++pr) {
        const int p = F.vcu * 2 + pr; const int b = p >> 4, e = p & 15;
        int base = 0, total = 0;
#pragma unroll
        for (int w = 0; w < 8; ++w) { const int tw = (int)red[64 + 16 * pr + w]; if (w < wave) base += tw; total += tw; }
        const int excl = base + inc[pr] - pk[pr];
        int gtb = excl & 0xffff, eqb = excl >> 16; const int need_eq = CAP - (total & 0xffff);
#pragma unroll
        for (int j = 0; j < 4; ++j) {
            const bool g = u[pr][j] > T[pr], q = u[pr][j] == T[pr]; const bool sel = g || (q && eqb < need_eq);
            const int slot = gtb + (eqb < need_eq ? eqb : need_eq); const int t = 4 * tid + j;
            if (sel) { IDX[p * CAP + slot] = t; VAL[p * CAP + slot] = v[pr][j]; }
            INV[((size_t)b * SEQ + t) * NE + e] = sel ? slot : -1;
            gtb += g ? 1 : 0; eqb += q ? 1 : 0;
        }
    }
    __syncthreads();
}

struct GuOrder { int vcu; const LAS unsigned short* lidx;
    static constexpr bool GATHER = true;
    __device__ __forceinline__ unsigned a_base(const pg8::Unit& u) const { return (unsigned)(u.pm >> 4) * (unsigned)(SEQ * DM); }
    __device__ __forceinline__ void rows(const pg8::Unit& u, unsigned (&g)[2][2]) const {
        int tid = threadIdx.x; asm volatile("" : "+v"(tid));
#pragma unroll
        for (int i = 0; i < 2; ++i) { int R, C; pg8::stage_rc(tid * 16 + i * 8192, R, C);
#pragma unroll
            for (int h = 0; h < 2; ++h) g[h][i] = (unsigned)lidx[(u.pm & 15) * CAP + 128 * h + R] * (unsigned)DM + (unsigned)C * 2u; } }
    __device__ __forceinline__ bool next(int i, pg8::Unit& u) const { if (i >= NE) return false; const int b = vcu >> 3, pn = vcu & 7; u.pm = b * NE + i; u.pn = pn; u.bt = i * 8 + pn; return true; } };
struct DownOrder { int vcu; static constexpr bool GATHER = false;
    __device__ __forceinline__ bool next(int i, pg8::Unit& u) const { if (i >= NE / 2) return false; const int b = vcu >> 3, j = vcu & 7, e = 2 * i + (j >> 2); u.pm = b * NE + e; u.pn = j & 3; u.bt = e * 4 + (j & 3); return true; } };
struct EpiSwiGLU {
    static constexpr bool PERM = true;
    unsigned char* HID;
    __device__ __forceinline__ void operator()(const f32x4 (&acc)[2][2][4][2], const pg8::Unit& u, int wr, int wc, int fr, int fq) const {
        { int l_ = threadIdx.x; asm volatile("" : "+v"(l_)); fr = l_ & 15; fq = (l_ >> 4) & 3; }
        const int row0 = u.pm * 256 + wr * 64 + fr, col0 = u.pn * 128 + wc * 32 + 8 * fq;
        const __amdgpu_buffer_rsrc_t hrs = __builtin_amdgcn_make_buffer_rsrc((void*)HID, 0, 0x7fffffff, 0x00020000);
#pragma unroll
        for (int ai = 0; ai < 2; ++ai)
#pragma unroll
            for (int m = 0; m < 4; ++m) {
                unsigned w[2];
#pragma unroll
                for (int n = 0; n < 2; ++n) { const f32x4 g = acc[ai][0][m][n], up = acc[ai][1][m][n]; f32x4 h;
#pragma unroll
                    for (int e = 0; e < 4; ++e) { const float gg = g[e] * (1.0f / 128.0f); h[e] = gg * __builtin_amdgcn_rcpf(1.0f + __expf(-gg)) * up[e] * (8.0f / 128.0f); }
                    unsigned x = 0u; x = cvt2_fp8(h[0], h[1], x, false); x = cvt2_fp8(h[2], h[3], x, true); w[n] = x; }
                v2u wv; wv.x = w[0]; wv.y = w[1];
                __builtin_amdgcn_raw_buffer_store_b64(wv, hrs, (unsigned)(row0 + ai * 128 + m * 16) * (unsigned)FF + (unsigned)col0, 0, 0);
            }
    }
};
struct EpiDown {
    static constexpr bool PERM = true;
    unsigned char* Y; const float* VAL; const float* mod;
    __device__ __forceinline__ void operator()(const f32x4 (&acc)[2][2][4][2], const pg8::Unit& u, int wr, int wc, int fr, int fq) const {
        { int l_ = threadIdx.x; asm volatile("" : "+v"(l_)); fr = l_ & 15; fq = (l_ >> 4) & 3; }
        const int row0 = u.pm * 256 + wr * 64 + fr, col0 = u.pn * 256 + wc * 64 + 16 * fq; const int b = u.pm >> 4;
        f32x4 gt[2][2];
#pragma unroll
        for (int bj = 0; bj < 2; ++bj)
#pragma unroll
            for (int n = 0; n < 2; ++n) gt[bj][n] = *(const f32x4*)(mod + b * 6 * DM + 5 * DM + col0 + 8 * bj + 4 * n);
        const __amdgpu_buffer_rsrc_t yrs = __builtin_amdgcn_make_buffer_rsrc((void*)Y, 0, 0x7fffffff, 0x00020000);
        float vls[2][4];
#pragma unroll
        for (int ai = 0; ai < 2; ++ai)
#pragma unroll
            for (int m = 0; m < 4; ++m) vls[ai][m] = VAL[row0 + ai * 128 + m * 16] * (64.0f / 256.0f);
#pragma unroll
        for (int ai = 0; ai < 2; ++ai)
#pragma unroll
            for (int m = 0; m < 4; ++m) { const int row = row0 + ai * 128 + m * 16; const float vl = vls[ai][m];
                unsigned w[4];
#pragma unroll
                for (int bj = 0; bj < 2; ++bj)
#pragma unroll
                    for (int n = 0; n < 2; ++n) { const f32x4 v = acc[ai][bj][m][n] * gt[bj][n] * vl; unsigned x = 0u;
                        x = cvt2_fp8(v[0], v[1], x, false); x = cvt2_fp8(v[2], v[3], x, true); w[2 * bj + n] = x; }
                v4u wv; wv.x = w[0]; wv.y = w[1]; wv.z = w[2]; wv.w = w[3];
                __builtin_amdgcn_raw_buffer_store_b128(wv, yrs, (unsigned)row * (unsigned)DM + (unsigned)col0, 0, 0); }
    }
};

__device__ __forceinline__ void p10_combine(Frame& F, const Args& a) {
    const int* INV = (const int*)(a.ws + WS_INV); const unsigned char* Y = a.ws + WS_Y;
    const int gw = F.vcu * NWAVES + F.wave; const int b = F.vcu >> 3; const int lane = F.lane;
    const bool nostore = (F.flags >> 20) & 1u;
    int inv_n[2];
#pragma unroll
    for (int r = 0; r < 2; ++r) inv_n[r] = INV[((size_t)gw * 32 + r) * NE + (lane & 15)];
    const bf16* X1 = (const bf16*)(a.ws + WS_X1);
    v2u vnx[2][4];
#pragma unroll
    for (int r = 0; r < 2; ++r) { const GAS v2u* xr = (const GAS v2u*)(X1 + ((size_t)gw * 32 + r) * DM) + lane;
#pragma unroll
        for (int j = 0; j < 4; ++j) vnx[r][j] = xr[64 * j]; }
    for (int i = 0; i < 32; i += 2) {
        const size_t row = (size_t)gw * 32 + i;
        int inv[2]; inv[0] = inv_n[0]; inv[1] = inv_n[1];
        if (i + 2 < 32) {
#pragma unroll
            for (int r = 0; r < 2; ++r) inv_n[r] = INV[(row + 2 + r) * NE + (lane & 15)]; }
        f32x4 v[2][4];
#pragma unroll
        for (int r = 0; r < 2; ++r)
#pragma unroll
            for (int j = 0; j < 4; ++j) v[r][j] = (f32x4){bflo(vnx[r][j].x), bfhi(vnx[r][j].x), bflo(vnx[r][j].y), bfhi(vnx[r][j].y)};
        if (i + 2 < 32) {
#pragma unroll
            for (int r = 0; r < 2; ++r) { const GAS v2u* xr = (const GAS v2u*)(X1 + (row + 2 + r) * DM) + lane;
#pragma unroll
                for (int j = 0; j < 4; ++j) vnx[r][j] = xr[64 * j]; } }
        unsigned m0 = (unsigned)(__ballot(inv[0] >= 0) & 0xffffull), m1 = (unsigned)(__ballot(inv[1] >= 0) & 0xffffull);
        while (m0 | m1) {
            unsigned w[2][3][4]; bool hit[2][3];
#pragma unroll
            for (int r = 0; r < 2; ++r)
#pragma unroll
                for (int k = 0; k < 3; ++k) { unsigned& mm = r ? m1 : m0; hit[r][k] = mm != 0u;
                    if (hit[r][k]) { const int e = __builtin_ctz(mm); mm &= mm - 1u; const int sl = __builtin_amdgcn_readlane(inv[r], e);
                        const unsigned char* yr = Y + ((size_t)(b * NE + e) * CAP + sl) * DM + 4 * lane;
#pragma unroll
                        for (int j = 0; j < 4; ++j) w[r][k][j] = *(const unsigned*)(yr + 256 * j); } }
#pragma unroll
            for (int r = 0; r < 2; ++r)
#pragma unroll
                for (int k = 0; k < 3; ++k) if (hit[r][k]) {
#pragma unroll
                    for (int j = 0; j < 4; ++j) { const f32x2 lo = __builtin_amdgcn_cvt_pk_f32_fp8(w[r][k][j], false), hi = __builtin_amdgcn_cvt_pk_f32_fp8(w[r][k][j], true);
                        v[r][j].x += lo.x * (1.0f / 64.0f); v[r][j].y += lo.y * (1.0f / 64.0f); v[r][j].z += hi.x * (1.0f / 64.0f); v[r][j].w += hi.y * (1.0f / 64.0f); } }
        }
        if (!nostore) {
#pragma unroll
            for (int r = 0; r < 2; ++r) { GAS f32x4* xr = (GAS f32x4*)(a.out + (row + r) * DM) + lane;
#pragma unroll
                for (int j = 0; j < 4; ++j) xr[64 * j] = v[r][j]; }
        } else asm volatile("" :: "v"(v[0][0]), "v"(v[0][1]), "v"(v[0][2]), "v"(v[0][3]), "v"(v[1][0]), "v"(v[1][1]), "v"(v[1][2]), "v"(v[1][3]));
    }
}

__global__ void __launch_bounds__(NWAVES * 64, 2) fwd_kernel(Args args) {
    extern __shared__ __attribute__((aligned(16))) unsigned char lds[];
    cg::grid_group grid = cg::this_grid();
    Frame F;
    F.lds = (LAS unsigned char*)lds;
    F.tid = threadIdx.x; F.lane = F.tid & 63; F.wave = __builtin_amdgcn_readfirstlane(F.tid >> 6);
    F.G = gridDim.x; { const int bx = blockIdx.x; F.vcu = (F.G % 8 == 0) ? (bx % 8) * (F.G / 8) + bx / 8 : bx; }
    unsigned char* ws = args.ws;
    const unsigned mask = args.mask; F.flags = mask;
    volatile LAS unsigned* MISC = (volatile LAS unsigned*)(F.lds + MISC_OFF);
    if (F.tid < 32) MISC[F.tid] = 0u;
    __syncthreads();
    XcdBarrier bar; bar.bar = (unsigned*)(ws + WS_CTL) + CW_BAR; bar.x = 0; bar.st = nullptr;
    const bool one_launch = __builtin_popcount(mask & 0x7ffu) > 1;
    if (one_launch) bar = xcd_barrier_post((unsigned*)(ws + WS_CTL) + CW_BAR, MISC + 8);
    if (one_launch) grid.sync();
#define REFRESH() do { F.tid = threadIdx.x; asm volatile("" : "+v"(F.tid)); F.lane = F.tid & 63; } while (0)
#define IN(k) ((mask >> (k)) & 1u)
#define SEAM(k) do { if (IN(k) && ((mask & 0x7ffu) >> ((k) + 1)) != 0u) xcd_barrier(bar); REFRESH(); } while (0)

    if (IN(0)) { p0_prologue(F, args); } SEAM(0);
    if (IN(1)) { p1_norm(F, args); } SEAM(1);
    if (IN(2)) {
        pg8::Gemm g{(const bf16*)(ws + WS_H), (const bf16*)(ws + WS_WIN), MT, NIN, DM}; pg8::StaticOrder S; S.init(MT, NIN, F.G, (int)blockIdx.x);
        EpiInProj E{(bf16*)(ws + WS_Q), (bf16*)(ws + WS_K), (bf16*)(ws + WS_V), (bf16*)(ws + WS_PR), args.in[6], args.in[7], (const float*)(ws + WS_ROPE)};
        pg8::gemm_phase<EpiInProj, pg8::StaticOrder, true, true>(F.lds, g, S, E, (mask >> 22) & 1u);
    } SEAM(2);
    if (IN(3)) {
        const int b = F.vcu >> 3, h = F.vcu & 7;
        if (!((mask >> 16) & 1u)) {
            prs_pass(F, args);
            REFRESH();
            float bref;
            { float gq = fabsf(args.in[6][F.lane]), gk = fabsf(args.in[7][F.lane]);
#pragma unroll
              for (int o_ = 1; o_ < 64; o_ <<= 1) { gq = fmaxf(gq, __shfl_xor(gq, o_)); gk = fmaxf(gk, __shfl_xor(gk, o_)); }
              bref = 64.0f * QSCALE * gq * gk * 1.02f + 0.25f; }
            for (int qb = 0; qb < 8; ++qb)
                attn_body::attn_unit<8>(b, h, qb, (const bf16*)(ws + WS_Q), (const bf16*)(ws + WS_K), (const bf16*)(ws + WS_V), (bf16*)(ws + WS_MIX), (char*)lds, qb > 0, true, bref);
            __syncthreads();
        }
        if (one_launch) xcd_barrier(bar);
        REFRESH();
        if (!((mask >> 17) & 1u)) {
            wkv::phase(F, args);
        }
    } SEAM(3);
    if (IN(4)) { p4_finalize(F, args); } SEAM(4);
    if (IN(5)) {
        pg8::Gemm g{(const bf16*)(ws + WS_MIX), (const bf16*)(ws + WS_WOUT), MT, DM, DM}; pg8::StaticOrder S; S.init(MT, DM, F.G, (int)blockIdx.x);
        EpiOutProj E{args.in[0], (bf16*)(ws + WS_X1), (const float*)(ws + WS_MOD)};
        pg8::gemm_phase<EpiOutProj, pg8::StaticOrder, true, true>(F.lds, g, S, E, (mask >> 22) & 1u);
    } SEAM(5);
    if (IN(6)) { p6_norm_router(F, args); } SEAM(6);
    if (IN(7)) { p7_topk_gather(F, args); } SEAM(7);
    if (IN(8)) {
        LAS unsigned short* lidx = (LAS unsigned short*)(F.lds + LIDX_OFF);
        { const int* IDX = (const int*)(ws + WS_IDX) + (size_t)(F.vcu >> 3) * NE * CAP; for (int i = F.tid; i < NE * CAP; i += 512) lidx[i] = (unsigned short)IDX[i]; }
        __syncthreads();
        pg8::Gemm g{(const bf16*)(ws + WS_H), (const bf16*)(ws + WS_WGU), NGROUP * CAP, 2 * FF, DM / 2}; GuOrder S{F.vcu, lidx};
        EpiSwiGLU E{ws + WS_HID};
        pg8::gemm_phase<EpiSwiGLU, GuOrder, true, true, true>(F.lds, g, S, E, (mask >> 22) & 1u);
    } SEAM(8);
    if (IN(9)) {
        pg8::Gemm g{(const bf16*)(ws + WS_HID), (const bf16*)(ws + WS_WD), NGROUP * CAP, DM, FF / 2}; DownOrder S{F.vcu};
        EpiDown E{ws + WS_Y, (const float*)(ws + WS_VAL), (const float*)(ws + WS_MOD)};
        pg8::gemm_phase<EpiDown, DownOrder, true, true, true>(F.lds, g, S, E, (mask >> 22) & 1u);
    } SEAM(9);
    if (IN(10)) { p10_combine(F, args); }
#undef IN
#undef SEAM
}

extern "C" void kernel_launch(void* const* d_in, const int* in_sizes, int n_in, void* d_out, int out_size, void* d_ws, size_t ws_size, hipStream_t stream) {
    static int grid = 0;
    if (grid == 0) {
        if (n_in != 25 || out_size != MT * DM || ws_size < WS_END) { fprintf(stderr, "kernel_launch: unexpected shapes n_in %d out %d ws %zu\n", n_in, out_size, ws_size); grid = -1; return; }
        int dev = 0, cus = 0, per_cu = 0;
        (void)hipGetDevice(&dev); (void)hipDeviceGetAttribute(&cus, hipDeviceAttributeMultiprocessorCount, dev);
        (void)hipFuncSetAttribute((const void*)fwd_kernel, hipFuncAttributeMaxDynamicSharedMemorySize, LDS_BYTES);
        (void)hipOccupancyMaxActiveBlocksPerMultiprocessor(&per_cu, (const void*)fwd_kernel, NWAVES * 64, LDS_BYTES);
        (void)hipGetLastError();
        if (per_cu < 1) { fprintf(stderr, "kernel_launch: occupancy query says %d blocks per CU\n", per_cu); grid = -1; return; }
        if (cus != NB * 8) { fprintf(stderr, "kernel_launch: built for a %d-CU device (one workgroup per (batch, head)); found %d CUs; nothing launched\n", NB * 8, cus); grid = -1; return; }
        grid = cus;
    }
    if (grid < 0) return;
    (void)hipMemsetAsync((char*)d_ws + WS_CTL, 0, CTL_ZERO_BYTES, stream);
#if !((DBG_MASK >> 5) & 1)
    (void)hipMemcpyAsync(d_out, d_in[0], (size_t)MT * DM * 4, hipMemcpyDeviceToDevice, stream);
#endif
    Args a{};
    for (int i = 0; i < 25; ++i) a.in[i] = (const float*)d_in[i];
    a.out = (float*)d_out; a.ws = (unsigned char*)d_ws;
    constexpr int NPH = 11;
#if MK_N_LAUNCHES == 1
    a.mask = DBG_MASK;
    void* kargs[] = {&a};
    hipError_t e = hipLaunchCooperativeKernel((const void*)fwd_kernel, dim3(grid), dim3(NWAVES * 64), kargs, LDS_BYTES, stream);
    if (e != hipSuccess) fprintf(stderr, "cooperative launch failed: %s (grid %d)\n", hipGetErrorString(e), grid);
#else
    for (int p = 0; p < NPH; ++p) {
        if (!((DBG_MASK >> p) & 1)) continue;
        a.mask = 1u << p;
        if (p == 3) { a.mask |= 1u << 17; hipLaunchKernelGGL(fwd_kernel, dim3(grid), dim3(NWAVES * 64), LDS_BYTES, stream, a); a.mask = (1u << 3) | (1u << 16); }
        hipLaunchKernelGGL(fwd_kernel, dim3(grid), dim3(NWAVES * 64), LDS_BYTES, stream, a);
        const int rp = DBG_REPEAT;
        if (rp == p || ((rp == 31 || rp == 32 || rp == 33) && p == 3)) {
            if (rp == 31) a.mask = (1u << 3) | (1u << 17); if (rp == 32) a.mask = (1u << 3) | (1u << 16); if (rp == 33) a.mask = (1u << 3) | (1u << 16) | (1u << 17); a.mask |= DBG_XFLAGS;
            hipLaunchKernelGGL(fwd_kernel, dim3(grid), dim3(NWAVES * 64), LDS_BYTES, stream, a);
        }
    }
#endif
}
```

```cpp
#include <hip/hip_runtime.h>
#include <hip/hip_cooperative_groups.h>
#include <hip/hip_bf16.h>
#include <cstdio>
#include <cstdint>
#include <cmath>
namespace cg = cooperative_groups;

#ifndef MK_N_LAUNCHES
#define MK_N_LAUNCHES 1
#endif
#ifndef DBG_REPEAT
#define DBG_REPEAT -1
#endif
#ifndef GEMM_GLDS
#define GEMM_GLDS 0
#endif
#ifndef WKV_PREFETCH
#define WKV_PREFETCH 1
#endif
#ifndef DBG_XFLAGS
#define DBG_XFLAGS 0
#endif
#ifndef USE_VALU_SCAN
#define USE_VALU_SCAN 0
#endif
#ifndef DBG_MASK
#define DBG_MASK 0x7ff
#endif

constexpr int DM = 1024, NB = 32, SEQ = 2048, MT = NB * SEQ;
constexpr int NIN = 2560, AW = 512, KVW = 128, RW = 512, NSH = 1792;
constexpr int NE = 16, CAP = 256, FF = 1024;
constexpr int NGROUP = NB * NE;
constexpr float NORM_EPS = 1e-6f, GN_EPS = 64e-5f, DECAY_SCALE = 0.606531f;
constexpr float QSCALE = 0.125f * 1.4426950408889634f;

constexpr size_t MiB = 1u << 20;
constexpr size_t WS_CTL = 0, CTL_ZERO_BYTES = 64 * 1024;
constexpr int CW_BAR = 4096;
constexpr size_t WS_MOD = 1 * MiB;
constexpr size_t WS_ROPE = 2 * MiB;
constexpr size_t WS_AFF = 3 * MiB;
constexpr size_t WS_IDX = 7 * MiB;
constexpr size_t WS_VAL = 7 * MiB + 512 * 1024;
constexpr size_t WS_INV = 8 * MiB;
constexpr size_t WS_BON = 12 * MiB;
constexpr size_t WS_GUPT = 16 * MiB;
constexpr size_t WS_WUPT = 16 * MiB + 128 * 1024;
constexpr size_t WS_AUPT = 16 * MiB + 256 * 1024;
constexpr size_t WS_AUPT2 = 16 * MiB + 384 * 1024;
constexpr size_t WS_WIN = 17 * MiB;
constexpr size_t WS_WOUT = 22 * MiB;
constexpr size_t WS_WGU = 24 * MiB;
constexpr size_t WS_WD = 88 * MiB;
constexpr size_t WS_H = 120 * MiB;
constexpr size_t WS_Q = 248 * MiB;
constexpr size_t WS_K = 312 * MiB;
constexpr size_t WS_V = 328 * MiB;
constexpr size_t WS_PR = 344 * MiB;
constexpr size_t WS_XG = 248 * MiB;
constexpr size_t WS_Y = 248 * MiB;
constexpr size_t WS_MIX = 568 * MiB;
constexpr size_t WS_YF = 696 * MiB;
constexpr size_t WS_YB = 760 * MiB;
constexpr size_t WS_RKVS = 824 * MiB;
constexpr size_t WS_TDS = 120 * MiB;
constexpr size_t WS_HID = 568 * MiB;
constexpr size_t WS_X1 = 696 * MiB;
constexpr size_t WS_END = 1016 * MiB;

constexpr int RING_BYTES = 131072;
constexpr int LIDX_OFF = RING_BYTES + 512;
constexpr int LDS_BYTES = 147456;
constexpr int MISC_OFF = LDS_BYTES - 256;
constexpr int NWAVES = 8;

#define GAS __attribute__((address_space(1)))
#define LAS __attribute__((address_space(3)))
typedef unsigned short bf16;
typedef unsigned v4u __attribute__((ext_vector_type(4)));
typedef unsigned v2u __attribute__((ext_vector_type(2)));
typedef float f32x4 __attribute__((ext_vector_type(4)));
typedef float f32x2 __attribute__((ext_vector_type(2)));
typedef short bf16x8 __attribute__((ext_vector_type(8)));
#define LDS_WAIT() asm volatile("s_waitcnt lgkmcnt(0)" ::: "memory")
#define VM_WAIT() asm volatile("s_waitcnt vmcnt(0)" ::: "memory")
__device__ __forceinline__ unsigned cvt2_fp8(float a, float b, unsigned old, bool hi) { a = __builtin_amdgcn_fmed3f(a, -448.0f, 448.0f); b = __builtin_amdgcn_fmed3f(b, -448.0f, 448.0f); return hi ? __builtin_amdgcn_cvt_pk_fp8_f32(a, b, old, true) : __builtin_amdgcn_cvt_pk_fp8_f32(a, b, old, false); }
typedef __bf16 bf16x2_hw __attribute__((ext_vector_type(2)));
__device__ __forceinline__ unsigned pk2(float lo, float hi) { const f32x2 v = {lo, hi}; return __builtin_bit_cast(unsigned, __builtin_convertvector(v, bf16x2_hw)); }
__device__ __forceinline__ unsigned f2bf(float f) { return pk2(f, 0.f) & 0xffffu; }
__device__ __forceinline__ float bf2f(unsigned short h) { return __builtin_bit_cast(float, (unsigned)h << 16); }
__device__ __forceinline__ float bflo(unsigned w) { return __builtin_bit_cast(float, w << 16); }
__device__ __forceinline__ float bfhi(unsigned w) { return __builtin_bit_cast(float, w & 0xffff0000u); }
#define DPP_ADD(v, CTRL) ((v) + __builtin_bit_cast(float, __builtin_amdgcn_update_dpp(0, __builtin_bit_cast(int, (v)), (CTRL), 0xf, 0xf, false)))
__device__ __forceinline__ float xor16_sum(float v) { auto r = __builtin_amdgcn_permlane16_swap(__float_as_uint(v), __float_as_uint(v), false, false); return __uint_as_float(r[0]) + __uint_as_float(r[1]); }
__device__ __forceinline__ float xor32_sum(float v) { auto r = __builtin_amdgcn_permlane32_swap(__float_as_uint(v), __float_as_uint(v), false, false); return __uint_as_float(r[0]) + __uint_as_float(r[1]); }
__device__ __forceinline__ float wave_sum(float v) {
    v = DPP_ADD(v, 0xB1); v = DPP_ADD(v, 0x4E); v = DPP_ADD(v, 0x141); v = DPP_ADD(v, 0x140);
    return xor32_sum(xor16_sum(v));
}
__device__ __forceinline__ float sigmoidf_(float x) { return 1.0f / (1.0f + __expf(-x)); }

namespace pg8 {
#define PG8_LAS __attribute__((address_space(3)))
typedef unsigned short bf16_t;
typedef short bf16x8 __attribute__((ext_vector_type(8)));
typedef float f32x4 __attribute__((ext_vector_type(4)));
typedef unsigned u32x4 __attribute__((ext_vector_type(4)));
constexpr int BM = 256, BK = 64, HALF = 128, HTB = HALF * BK * 2, STAGE_BYTES = 8 * HTB, NXCD = 8, WGM = 8;

__host__ __device__ __forceinline__ int lds_byte(int r, int c) { const int st = (r >> 4) * 2 + (c >> 5), rr = r & 15, cc = c & 31, ob = rr * 64 + cc * 2; return st * 1024 + (ob ^ (((ob >> 9) & 1) << 5)); }
__host__ __device__ __forceinline__ void stage_rc(int b, int& R, int& C) { const int st = b / 1024, sb = b % 1024, swz = sb ^ (((sb >> 9) & 1) << 5); R = (st >> 1) * 16 + swz / 64; C = (st & 1) * 32 + (swz % 64) / 2; }
__host__ __device__ __forceinline__ int perm32(int rho) { const int n = rho >> 4, i = rho & 15; return 8 * (i >> 2) + 4 * n + (i & 3); }

struct Unit { int pm, pn, bt; };
struct Gemm { const bf16_t* A; const bf16_t* Bt; int M, N, K; };

struct StaticOrder {
    static constexpr bool GATHER = false;
    int nM, nN, nwg, G, c;
    __host__ __device__ void init(int M, int N, int G_, int c_) { nM = M / BM; nN = N / BM; nwg = nM * nN; G = G_; c = c_; }
    __host__ __device__ bool next(int i, Unit& u) const {
        const long L = (long)i * G + c; if (L >= nwg) return false;
        int wgid = (int)L; { const int q = nwg / NXCD, r = nwg % NXCD, xcd = wgid % NXCD, off = wgid / NXCD; wgid = (xcd < r ? xcd * (q + 1) : r * (q + 1) + (xcd - r) * q) + off; }
        const int nig = WGM * nN, gid = wgid / nig, fm = gid * WGM, gsz = (nM - fm) < WGM ? (nM - fm) : WGM;
        u.pm = fm + ((wgid % nig) % gsz); u.pn = (wgid % nig) / gsz; u.bt = u.pn; return true;
    }
};

__device__ __forceinline__ unsigned cvt_pk_bf16(float lo, float hi) { unsigned r; asm volatile("v_cvt_pk_bf16_f32 %0, %1, %2" : "=v"(r) : "v"(lo), "v"(hi)); return r; }

typedef int v8i_t __attribute__((ext_vector_type(8)));
typedef int v4i_t __attribute__((ext_vector_type(4)));
template <class Sched> __device__ __forceinline__ unsigned a_base_of(const Sched& S, const Unit& u, unsigned tstep) { if constexpr (Sched::GATHER) return S.a_base(u); else return (unsigned)u.pm * tstep; }
template <class Epi, class Sched, bool ALIGN_EPI = false, bool SP2 = false, bool FP8 = false>
__device__ __forceinline__ void gemm_phase(PG8_LAS unsigned char* lds, const Gemm g, const Sched& S, const Epi& E, const bool skip_epi = false) {
    const int tid = threadIdx.x, wid = __builtin_amdgcn_readfirstlane(tid >> 6), lane = tid & 63, wr = wid >> 2, wc = wid & 3, fr = lane & 15, fq = lane >> 4;
    int K = g.K; asm volatile("" : "+s"(K));
    const int nt = K / BK;
    unsigned voffA[2], voffB[2];
#pragma unroll
    for (int i = 0; i < 2; ++i) { int R, C; stage_rc(tid * 16 + i * 8192, R, C); const int Rb = Epi::PERM ? ((R & ~31) + perm32(R & 31)) : R;
        voffA[i] = (unsigned)(R * K + C) * 2u; voffB[i] = (unsigned)(Rb * K + C) * 2u; }
    const unsigned kstep = (unsigned)(BK * 2);
    const unsigned hstep = (unsigned)HALF * (unsigned)K * 2u;
    const unsigned tstep = 2u * hstep;
    const unsigned ldsw = (unsigned)wid * 1024u;
    const int aoff = lds_byte(wr * 64 + fr, fq * 8), boff = lds_byte(wc * 32 + fr, fq * 8);
    const __amdgpu_buffer_rsrc_t rsA = __builtin_amdgcn_make_buffer_rsrc((void*)g.A, 0, 0x7fffffff, 0x00020000), rsB = __builtin_amdgcn_make_buffer_rsrc((void*)g.Bt, 0, 0x7fffffff, 0x00020000);
#define PG8_SA(b, h) (((b) * 2 + (h)) * HTB)
#define PG8_SB(b, h) ((4 + (b) * 2 + (h)) * HTB)
#if GEMM_GLDS
#define PG8_STAGE(bufoff, rs, soff, voff) do { _Pragma("unroll") for (int _i = 0; _i < 2; ++_i) { \
        if constexpr (FP8) __builtin_amdgcn_raw_ptr_buffer_load_lds(rs, (PG8_LAS void*)(lds + (bufoff) + ldsw + _i * 8192), 16, (int)(voff)[_i], (int)(soff), 0, 0); \
        else __builtin_amdgcn_global_load_lds((const unsigned*)((&rs == &rsA ? (const char*)g.A : (const char*)g.Bt) + (size_t)(soff) + (voff)[_i]), (PG8_LAS unsigned*)(lds + (bufoff) + ldsw + _i * 8192), 16, 0, 0); } } while (0)
#else
#define PG8_STAGE(bufoff, rs, soff, voff) do { _Pragma("unroll") for (int _i = 0; _i < 2; ++_i) \
        __builtin_amdgcn_raw_ptr_buffer_load_lds(rs, (PG8_LAS void*)(lds + (bufoff) + ldsw + _i * 8192), 16, (int)(voff)[_i], (int)(soff), 0, 0); } while (0)
#endif
#define PG8_STAGE_A(bufoff, half, soff, gsel) do { if constexpr (Sched::GATHER) { PG8_STAGE(bufoff, rsA, soff, gsel[half]); } else { PG8_STAGE(bufoff, rsA, (soff) + (half) * hstep, voffA); } } while (0)
#define PG8_LDA(dst, b, h) do { if constexpr (FP8) { _Pragma("unroll") for (int m = 0; m < 4; ++m) { const v4i_t _lo = *(const PG8_LAS v4i_t*)(lds + PG8_SA(b, h) + aoff + m * 2048), _hi = *(const PG8_LAS v4i_t*)(lds + PG8_SA(b, h) + aoff + m * 2048 + 1024); dst##8[m] = __builtin_shufflevector(_lo, _hi, 0, 1, 2, 3, 4, 5, 6, 7); } } \
    else { _Pragma("unroll") for (int m = 0; m < 4; ++m) _Pragma("unroll") for (int k = 0; k < 2; ++k) dst[m][k] = *(const PG8_LAS bf16x8*)(lds + PG8_SA(b, h) + aoff + m * 2048 + k * 1024); } } while (0)
#define PG8_LDB(dst, b, h) do { if constexpr (FP8) { _Pragma("unroll") for (int n = 0; n < 2; ++n) { const v4i_t _lo = *(const PG8_LAS v4i_t*)(lds + PG8_SB(b, h) + boff + n * 2048), _hi = *(const PG8_LAS v4i_t*)(lds + PG8_SB(b, h) + boff + n * 2048 + 1024); dst##8[n] = __builtin_shufflevector(_lo, _hi, 0, 1, 2, 3, 4, 5, 6, 7); } } \
    else { _Pragma("unroll") for (int n = 0; n < 2; ++n) _Pragma("unroll") for (int k = 0; k < 2; ++k) dst[n][k] = *(const PG8_LAS bf16x8*)(lds + PG8_SB(b, h) + boff + n * 2048 + k * 1024); } } while (0)
#define PG8_MMA(ai, bj, At, Bt) do { __builtin_amdgcn_s_setprio(1); _Pragma("unroll") for (int m = 0; m < 4; ++m) _Pragma("unroll") for (int n = 0; n < 2; ++n) { \
        if constexpr (FP8) acc[ai][bj][m][n] = __builtin_amdgcn_mfma_scale_f32_16x16x128_f8f6f4(Bt##8[n], At##8[m], acc[ai][bj][m][n], 0, 0, 0, 0, 0, 0); \
        else { _Pragma("unroll") for (int k = 0; k < 2; ++k) acc[ai][bj][m][n] = __builtin_amdgcn_mfma_f32_16x16x32_bf16(Bt[n][k], At[m][k], acc[ai][bj][m][n], 0, 0, 0); } } __builtin_amdgcn_s_setprio(0); } while (0)
#define PG8_WAIT_V(n) asm volatile("s_waitcnt vmcnt(" #n ")" ::: "memory")
#define PG8_WAIT_L(n) asm volatile("s_waitcnt lgkmcnt(" #n ")" ::: "memory")
#define PG8_BAR __builtin_amdgcn_s_barrier()
#define PG8_SCHED __builtin_amdgcn_sched_barrier(0)
    Unit cur, nxt; int ui = 0;
    if (!S.next(0, cur)) return;
    f32x4 acc[2][2][4][2];
#pragma unroll
    for (int a = 0; a < 2; ++a)
#pragma unroll
        for (int b = 0; b < 2; ++b)
#pragma unroll
            for (int m = 0; m < 4; ++m)
#pragma unroll
                for (int n = 0; n < 2; ++n) acc[a][b][m][n] = (f32x4){0.f, 0.f, 0.f, 0.f};
    bf16x8 At[4][2], B0[2][2], B1[2][2]; v8i_t At8[4], B08[2], B18[2];
    unsigned cA = a_base_of(S, cur, tstep), cB = (unsigned)cur.bt * tstep;
    unsigned gc[2][2] = {{0u, 0u}, {0u, 0u}};
    if constexpr (Sched::GATHER) S.rows(cur, gc);
    if constexpr (SP2) {
        PG8_STAGE(PG8_SB(0, 0), rsB, cB, voffB); PG8_STAGE(PG8_SB(0, 1), rsB, cB + hstep, voffB); PG8_STAGE_A(PG8_SA(0, 0), 0, cA, gc); PG8_STAGE_A(PG8_SA(0, 1), 1, cA, gc);
        if (wr == 1) PG8_BAR;
        PG8_WAIT_V(2); PG8_BAR;
        PG8_STAGE(PG8_SB(1, 0), rsB, cB + kstep, voffB); PG8_STAGE_A(PG8_SA(1, 0), 0, cA + kstep, gc); PG8_STAGE(PG8_SB(1, 1), rsB, cB + hstep + kstep, voffB);
        PG8_WAIT_V(6); PG8_BAR;
    } else {
        PG8_STAGE(PG8_SB(0, 0), rsB, cB, voffB); PG8_STAGE_A(PG8_SA(0, 0), 0, cA, gc); PG8_STAGE(PG8_SB(0, 1), rsB, cB + hstep, voffB); PG8_STAGE_A(PG8_SA(0, 1), 1, cA, gc);
        if (wr == 1) PG8_BAR;
        PG8_WAIT_V(4); PG8_BAR;
        PG8_STAGE(PG8_SB(1, 0), rsB, cB + kstep, voffB); PG8_STAGE_A(PG8_SA(1, 0), 0, cA + kstep, gc); PG8_STAGE(PG8_SB(1, 1), rsB, cB + hstep + kstep, voffB);
        PG8_WAIT_V(6); PG8_BAR;
    }
    for (;;) {
        const bool has_next = S.next(ui + 1, nxt);
        const unsigned nA = has_next ? a_base_of(S, nxt, tstep) : cA, nB = has_next ? (unsigned)nxt.bt * tstep : cB;
#pragma clang loop unroll(disable)
        for (int t = 0; t < nt; t += 2) {
            const bool last = (t == nt - 2);
            const unsigned a1 = cA + (unsigned)(t + 1) * kstep;
            const unsigned a2 = last ? nA : cA + (unsigned)(t + 2) * kstep, b2 = last ? nB : cB + (unsigned)(t + 2) * kstep;
            const unsigned a3 = a2 + kstep, b3 = b2 + kstep;
            unsigned g23[2][2] = {{gc[0][0], gc[0][1]}, {gc[1][0], gc[1][1]}};
            if constexpr (Sched::GATHER) { if (last && has_next) S.rows(nxt, g23); }
            if constexpr (SP2) {
            PG8_LDB(B0, 0, 0); PG8_LDB(B1, 0, 1); PG8_SCHED; PG8_LDA(At, 0, 0); PG8_STAGE_A(PG8_SA(1, 1), 1, a1, gc);
            PG8_WAIT_V(8); PG8_WAIT_L(0); PG8_BAR; PG8_MMA(0, 0, At, B0); PG8_MMA(0, 1, At, B1); PG8_BAR; PG8_SCHED;
            PG8_LDA(At, 0, 1); PG8_STAGE(PG8_SB(0, 0), rsB, b2, voffB); PG8_STAGE(PG8_SB(0, 1), rsB, b2 + hstep, voffB); PG8_STAGE_A(PG8_SA(0, 0), 0, a2, g23);
            PG8_WAIT_V(8); PG8_WAIT_L(0); PG8_BAR; PG8_MMA(1, 0, At, B0); PG8_MMA(1, 1, At, B1); PG8_BAR; PG8_SCHED;
            PG8_LDB(B0, 1, 0); PG8_LDB(B1, 1, 1); PG8_SCHED; PG8_LDA(At, 1, 0); PG8_STAGE_A(PG8_SA(0, 1), 1, a2, g23);
            PG8_WAIT_V(8); PG8_WAIT_L(0); PG8_BAR; PG8_MMA(0, 0, At, B0); PG8_MMA(0, 1, At, B1); PG8_BAR; PG8_SCHED;
            PG8_LDA(At, 1, 1); PG8_STAGE(PG8_SB(1, 0), rsB, b3, voffB); PG8_STAGE(PG8_SB(1, 1), rsB, b3 + hstep, voffB); PG8_STAGE_A(PG8_SA(1, 0), 0, a3, g23);
            PG8_WAIT_V(8); PG8_WAIT_L(0); PG8_BAR; PG8_MMA(1, 0, At, B0); PG8_MMA(1, 1, At, B1); PG8_BAR; PG8_SCHED;
            } else {
            PG8_LDB(B0, 0, 0); PG8_SCHED; PG8_LDA(At, 0, 0); PG8_STAGE_A(PG8_SA(1, 1), 1, a1, gc);
            PG8_WAIT_L(8); PG8_BAR; PG8_WAIT_L(0); PG8_MMA(0, 0, At, B0); PG8_BAR; PG8_SCHED;
            PG8_LDB(B1, 0, 1); PG8_STAGE(PG8_SB(0, 0), rsB, b2, voffB);
            PG8_BAR; PG8_WAIT_L(0); PG8_MMA(0, 1, At, B1); PG8_BAR;
            PG8_LDA(At, 0, 1); PG8_STAGE_A(PG8_SA(0, 0), 0, a2, g23);
            PG8_BAR; PG8_WAIT_L(0); PG8_MMA(1, 0, At, B0); PG8_BAR; PG8_SCHED;
            PG8_STAGE(PG8_SB(0, 1), rsB, b2 + hstep, voffB);
            PG8_WAIT_V(6); PG8_BAR; PG8_MMA(1, 1, At, B1); PG8_BAR;
            PG8_LDB(B0, 1, 0); PG8_SCHED; PG8_LDA(At, 1, 0); PG8_STAGE_A(PG8_SA(0, 1), 1, a2, g23);
            PG8_WAIT_L(8); PG8_BAR; PG8_WAIT_L(0); PG8_MMA(0, 0, At, B0); PG8_BAR; PG8_SCHED;
            PG8_LDB(B1, 1, 1); PG8_STAGE(PG8_SB(1, 0), rsB, b3, voffB);
            PG8_BAR; PG8_WAIT_L(0); PG8_MMA(0, 1, At, B1); PG8_BAR;
            PG8_LDA(At, 1, 1); PG8_STAGE_A(PG8_SA(1, 0), 0, a3, g23);
            PG8_BAR; PG8_WAIT_L(0); PG8_MMA(1, 0, At, B0); PG8_BAR; PG8_SCHED;
            PG8_STAGE(PG8_SB(1, 1), rsB, b3 + hstep, voffB);
            PG8_WAIT_V(6); PG8_BAR; PG8_MMA(1, 1, At, B1); PG8_BAR;
            }
        }
        if constexpr (ALIGN_EPI) { if (wr == 0) PG8_BAR; }
        if (!skip_epi) E(acc, cur, wr, wc, fr, fq); else asm volatile("" :: "v"(acc[0][0][0][0]), "v"(acc[1][1][3][1]), "v"(acc[0][1][2][0]), "v"(acc[1][0][1][1]));
        if (!has_next) break;
#pragma unroll
        for (int a = 0; a < 2; ++a)
#pragma unroll
            for (int b = 0; b < 2; ++b)
#pragma unroll
                for (int m = 0; m < 4; ++m)
#pragma unroll
                    for (int n = 0; n < 2; ++n) acc[a][b][m][n] = (f32x4){0.f, 0.f, 0.f, 0.f};
        cur = nxt; cA = nA; cB = nB; ++ui;
        if constexpr (Sched::GATHER) S.rows(cur, gc);
        if constexpr (ALIGN_EPI) { if (wr == 1) PG8_BAR; }
    }
    PG8_WAIT_V(0);
    if constexpr (!ALIGN_EPI) { if (wr == 0) PG8_BAR; }
    PG8_BAR;
#undef PG8_SA
#undef PG8_SB
#undef PG8_STAGE
#undef PG8_STAGE_A
#undef PG8_LDA
#undef PG8_LDB
#undef PG8_MMA
#undef PG8_WAIT_V
#undef PG8_WAIT_L
#undef PG8_BAR
#undef PG8_SCHED
}
}

namespace attn_body {
using bf16x8=__attribute__((ext_vector_type(8)))short;
using s16x4=__attribute__((ext_vector_type(4)))short;
using f32x16=__attribute__((ext_vector_type(16)))float;
using u32x4=__attribute__((ext_vector_type(4)))unsigned;
typedef unsigned short bf16r;
constexpr int D=64, QP=AW, KP=KVW, OP=DM;
constexpr int NW=8,QBLK=32,QB=QBLK*NW,KVBLK=64;
__device__ __forceinline__ int crow(int r,int hi){return (r&3)+8*(r>>2)+4*hi;}
#define SBAR() __builtin_amdgcn_sched_barrier(0)
constexpr int NSLOT=3, SLOTB=8192;
constexpr int LDS_K=0, LDS_V=NSLOT*SLOTB, LDS_WS=2*NSLOT*SLOTB, LDS_OST=LDS_WS+NW*64*4, LDS_BYTES_A=LDS_OST+NW*4096;
__device__ __forceinline__ void glds16(const void*gsrc,unsigned lds_dst){unsigned keep;
  asm volatile("s_mov_b32 %0, m0\n\ts_mov_b32 m0, %2\n\ts_nop 0\n\tglobal_load_lds_dwordx4 %1, off\n\ts_mov_b32 m0, %0":"=&s"(keep):"v"(gsrc),"s"(lds_dst):"memory");}
__device__ __forceinline__ float max3f(float a,float b,float c){float r;asm("v_max3_f32 %0, %1, %2, %3":"=v"(r):"v"(a),"v"(b),"v"(c));return r;}
__device__ __forceinline__ float max2f(float a,float b){float r;asm("v_max_f32_e32 %0, %1, %2":"=v"(r):"v"(a),"v"(b));return r;}
__device__ __forceinline__ float fadd_s(float a,float b){float r;asm("v_add_f32_e32 %0, %1, %2":"=v"(r):"v"(a),"v"(b));return r;}
__device__ __forceinline__ float fsub_s(float a,float b){float r;asm("v_sub_f32_e32 %0, %1, %2":"=v"(r):"v"(a),"v"(b));return r;}
typedef float f32x2_t __attribute__((ext_vector_type(2))); typedef __bf16 bf16x2_t __attribute__((ext_vector_type(2)));
__device__ __forceinline__ unsigned cvtpk_s(float lo,float hi){f32x2_t v={lo,hi};bf16x2_t b=__builtin_convertvector(v,bf16x2_t);return __builtin_bit_cast(unsigned,b);}
#define WAIT_BAR(N) asm volatile("s_waitcnt vmcnt(" #N ") lgkmcnt(0)\n\ts_barrier":::"memory")
__device__ __forceinline__ void qkt(f32x16&p0,f32x16&p1,const char*Kslot,const bf16x8*qr,const f32x16&negm,int r32,int hi){
  const char*kb=Kslot+hi*1024+r32*16;
  #pragma unroll
  for(int d0=0;d0<4;++d0){
    const bf16x8 b0=*reinterpret_cast<const bf16x8*>(kb+d0*2048);
    const bf16x8 b1=*reinterpret_cast<const bf16x8*>(kb+d0*2048+512);
    if(d0==0){p0=__builtin_amdgcn_mfma_f32_32x32x16_bf16(b0,qr[0],negm,0,0,0);p1=__builtin_amdgcn_mfma_f32_32x32x16_bf16(b1,qr[0],negm,0,0,0);}
    else{p0=__builtin_amdgcn_mfma_f32_32x32x16_bf16(b0,qr[d0],p0,0,0,0);p1=__builtin_amdgcn_mfma_f32_32x32x16_bf16(b1,qr[d0],p1,0,0,0);}}
}
typedef __attribute__((address_space(3))) const char* lds_cptr;
typedef short v4i16_t __attribute__((ext_vector_type(4)));
__device__ __forceinline__ void kload8(bf16x8*kf,lds_cptr kp){
  kf[0]=*(const __attribute__((address_space(3))) bf16x8*)(kp);      kf[1]=*(const __attribute__((address_space(3))) bf16x8*)(kp+512);
  kf[2]=*(const __attribute__((address_space(3))) bf16x8*)(kp+2048); kf[3]=*(const __attribute__((address_space(3))) bf16x8*)(kp+2560);
  kf[4]=*(const __attribute__((address_space(3))) bf16x8*)(kp+4096); kf[5]=*(const __attribute__((address_space(3))) bf16x8*)(kp+4608);
  kf[6]=*(const __attribute__((address_space(3))) bf16x8*)(kp+6144); kf[7]=*(const __attribute__((address_space(3))) bf16x8*)(kp+6656);
}
__device__ __forceinline__ void kload2(bf16x8*kf,lds_cptr kp,int j){ kf[2*j]=*(const __attribute__((address_space(3))) bf16x8*)(kp+j*2048); kf[2*j+1]=*(const __attribute__((address_space(3))) bf16x8*)(kp+j*2048+512); }
__device__ __forceinline__ s16x4 vtr(lds_cptr p){ return __builtin_bit_cast(s16x4,__builtin_amdgcn_ds_read_tr16_b64_v4i16((__attribute__((address_space(3))) v4i16_t*)p)); }
__device__ __forceinline__ float rowmax(const f32x16&p0,const f32x16&p1){
  float a=max3f(p0[0],p0[1],p1[0]),b=max3f(p0[2],p0[3],p1[1]);a=max3f(a,p1[2],p1[3]);
  #pragma unroll
  for(int r=4;r<16;r+=4){a=max3f(a,p0[r],p0[r+1]);b=max3f(b,p0[r+2],p0[r+3]);a=max3f(a,p1[r],p1[r+1]);b=max3f(b,p1[r+2],p1[r+3]);}
  const float m=max2f(a,b);
  auto rr=__builtin_amdgcn_permlane32_swap(__float_as_uint(m),__float_as_uint(m),false,false);
  return max2f(__uint_as_float(rr[0]),__uint_as_float(rr[1]));
}
__device__ __forceinline__ void pv(f32x16*o,int vb,bf16x8 pa0,bf16x8 pa1,bf16x8 pa2,bf16x8 pa3){
  #pragma unroll
  for(int d0=0;d0<2;++d0){s16x4 lo[4],hi[4];
    #pragma unroll
    for(int ks=0;ks<4;++ks){
      asm volatile("ds_read_b64_tr_b16 %0,%1 offset:%c2":"=&v"(lo[ks]):"v"(vb),"i"(d0*4096+ks*1024):"memory");
      asm volatile("ds_read_b64_tr_b16 %0,%1 offset:%c2":"=&v"(hi[ks]):"v"(vb),"i"(d0*4096+ks*1024+512):"memory");}
    asm volatile("s_waitcnt lgkmcnt(0)":::"memory");SBAR();
    #define PK(k) (bf16x8){lo[k][0],lo[k][1],lo[k][2],lo[k][3],hi[k][0],hi[k][1],hi[k][2],hi[k][3]}
    o[d0]=__builtin_amdgcn_mfma_f32_32x32x16_bf16(pa0,PK(0),o[d0],0,0,0);
    o[d0]=__builtin_amdgcn_mfma_f32_32x32x16_bf16(pa1,PK(1),o[d0],0,0,0);
    o[d0]=__builtin_amdgcn_mfma_f32_32x32x16_bf16(pa2,PK(2),o[d0],0,0,0);
    o[d0]=__builtin_amdgcn_mfma_f32_32x32x16_bf16(pa3,PK(3),o[d0],0,0,0);
    #undef PK
  }
}
template<int THRL> __device__ __forceinline__ void attn_unit(int b,int h,int qb,const bf16r*Q,const bf16r*__restrict__ K,const bf16r*__restrict__ V,bf16r*O,char*shm,bool pre_issued,bool issue_next,float bref){
  const int tid=threadIdx.x,lane=tid&63,r32=lane&31,hi=lane>>5; const int wid=__builtin_amdgcn_readfirstlane(tid>>6);
  const long rowbase=(long)b*SEQ; const int q0=qb*QB; const int hk=h>>2;
  const bf16r*Qw=Q+(rowbase+q0+wid*QBLK)*QP+h*D;
  const bf16r*Kh=K+rowbase*KP+hk*D,*Vh=V+rowbase*KP+hk*D;
  const unsigned lds0=(unsigned)(uintptr_t)shm;
  float*wsf=(float*)(shm+LDS_WS)+wid*64;
  const bf16r*ksrc=Kh+(long)lane*KP+wid*8;
  const bf16r*vsrc=Vh+(long)(16*(wid&3)+(lane>>2))*KP+(wid>>2)*32+(lane&3)*8;
  const unsigned kdst=lds0+LDS_K+wid*1024, vdst=lds0+LDS_V+wid*1024;
  #define DMA_K(t,slot) glds16(ksrc+(long)(t)*KVBLK*KP,(unsigned)__builtin_amdgcn_readfirstlane(kdst+(slot)))
  #define DMA_V(t,slot) glds16(vsrc+(long)(t)*KVBLK*KP,(unsigned)__builtin_amdgcn_readfirstlane(vdst+(slot)))
  const int vb0=(int)(lds0+LDS_V)+((lane>>4)&1)*32+(lane&3)*8+(4*hi+((lane&15)>>2))*64;
  const char*Kbase=shm+LDS_K; bf16x8 kf[8];
  const lds_cptr shm3=(lds_cptr)shm; const lds_cptr kp0=shm3+LDS_K+hi*1024+r32*16; const lds_cptr vp0=shm3+LDS_V+((lane>>4)&1)*32+(lane&3)*8+(4*hi+((lane&15)>>2))*64;
  constexpr int NT=SEQ/KVBLK;
  if(!pre_issued){DMA_K(0,0);DMA_V(0,0);DMA_K(1,SLOTB);}
  bf16x8 qr[4];
  #pragma unroll
  for(int d0=0;d0<4;++d0)qr[d0]=*reinterpret_cast<const bf16x8*>(&Qw[(long)r32*QP+d0*16+hi*8]);
  float l_reg=0.f;f32x16 o[2];o[0]=f32x16{};o[1]=f32x16{};f32x16 negm;
  _Pragma("unroll") for(int r=0;r<16;++r)negm[r]=-bref; asm volatile("":"+v"(negm));
  bool resc=false;
  #define START(P0,P1) do{ _Pragma("unroll") for(int r=0;r<16;++r)P0[r]=__builtin_amdgcn_exp2f(P0[r]); }while(0)
  #define RESC() do{ if(resc){ asm volatile("s_waitcnt lgkmcnt(0)":::"memory"); \
      _Pragma("unroll") for(int d_=0;d_<2;++d_) _Pragma("unroll") for(int r=0;r<16;++r)o[d_][r]*=wsf[crow(r,hi)]; } }while(0)
  f32x16 pA0,pA1,pB0,pB1;
  int sl_prev=0,sl_cur=0,sl_next=SLOTB;
  #define ROT() do{sl_prev=sl_cur;sl_cur=sl_next;sl_next=(sl_next==(NSLOT-1)*SLOTB)?0:sl_next+SLOTB;}while(0)
  if(!pre_issued){DMA_K(2,2*SLOTB);}
  WAIT_BAR(3);
  qkt(pA0,pA1,Kbase,qr,negm,r32,hi);asm volatile("s_nop 15\n\ts_nop 7":"+v"(pA0),"+v"(pA1));
  START(pA0,pA1);
  _Pragma("unroll") for(int r=0;r<16;++r)pA1[r]=__builtin_amdgcn_exp2f(pA1[r]);
  WAIT_BAR(0);
  DMA_K(3,0);DMA_V(1,SLOTB);
  ROT();
  kload8(kf,kp0+sl_cur);
  WAIT_BAR(2);
  s16x4 vlo[8],vhi[8]; u32x4 pw0,pw1,pw2,pw3;
  #define PKW(P,B) cvtpk_s(P[B],P[B+1])
  #define PAF(k) __builtin_bit_cast(bf16x8,pw##k)
  #define VFR(i) (bf16x8){vlo[i][0],vlo[i][1],vlo[i][2],vlo[i][3],vhi[i][0],vhi[i][1],vhi[i][2],vhi[i][3]}
  #define PIN(x) asm volatile("":"+v"(x))
  #define MX3(a,b,c) __builtin_fmaxf(__builtin_fmaxf((a),(b)),(c))
  #define GAPA(MF,A0,A1,A2,A3,W0,W1,PW) do{ MF; sacc+=A0; sacc+=A1; sacc+=A2; sacc+=A3; PIN(sacc); W0; W1; PIN(PW); SBAR(); }while(0)
  #define EX(v) __builtin_amdgcn_exp2f(v)
  #define GAPB(MF,X,B) do{ MF; X[B]=EX(X[B]); X[B+1]=EX(X[B+1]); X[B+2]=EX(X[B+2]); X[B+3]=EX(X[B+3]); PIN(X); SBAR(); }while(0)
  #define VRD(i) do{ vlo[i]=vtr(vp_+(((i)>>2)*4096+((i)&3)*1024)); vhi[i]=vtr(vp_+(((i)>>2)*4096+((i)&3)*1024+512)); }while(0)
  #define KRD(G,j) do{ if(G){ kload2(kf,kp0+sl_next,j); SBAR(); } }while(0)
  #define STEP(C0,C1,P0,P1,t,GK,GV,GL) do{ SBAR(); \
    const lds_cptr vp_=vp0+sl_prev; \
    VRD(0); SBAR(); float sacc=(P0[0]+P0[1]); \
    GAPA(C0=__builtin_amdgcn_mfma_f32_32x32x16_bf16(kf[0],qr[0],negm,0,0,0), P0[2],P0[3],P0[4],P0[5],     pw0[0]=PKW(P0,0), pw0[1]=PKW(P0,2), pw0); \
    VRD(4); SBAR(); GAPA(C1=__builtin_amdgcn_mfma_f32_32x32x16_bf16(kf[1],qr[0],negm,0,0,0), P0[6],P0[7],P0[8],P0[9],     pw0[2]=PKW(P0,4), pw0[3]=PKW(P0,6), pw0); \
    VRD(1); SBAR(); GAPA(C0=__builtin_amdgcn_mfma_f32_32x32x16_bf16(kf[2],qr[1],C0,0,0,0),   P0[10],P0[11],P0[12],P0[13], pw1[0]=PKW(P0,8), pw1[1]=PKW(P0,10), pw1); \
    VRD(5); SBAR(); GAPA(C1=__builtin_amdgcn_mfma_f32_32x32x16_bf16(kf[3],qr[1],C1,0,0,0),   P0[14],P0[15],P1[0],P1[1],   pw1[2]=PKW(P0,12),pw1[3]=PKW(P0,14), pw1); \
    VRD(2); SBAR(); GAPA(C0=__builtin_amdgcn_mfma_f32_32x32x16_bf16(kf[4],qr[2],C0,0,0,0),   P1[2],P1[3],P1[4],P1[5],     pw2[0]=PKW(P1,0), pw2[1]=PKW(P1,2), pw2); \
    VRD(6); SBAR(); GAPA(C1=__builtin_amdgcn_mfma_f32_32x32x16_bf16(kf[5],qr[2],C1,0,0,0),   P1[6],P1[7],P1[8],P1[9],     pw2[2]=PKW(P1,4), pw2[3]=PKW(P1,6), pw2); \
    VRD(3); SBAR(); GAPA(C0=__builtin_amdgcn_mfma_f32_32x32x16_bf16(kf[6],qr[3],C0,0,0,0),   P1[10],P1[11],P1[12],P1[13], pw3[0]=PKW(P1,8), pw3[1]=PKW(P1,10), pw3); \
    VRD(7); SBAR(); GAPA(C1=__builtin_amdgcn_mfma_f32_32x32x16_bf16(kf[7],qr[3],C1,0,0,0),   P1[14],P1[15],0.f,0.f,       pw3[2]=PKW(P1,12),pw3[3]=PKW(P1,14), pw3); \
    l_reg+=sacc; \
    if(GK){DMA_K((t)+3,sl_cur);} if(GV){DMA_V((t)+1,sl_next);} \
    SBAR(); \
    GAPB(o[0]=__builtin_amdgcn_mfma_f32_32x32x16_bf16(PAF(0),VFR(0),o[0],0,0,0), C0,0); \
    GAPB(o[1]=__builtin_amdgcn_mfma_f32_32x32x16_bf16(PAF(0),VFR(4),o[1],0,0,0), C0,4); \
    KRD(GL,0); GAPB(o[0]=__builtin_amdgcn_mfma_f32_32x32x16_bf16(PAF(1),VFR(1),o[0],0,0,0), C0,8); \
    KRD(GL,1); GAPB(o[1]=__builtin_amdgcn_mfma_f32_32x32x16_bf16(PAF(1),VFR(5),o[1],0,0,0), C0,12); \
    KRD(GL,2); GAPB(o[0]=__builtin_amdgcn_mfma_f32_32x32x16_bf16(PAF(2),VFR(2),o[0],0,0,0), C1,0); \
    KRD(GL,3); GAPB(o[1]=__builtin_amdgcn_mfma_f32_32x32x16_bf16(PAF(2),VFR(6),o[1],0,0,0), C1,4); \
    GAPB(o[0]=__builtin_amdgcn_mfma_f32_32x32x16_bf16(PAF(3),VFR(3),o[0],0,0,0), C1,8); \
    GAPB(o[1]=__builtin_amdgcn_mfma_f32_32x32x16_bf16(PAF(3),VFR(7),o[1],0,0,0), C1,12); \
    }while(0)
  int t=1;
  for(;t+5<NT;t+=2){
    STEP(pB0,pB1,pA0,pA1,t,true,true,true);     WAIT_BAR(2); RESC(); ROT();
    STEP(pA0,pA1,pB0,pB1,t+1,true,true,true);   WAIT_BAR(2); RESC(); ROT();
  }
  #define ENDW(tt) do{ if((tt)+3<NT){WAIT_BAR(2);} else if((tt)+2<NT){WAIT_BAR(1);} else {WAIT_BAR(0);} }while(0)
  for(;t+1<NT;t+=2){
    STEP(pB0,pB1,pA0,pA1,t,(t+3<NT),(t+1<NT),(t+1<NT));       ENDW(t);   RESC(); ROT();
    STEP(pA0,pA1,pB0,pB1,t+1,(t+4<NT),(t+2<NT),(t+2<NT));     ENDW(t+1); RESC(); ROT();
  }
  STEP(pB0,pB1,pA0,pA1,NT-1,false,false,false); RESC();
  { float sacc=pB0[0]+pB0[1]; _Pragma("unroll") for(int r=2;r<16;++r)sacc+=pB0[r]; _Pragma("unroll") for(int r=0;r<16;++r)sacc+=pB1[r]; l_reg+=sacc;
    pw0=(u32x4){PKW(pB0,0),PKW(pB0,2),PKW(pB0,4),PKW(pB0,6)};pw1=(u32x4){PKW(pB0,8),PKW(pB0,10),PKW(pB0,12),PKW(pB0,14)};pw2=(u32x4){PKW(pB1,0),PKW(pB1,2),PKW(pB1,4),PKW(pB1,6)};pw3=(u32x4){PKW(pB1,8),PKW(pB1,10),PKW(pB1,12),PKW(pB1,14)};
    SBAR(); pv(o,vb0+sl_cur,PAF(0),PAF(1),PAF(2),PAF(3)); }
  #undef PKW
  #undef PAF
  #undef VFR
  #undef PIN
  #undef MX3
  #undef GAPA
  #undef GAPB
  #undef EX
  #undef VRD
  #undef KRD
  #undef STEP
  #undef ENDW
  if(issue_next){ asm volatile("s_waitcnt lgkmcnt(0)\n\ts_barrier":::"memory");
    DMA_K(0,0);DMA_V(0,0);DMA_K(1,SLOTB);DMA_K(2,2*SLOTB); }
  {auto rr=__builtin_amdgcn_permlane32_swap(__float_as_uint(l_reg),__float_as_uint(l_reg),false,false);l_reg=__uint_as_float(rr[0])+__uint_as_float(rr[1]);}
  if(hi==0)wsf[32+r32]=l_reg;asm volatile("s_waitcnt lgkmcnt(0)":::"memory");
  float rli[16];
  #pragma unroll
  for(int r=0;r<16;++r)rli[r]=__builtin_amdgcn_rcpf(wsf[32+crow(r,hi)]);
  bf16r*Ow=O+(rowbase+q0+wid*QBLK)*OP+h*D;
  { __hip_bfloat16*stg=(__hip_bfloat16*)(shm+LDS_OST)+wid*2048;
    #pragma unroll
    for(int r=0;r<16;++r){const int orow=crow(r,hi);
      #pragma unroll
      for(int d0=0;d0<2;++d0)stg[orow*64+d0*32+r32]=__float2bfloat16(o[d0][r]*rli[r]);}
    asm volatile("s_waitcnt lgkmcnt(0)":::"memory");
    #pragma unroll
    for(int i=0;i<4;++i){const int row=i*8+(lane>>3),ch=lane&7; const u32x4 v=*(const u32x4*)(stg+row*64+ch*8); *(u32x4*)(Ow+(long)row*OP+ch*8)=v;} }
  asm volatile("s_waitcnt lgkmcnt(0)\n\ts_barrier":::"memory");
  #undef DMA_K
  #undef DMA_V
  #undef START
  #undef RESC
  #undef ROT
}
#undef SBAR
#undef WAIT_BAR
}

#define XB_TMO      128
#define XB_XCNT(j)  (256  + 64 * (j))
#define XB_XSUB(j)  (1280 + 64 * (j))
#define XB_XGEN(j)  (2304 + 64 * (j))
#define XB_TOP      3328
#define XB_TOPGEN   3392
#define XCD_BAR_WORDS 3456
#define XB_SPIN_CAP (1u << 18)

__device__ __forceinline__ unsigned xb_ld(unsigned* p)              { return __hip_atomic_load(p, __ATOMIC_RELAXED, __HIP_MEMORY_SCOPE_AGENT); }
__device__ __forceinline__ unsigned xb_add(unsigned* p, unsigned v) { return __hip_atomic_fetch_add(p, v, __ATOMIC_RELAXED, __HIP_MEMORY_SCOPE_AGENT); }
__device__ __forceinline__ unsigned xb_xcc_id() { return (unsigned)__builtin_amdgcn_s_getreg((3 << 11) | 20) & 0xFu; }
#define XB_SPIN(cond, bar) do { unsigned _sp = 0; while (cond) { __builtin_amdgcn_s_sleep(1); \
    if ((++_sp & 255u) == 0u) { if (xb_ld(&(bar)[XB_TMO])) break; if (_sp > XB_SPIN_CAP) { atomicAdd(&(bar)[XB_TMO], 1u); break; } } } } while (0)

struct XcdBarrier {
    unsigned* bar; unsigned x;
    volatile LAS unsigned* st;
};

__device__ __forceinline__ XcdBarrier xcd_barrier_post(unsigned* bar, volatile LAS unsigned* st) {
    XcdBarrier b; b.bar = bar; b.x = xb_xcc_id(); b.st = st;
    if (threadIdx.x == 0) (void)xb_add(&bar[XB_XCNT(b.x)], 1u);
    return b;
}
__device__ __forceinline__ void xcd_barrier_complete(unsigned* bar, unsigned x, unsigned& nloc, unsigned& nx) {
    const unsigned G = gridDim.x * gridDim.y * gridDim.z;
    unsigned sum, cnt, mine, sp = 0u;
    for (;;) {
        sum = 0u; cnt = 0u; mine = 0u;
#pragma unroll
        for (unsigned j = 0; j < 16; ++j) { const unsigned c = xb_ld(&bar[XB_XCNT(j)]); sum += c; cnt += (c > 0u) ? 1u : 0u; mine = (j == x) ? c : mine; }
        if (sum == G) break;
        __builtin_amdgcn_s_sleep(1);
        if ((++sp & 255u) == 0u) { if (xb_ld(&bar[XB_TMO])) break; if (sp > XB_SPIN_CAP) { atomicAdd(&bar[XB_TMO], 1u); break; } }
    }
    nloc = mine > 0u ? mine : 1u; nx = cnt > 0u ? cnt : 1u;
}

__device__ __forceinline__ void xcd_barrier(const XcdBarrier& b) {
    asm volatile("s_waitcnt vmcnt(0)" ::: "memory");
    __syncthreads();
    if (threadIdx.x == 0) {
        unsigned* bar = b.bar;
        __builtin_amdgcn_s_waitcnt(0);
        unsigned nloc = b.st[0], nx = b.st[1];
        if (nloc == 0u) { xcd_barrier_complete(bar, b.x, nloc, nx); b.st[0] = nloc; b.st[1] = nx; }
        const unsigned old = xb_add(&bar[XB_XSUB(b.x)], 1u);
        const unsigned gen = old / nloc;
        if (old + 1u == (gen + 1u) * nloc) {
            __builtin_amdgcn_fence(__ATOMIC_RELEASE, "agent");
            asm volatile("s_waitcnt vmcnt(0)" ::: "memory");
            const unsigned og = xb_add(&bar[XB_TOP], 1u);
            const unsigned tg = og / nx;
            if (og + 1u == (tg + 1u) * nx) xb_add(&bar[XB_TOPGEN], 1u);
            else XB_SPIN(xb_ld(&bar[XB_TOPGEN]) == tg, bar);
            __builtin_amdgcn_fence(__ATOMIC_ACQUIRE, "agent");
            xb_add(&bar[XB_XGEN(b.x)], 1u);
            asm volatile("s_waitcnt vmcnt(0)" ::: "memory");
        } else {
            XB_SPIN(xb_ld(&bar[XB_XGEN(b.x)]) == gen, bar);
            __builtin_amdgcn_fence(__ATOMIC_ACQUIRE, "agent");
            asm volatile("s_waitcnt vmcnt(0)" ::: "memory");
        }
    }
    __syncthreads();
}


struct Frame {
    LAS unsigned char* lds;
    int tid, lane, wave;
    int vcu, G;
    unsigned flags;
};
struct Args { const float* in[25]; float* out; unsigned char* ws; unsigned mask, pad; };

__device__ __forceinline__ void p0_transpose_item(const float* W, int K, int N, bf16* WT, int k0, int n0, int v0, LAS float* scr, int lane, const float* ksc = nullptr, int kmode = 0) {
#pragma unroll 8
    for (int i = 0; i < 32; ++i) { const int kk = 2 * i + (lane >> 5); float wv = W[(size_t)(k0 + kk) * N + n0 + (lane & 31)];
        if (ksc) { const float mv = ksc[k0 + kk]; wv *= (kmode == 1) ? (1.0f - mv) : (0.5f * mv); }
        scr[kk * 33 + (lane & 31)] = wv; }
    LDS_WAIT(); asm volatile("" ::: "memory");
    const int c = lane & 7;
#pragma unroll
    for (int j = 0; j < 4; ++j) { const int n = (lane >> 3) + 8 * j; const LAS float* s = scr + (8 * c) * 33 + n;
        v4u o; o.x = pk2(s[0 * 33], s[1 * 33]); o.y = pk2(s[2 * 33], s[3 * 33]); o.z = pk2(s[4 * 33], s[5 * 33]); o.w = pk2(s[6 * 33], s[7 * 33]);
        *(GAS v4u*)(WT + (size_t)(v0 + n) * K + k0 + 8 * c) = o; }
    LDS_WAIT(); asm volatile("" ::: "memory");
}
__device__ __forceinline__ void p0_transpose_item_fp8(const float* W, int K, int N, unsigned char* WT, int k0, int n0, int v0, LAS float* scr, int lane, float sc, bool remap16 = false) {
#pragma unroll 8
    for (int i = 0; i < 32; ++i) { const int kk = 2 * i + (lane >> 5); scr[kk * 33 + (lane & 31)] = W[(size_t)(k0 + kk) * N + n0 + (lane & 31)] * sc; }
    LDS_WAIT(); asm volatile("" ::: "memory");
    const int c = lane & 7;
#pragma unroll
    for (int j = 0; j < 4; ++j) { const int n = (lane >> 3) + 8 * j; const LAS float* s = scr + (8 * c) * 33 + n;
        unsigned w0 = 0u, w1 = 0u;
        w0 = cvt2_fp8(s[0 * 33], s[1 * 33], w0, false); w0 = cvt2_fp8(s[2 * 33], s[3 * 33], w0, true);
        w1 = cvt2_fp8(s[4 * 33], s[5 * 33], w1, false); w1 = cvt2_fp8(s[6 * 33], s[7 * 33], w1, true);
        v2u o; o.x = w0; o.y = w1;
        int vr = v0 + n;
        if (remap16) { const int t = (n0 & 255) + n, wc = t >> 6, fq = (t >> 4) & 3, bj = (t >> 3) & 1; vr = (n0 & ~255) + 128 * bj + 32 * wc + 8 * fq + (t & 7); }
        *(GAS v2u*)(WT + (size_t)vr * K + k0 + 8 * c) = o; }
    LDS_WAIT(); asm volatile("" ::: "memory");
}
struct ExpItem { const float* W; unsigned char* WT; int k0, n0, v0; bool remap; };
__device__ __forceinline__ ExpItem exp_item(const Args& a, int r) {
    constexpr int I_E = (DM / 64) * (FF / 32);
    const int mat = r / I_E, rr = r % I_E, which = mat / NE, e = mat % NE; const int nblk = FF / 32, kb = rr / nblk, nb = rr % nblk, n0 = 32 * nb;
    ExpItem it; it.k0 = 64 * kb; it.n0 = n0; it.remap = false;
    if (which == 0) { it.W = a.in[22] + (size_t)e * DM * FF; it.WT = a.ws + WS_WGU + (size_t)e * 2 * FF * DM; it.v0 = 256 * (n0 >> 7) + (n0 & 127); }
    else if (which == 1) { it.W = a.in[23] + (size_t)e * DM * FF; it.WT = a.ws + WS_WGU + (size_t)e * 2 * FF * DM; it.v0 = 256 * (n0 >> 7) + 128 + (n0 & 127); }
    else { it.W = a.in[24] + (size_t)e * FF * DM; it.WT = a.ws + WS_WD + (size_t)e * DM * FF; it.v0 = n0; it.remap = true; }
    return it;
}
__device__ __forceinline__ void exp_item_load(const ExpItem& it, float (&t)[32], int lane) {
#pragma unroll
    for (int i = 0; i < 32; ++i) { const int kk = 2 * i + (lane >> 5); t[i] = it.W[(size_t)(it.k0 + kk) * FF + it.n0 + (lane & 31)]; }
}
__device__ __forceinline__ void exp_item_store(const ExpItem& it, const float (&t)[32], LAS float* scr, int lane) {
#pragma unroll
    for (int i = 0; i < 32; ++i) { const int kk = 2 * i + (lane >> 5); scr[kk * 33 + (lane & 31)] = t[i] * 32.0f; }
    LDS_WAIT(); asm volatile("" ::: "memory");
    const int c = lane & 7;
#pragma unroll
    for (int j = 0; j < 4; ++j) { const int n = (lane >> 3) + 8 * j; const LAS float* s = scr + (8 * c) * 33 + n;
        unsigned w0 = 0u, w1 = 0u;
        w0 = cvt2_fp8(s[0 * 33], s[1 * 33], w0, false); w0 = cvt2_fp8(s[2 * 33], s[3 * 33], w0, true);
        w1 = cvt2_fp8(s[4 * 33], s[5 * 33], w1, false); w1 = cvt2_fp8(s[6 * 33], s[7 * 33], w1, true);
        v2u o; o.x = w0; o.y = w1;
        int vr = it.v0 + n;
        if (it.remap) { const int tt = (it.n0 & 255) + n, wc = tt >> 6, fq = (tt >> 4) & 3, bj = (tt >> 3) & 1; vr = (it.n0 & ~255) + 128 * bj + 32 * wc + 8 * fq + (tt & 7); }
        *(GAS v2u*)(it.WT + (size_t)vr * 1024 + it.k0 + 8 * c) = o; }
    LDS_WAIT(); asm volatile("" ::: "memory");
}
__host__ __device__ __forceinline__ int win_virt32(int n0) { const int tile = n0 >> 8, t = n0 & 255, wc = t >> 6, bj = (t >> 5) & 1; return 256 * tile + 128 * bj + 32 * wc; }

__device__ __forceinline__ void p0_prologue(Frame& F, const Args& a) {
    unsigned char* ws = a.ws;
    if (F.vcu < 192) {
        LAS float* st = (LAS float*)F.lds;
        const float* c = a.in[1];
        for (int i = F.tid; i < NB * DM; i += 512) { const float v = c[i]; st[i] = v / (1.0f + __expf(-v)); }
        __syncthreads();
        const int cc = F.tid & 31, kg = F.tid >> 5, col0 = F.vcu * 32;
        const float* wa = a.in[2] + (size_t)(kg * 64) * (6 * DM) + col0 + cc;
        float acc[32];
#pragma unroll
        for (int b = 0; b < 32; ++b) acc[b] = 0.f;
        for (int k = 0; k < 64; ++k) {
            const float wv = wa[(size_t)k * (6 * DM)];
            const LAS float* sp = st + kg * 64 + k;
#pragma unroll
            for (int b = 0; b < 32; ++b) acc[b] += sp[b * DM] * wv;
        }
        __syncthreads();
        LAS float* part = (LAS float*)F.lds;
#pragma unroll
        for (int b = 0; b < 32; ++b) part[(kg * 32 + b) * 32 + cc] = acc[b];
        __syncthreads();
        float* mod = (float*)(ws + WS_MOD);
        for (int o = F.tid; o < 1024; o += 512) { const int b = o >> 5, c2 = o & 31; float s = a.in[3][col0 + c2];
#pragma unroll
            for (int g = 0; g < 16; ++g) s += part[(g * 32 + b) * 32 + c2];
            mod[b * (6 * DM) + col0 + c2] = s; }
        __syncthreads();
    } else {
        float* rope = (float*)(ws + WS_ROPE);
        for (int j = (F.vcu - 192) * 512 + F.tid; j < SEQ * 32; j += 64 * 512) {
            const int t = j >> 5, i = j & 31;
            const float pos = (i < 16) ? (float)(t >> 6) : (float)(t & 63);
            const float freq = powf(10000.0f, -(float)(i & 15) / 16.0f);
            const float ang = pos * freq;
            rope[2 * j] = cosf(ang); rope[2 * j + 1] = sinf(ang);
        }
    }
    LAS float* scr = (LAS float*)(F.lds + F.wave * 16384);
    const int gw = F.vcu * NWAVES + F.wave, NGW = F.G * NWAVES;
    constexpr int I_IN = (DM / 64) * (NIN / 32), I_OUT = (DM / 64) * (DM / 32), I_E = (DM / 64) * (FF / 32), I_GUP = (128 / 64) * (RW / 32);
    constexpr int I_LORA = 6 * (RW / 32);
    constexpr int NITEMS = I_IN + I_OUT + I_GUP + I_LORA;
    for (int it = gw; it < NITEMS; it += NGW) {
        int r = it;
        if (r < I_IN) { const int nblk = NIN / 32, kb = r / nblk, nb = r % nblk; p0_transpose_item(a.in[5], DM, NIN, (bf16*)(ws + WS_WIN), 64 * kb, 32 * nb, win_virt32(32 * nb), scr, F.lane); continue; } r -= I_IN;
        if (r < I_OUT) { const int nblk = DM / 32, kb = r / nblk, nb = r % nblk; p0_transpose_item(a.in[19], DM, DM, (bf16*)(ws + WS_WOUT), 64 * kb, 32 * nb, 32 * nb, scr, F.lane); continue; } r -= I_OUT;
        if (r < I_GUP) { const int nblk = RW / 32, kb = r / nblk, nb = r % nblk; p0_transpose_item(a.in[13], 128, RW, (bf16*)(ws + WS_GUPT), 64 * kb, 32 * nb, 32 * nb, scr, F.lane); continue; } r -= I_GUP;
        { const int nblk = RW / 32, md = r / nblk, nb = r % nblk, which = md >> 1, d = md & 1;
          if (which == 0) p0_transpose_item(a.in[10] + (size_t)d * 64 * RW, 64, RW, (bf16*)(ws + WS_WUPT) + (size_t)d * RW * 64, 0, 32 * nb, 32 * nb, scr, F.lane);
          else if (which == 1) p0_transpose_item(a.in[12] + (size_t)d * 64 * RW, 64, RW, (bf16*)(ws + WS_AUPT) + (size_t)d * RW * 64, 0, 32 * nb, 32 * nb, scr, F.lane); }
    }
}

__device__ __forceinline__ void p1_norm(Frame& F, const Args& a) {
    const float* mod = (const float*)(a.ws + WS_MOD); bf16* H = (bf16*)(a.ws + WS_H);
    const int gw = F.vcu * NWAVES + F.wave; const int b = F.vcu >> 3;
    f32x4 gs[4], sh[4];
#pragma unroll
    for (int j = 0; j < 4; ++j) { const int c = 4 * F.lane + 256 * j; const f32x4 g = *(const f32x4*)(a.in[4] + c); const f32x4 sc = *(const f32x4*)(mod + b * 6 * DM + DM + c);
        gs[j] = g * (sc + 1.0f); sh[j] = *(const f32x4*)(mod + b * 6 * DM + c); }
    f32x4 vn[4][4];
#pragma unroll
    for (int r = 0; r < 4; ++r) { const GAS f32x4* xr = (const GAS f32x4*)(a.in[0] + ((size_t)gw * 32 + r) * DM) + F.lane;
#pragma unroll
        for (int j = 0; j < 4; ++j) vn[r][j] = xr[64 * j]; }
    for (int i = 0; i < 32; i += 4) {
        const size_t row = (size_t)gw * 32 + i;
        f32x4 v[4][4]; float s2[4];
#pragma unroll
        for (int r = 0; r < 4; ++r)
#pragma unroll
            for (int j = 0; j < 4; ++j) v[r][j] = vn[r][j];
        if (i + 4 < 32) {
#pragma unroll
            for (int r = 0; r < 4; ++r) { const GAS f32x4* xr = (const GAS f32x4*)(a.in[0] + (row + 4 + r) * DM) + F.lane;
#pragma unroll
                for (int j = 0; j < 4; ++j) vn[r][j] = xr[64 * j]; } }
        asm volatile("" ::: "memory");
#pragma unroll
        for (int r = 0; r < 4; ++r) { float t = 0.f;
#pragma unroll
            for (int j = 0; j < 4; ++j) t += (v[r][j].x * v[r][j].x + v[r][j].y * v[r][j].y) + (v[r][j].z * v[r][j].z + v[r][j].w * v[r][j].w);
            s2[r] = t; }
#pragma unroll
        for (int r = 0; r < 4; ++r) s2[r] = wave_sum(s2[r]);
#pragma unroll
        for (int r = 0; r < 4; ++r) { const float rstd = 1.0f / sqrtf(s2[r] * (1.0f / DM) + NORM_EPS);
            GAS unsigned long long* o8 = (GAS unsigned long long*)(H + (row + r) * DM) + F.lane;
#pragma unroll
            for (int j = 0; j < 4; ++j) { const f32x4 y = v[r][j] * rstd * gs[j] + sh[j]; o8[64 * j] = (unsigned long long)pk2(y.x, y.y) | ((unsigned long long)pk2(y.z, y.w) << 32); } }
    }
}

struct EpiInProj {
    static constexpr bool PERM = true;
    bf16 *Q, *K, *V, *PR; const float *qn, *kn, *rope;
    __device__ __forceinline__ void operator()(const f32x4 (&acc)[2][2][4][2], const pg8::Unit& u, int wr, int wc, int fr, int fq) const {
        { int l_ = threadIdx.x; asm volatile("" : "+v"(l_)); fr = l_ & 15; fq = (l_ >> 4) & 3; }
        const int row0 = u.pm * 256 + wr * 64 + fr;
        if (u.pn >= 3) {
            const int col0 = 256 * (u.pn - 3) + 64 * wc + 8 * fq;
#pragma unroll
            for (int ai = 0; ai < 2; ++ai)
#pragma unroll
                for (int m = 0; m < 4; ++m) { bf16* rowp = PR + (size_t)(row0 + ai * 128 + m * 16) * NSH + col0;
#pragma unroll
                    for (int bj = 0; bj < 2; ++bj) { const f32x4 v0 = acc[ai][bj][m][0], v1 = acc[ai][bj][m][1];
                        v4u w; w.x = pk2(v0[0], v0[1]); w.y = pk2(v0[2], v0[3]); w.z = pk2(v1[0], v1[1]); w.w = pk2(v1[2], v1[3]);
                        *(v4u*)(rowp + 32 * bj) = w; } }
            return;
        }
        const bool isV = (u.pn == 2 && wc >= 2);
        if (isV) {
            const int col0 = 64 * (wc - 2) + 8 * fq;
#pragma unroll
            for (int ai = 0; ai < 2; ++ai)
#pragma unroll
                for (int m = 0; m < 4; ++m) { bf16* rowp = V + (size_t)(row0 + ai * 128 + m * 16) * KVW + col0;
#pragma unroll
                    for (int bj = 0; bj < 2; ++bj) { const f32x4 v0 = acc[ai][bj][m][0], v1 = acc[ai][bj][m][1];
                        v4u w; w.x = pk2(v0[0], v0[1]); w.y = pk2(v0[2], v0[3]); w.z = pk2(v1[0], v1[1]); w.w = pk2(v1[2], v1[3]);
                        *(v4u*)(rowp + 32 * bj) = w; } }
            return;
        }
        const bool isQ = (u.pn < 2);
        const float* gn = isQ ? qn : kn;
        bf16* dst = isQ ? (Q + 64 * (4 * u.pn + wc)) : (K + 64 * wc);
        const int pitch = isQ ? AW : KVW;
        const float osc = isQ ? QSCALE : 1.0f;
        f32x4 gv[2][2];
#pragma unroll
        for (int bj = 0; bj < 2; ++bj)
#pragma unroll
            for (int n = 0; n < 2; ++n) gv[bj][n] = *(const f32x4*)(gn + 32 * bj + 8 * fq + 4 * n);
#pragma unroll
        for (int ai = 0; ai < 2; ++ai) {
            f32x4 csv[4][2][2];
#pragma unroll
            for (int m = 0; m < 4; ++m) { const int t = (row0 + ai * 128 + m * 16) & (SEQ - 1);
#pragma unroll
                for (int bj = 0; bj < 2; ++bj)
#pragma unroll
                    for (int n = 0; n < 2; ++n) csv[m][bj][n] = *(const f32x4*)(rope + ((size_t)t * 32 + 16 * bj + 4 * fq + 2 * n) * 2); }
            asm volatile("" ::: "memory");
#pragma unroll
            for (int m = 0; m < 4; ++m) {
                const int row = row0 + ai * 128 + m * 16;
                float ss = 0.f;
#pragma unroll
                for (int bj = 0; bj < 2; ++bj)
#pragma unroll
                    for (int n = 0; n < 2; ++n) { const f32x4 x = acc[ai][bj][m][n]; ss += (x[0] * x[0] + x[1] * x[1]) + (x[2] * x[2] + x[3] * x[3]); }
                ss = xor32_sum(xor16_sum(ss));
                const float rstd = 1.0f / sqrtf(ss * (1.0f / 64.0f) + NORM_EPS);
                bf16* rowp = dst + (size_t)row * pitch + 8 * fq;
#pragma unroll
                for (int bj = 0; bj < 2; ++bj) {
                    unsigned w[4];
#pragma unroll
                    for (int n = 0; n < 2; ++n) {
                        const f32x4 x = acc[ai][bj][m][n] * rstd * gv[bj][n];
                        const f32x4 cs = csv[m][bj][n];
                        const float o0 = x[0] * cs[0] - x[1] * cs[1], o1 = x[0] * cs[1] + x[1] * cs[0];
                        const float o2 = x[2] * cs[2] - x[3] * cs[3], o3 = x[2] * cs[3] + x[3] * cs[2];
                        w[2 * n] = pk2(o0 * osc, o1 * osc); w[2 * n + 1] = pk2(o2 * osc, o3 * osc);
                    }
                    v4u wv; wv.x = w[0]; wv.y = w[1]; wv.z = w[2]; wv.w = w[3];
                    *(v4u*)(rowp + 32 * bj) = wv;
                }
            }
            asm volatile("" ::: "memory");
        }
    }
};

struct EpiOutProj {
    static constexpr bool PERM = true;
    const float* x; bf16* x1; const float* mod;
    __device__ __forceinline__ void operator()(const f32x4 (&acc)[2][2][4][2], const pg8::Unit& u, int wr, int wc, int fr, int fq) const {
        { int l_ = threadIdx.x; asm volatile("" : "+v"(l_)); fr = l_ & 15; fq = (l_ >> 4) & 3; }
        const int row0 = u.pm * 256 + wr * 64 + fr, col0 = u.pn * 256 + wc * 32 + 8 * fq; const int b = u.pm >> 3;
        f32x4 gt[2][2];
#pragma unroll
        for (int bj = 0; bj < 2; ++bj)
#pragma unroll
            for (int n = 0; n < 2; ++n) gt[bj][n] = *(const f32x4*)(mod + b * 6 * DM + 2 * DM + col0 + bj * 128 + n * 4);
#pragma unroll
        for (int ai = 0; ai < 2; ++ai) {
            f32x4 xv[4][2][2];
#pragma unroll
            for (int m = 0; m < 4; ++m) { const size_t off = (size_t)(row0 + ai * 128 + m * 16) * DM + col0;
#pragma unroll
                for (int bj = 0; bj < 2; ++bj)
#pragma unroll
                    for (int n = 0; n < 2; ++n) xv[m][bj][n] = *(const f32x4*)(x + off + bj * 128 + n * 4); }
            asm volatile("" ::: "memory");
#pragma unroll
            for (int m = 0; m < 4; ++m) { const size_t off = (size_t)(row0 + ai * 128 + m * 16) * DM + col0;
#pragma unroll
                for (int bj = 0; bj < 2; ++bj) { const f32x4 v0 = xv[m][bj][0] + gt[bj][0] * acc[ai][bj][m][0], v1 = xv[m][bj][1] + gt[bj][1] * acc[ai][bj][m][1];
                    v4u w; w.x = pk2(v0[0], v0[1]); w.y = pk2(v0[2], v0[3]); w.z = pk2(v1[0], v1[1]); w.w = pk2(v1[2], v1[3]);
                    *(v4u*)(x1 + off + bj * 128) = w; } }
            asm volatile("" ::: "memory");
        }
    }
};


__device__ __forceinline__ void prs_pass(Frame& F, const Args& a) {
    const bf16* __restrict__ PR = (const bf16*)(a.ws + WS_PR); bf16* __restrict__ RK = (bf16*)(a.ws + WS_RKVS); bf16* __restrict__ TD = (bf16*)(a.ws + WS_TDS);
    const float* __restrict__ mu = a.in[8];
    const int lane = F.lane; const int b = F.vcu >> 3;
    f32x4 mus[7];
#pragma unroll
    for (int cs = 0; cs < 7; ++cs) mus[cs] = *(const f32x4*)(mu + 256 * cs + 4 * lane);
    v2u xn[7][6];
#define PRS_LOAD(G) do { _Pragma("unroll") for (int r = 0; r < 6; ++r) { int t_ = 4 * (G) - 1 + r; t_ = t_ < 0 ? 0 : t_ > SEQ - 1 ? SEQ - 1 : t_; \
            const bf16* rp_ = PR + ((size_t)b * SEQ + t_) * NSH + 4 * lane; _Pragma("unroll") for (int cs = 0; cs < 7; ++cs) xn[cs][r] = *(const v2u*)(rp_ + 256 * cs); } } while (0)
    PRS_LOAD((F.vcu & 7) * 64 + F.wave * 8);
    for (int it = 0; it < 8; ++it) {
        const int g = (F.vcu & 7) * 64 + F.wave * 8 + it;
        const size_t row0 = (size_t)b * SEQ + 4 * g;
        v2u x[7][6];
#pragma unroll
        for (int cs = 0; cs < 7; ++cs)
#pragma unroll
            for (int r = 0; r < 6; ++r) x[cs][r] = xn[cs][r];
        if (it + 1 < 8) PRS_LOAD(g + 1);
        asm volatile("" ::: "memory");
        if (g == 0) {
#pragma unroll
            for (int cs = 0; cs < 7; ++cs) x[cs][0] = (v2u){0u, 0u}; }
        if (g == SEQ / 4 - 1) {
#pragma unroll
            for (int cs = 0; cs < 7; ++cs) x[cs][5] = (v2u){0u, 0u}; }
#pragma unroll
        for (int cs = 0; cs < 7; ++cs) {
            float y[4][4];
#pragma unroll
            for (int e = 0; e < 4; ++e) { const v2u c = x[cs][e + 1], p = x[cs][e], n = x[cs][e + 2];
                const float c0 = bflo(c.x), c1 = bfhi(c.x), c2 = bflo(c.y), c3 = bfhi(c.y);
                y[e][0] = c0 + mus[cs][0] * (0.5f * (bflo(p.x) + bflo(n.x)) - c0); y[e][1] = c1 + mus[cs][1] * (0.5f * (bfhi(p.x) + bfhi(n.x)) - c1);
                y[e][2] = c2 + mus[cs][2] * (0.5f * (bflo(p.y) + bflo(n.y)) - c2); y[e][3] = c3 + mus[cs][3] * (0.5f * (bfhi(p.y) + bfhi(n.y)) - c3); }
            if (cs < 6) {
                bf16* dst = RK + (((size_t)b * (SEQ / 4) + g) * 1536 + 256 * cs + 4 * lane) * 4;
                v4u w0, w1;
                w0.x = pk2(y[0][0], y[1][0]); w0.y = pk2(y[2][0], y[3][0]); w0.z = pk2(y[0][1], y[1][1]); w0.w = pk2(y[2][1], y[3][1]);
                w1.x = pk2(y[0][2], y[1][2]); w1.y = pk2(y[2][2], y[3][2]); w1.z = pk2(y[0][3], y[1][3]); w1.w = pk2(y[2][3], y[3][3]);
                *(v4u*)dst = w0; *(v4u*)(dst + 8) = w1;
            } else {
#pragma unroll
                for (int e = 0; e < 4; ++e) { float o[4];
#pragma unroll
                    for (int j = 0; j < 4; ++j) { const float v = y[e][j]; const float th = 1.0f - 2.0f * __builtin_amdgcn_rcpf(__expf(2.0f * v) + 1.0f), sg = __builtin_amdgcn_rcpf(1.0f + __expf(-v));
                        o[j] = lane < 16 ? th : lane < 32 ? v : sg; }
                    v2u w; w.x = pk2(o[0], o[1]); w.y = pk2(o[2], o[3]);
                    *(v2u*)(TD + (row0 + e) * 256 + 4 * lane) = w; }
            }
        }
    }
}

#undef PRS_LOAD
namespace wkv {
constexpr int SLOT = 12544, O_AT = 0, O_RT = 2048, O_BT = 4096, O_KT = 6144, O_VT = 8192, O_MAK = 10240, O_MTM = 10752, O_MRB = 11264, O_MRK = 11776, O_GC = 12288;
typedef short v4i16_t __attribute__((ext_vector_type(4)));
typedef __bf16 bf16x2_t __attribute__((ext_vector_type(2)));
__device__ __forceinline__ unsigned cvtpk(float lo, float hi) { f32x2 v = {lo, hi}; bf16x2_t b = __builtin_convertvector(v, bf16x2_t); return __builtin_bit_cast(unsigned, b); }
__device__ __forceinline__ v2u pack4(const f32x4 v) { v2u r; r.x = cvtpk(v[0], v[1]); r.y = cvtpk(v[2], v[3]); return r; }
__device__ __forceinline__ bf16x8 frag(v2u lo, v2u hi) { v4u w; w.x = lo.x; w.y = lo.y; w.z = hi.x; w.w = hi.y; return __builtin_bit_cast(bf16x8, w); }
__device__ __forceinline__ bf16x8 frag4(const f32x4 v) { return frag(pack4(v), (v2u){0u, 0u}); }
__device__ __forceinline__ v2u trrd(LAS const unsigned char* p) { return __builtin_bit_cast(v2u, __builtin_amdgcn_ds_read_tr16_b64_v4i16((LAS v4i16_t*)p)); }
__device__ __forceinline__ bf16x8 trop(LAS const unsigned char* arr, int m, int lane) {
    LAS const unsigned char* p = arr + (32 * m + 4 * (lane >> 4) + ((lane & 15) >> 2)) * 32 + (lane & 3) * 8;
    return frag(trrd(p), trrd(p + 16 * 32));
}
#define MFMA16(A, B, C) __builtin_amdgcn_mfma_f32_16x16x32_bf16((A), (B), (C), 0, 0, 0)
__device__ __forceinline__ void up8(const v4u w, float (&o)[8]) { o[0] = bflo(w.x); o[1] = bfhi(w.x); o[2] = bflo(w.y); o[3] = bfhi(w.y); o[4] = bflo(w.z); o[5] = bfhi(w.z); o[6] = bflo(w.w); o[7] = bfhi(w.w); }
__device__ __forceinline__ bf16x8 pack8(const float (&o)[8]) { v4u w; w.x = cvtpk(o[0], o[1]); w.y = cvtpk(o[2], o[3]); w.z = cvtpk(o[4], o[5]); w.w = cvtpk(o[6], o[7]); return __builtin_bit_cast(bf16x8, w); }
__device__ __forceinline__ float dppf(float v, int ctrl_tag);
#define WKV_DPP_ADD(v, CTRL) ((v) + __builtin_bit_cast(float, __builtin_amdgcn_update_dpp(0, __builtin_bit_cast(int, (v)), (CTRL), 0xf, 0xf, false)))
__device__ __forceinline__ float red16(float v) { v = WKV_DPP_ADD(v, 0xB1); v = WKV_DPP_ADD(v, 0x4E); v = WKV_DPP_ADD(v, 0x141); v = WKV_DPP_ADD(v, 0x140); return v; }
__device__ __forceinline__ float fsig(float x) { return __builtin_amdgcn_rcpf(1.0f + __expf(-x)); }
constexpr int NRAW = 10;
constexpr int LORA_OFF = 8 * SLOT + 12 * 64 * 4, LORA_ROW = 144, LORA_TAB = 64 * LORA_ROW;
constexpr int CST_OFF = 8 * SLOT;
__device__ __forceinline__ void prep_load(v4u (&raw)[NRAW], const bf16* RK, const bf16* TD, int b, int h, int dir, int c, int lane) {
    const int kl = lane & 15, q = lane >> 4;
    const int g = dir ? (SEQ / 4 - 1 - (4 * c + q)) : (4 * c + q);
    const bf16* rp = RK + (((size_t)b * (SEQ / 4) + g) * 1536 + 64 * h + kl) * 4;
#pragma unroll
    for (int X = 0; X < 3; ++X)
#pragma unroll
        for (int cp = 0; cp < 2; ++cp) { const v2u lo = *(const v2u*)(rp + (512 * X + 16 * (2 * cp)) * 4), hi = *(const v2u*)(rp + (512 * X + 16 * (2 * cp + 1)) * 4);
            raw[X * 2 + cp] = (v4u){lo.x, lo.y, hi.x, hi.y}; }
    const int s_i = c * 16 + kl; const int t_i = dir ? (SEQ - 1 - s_i) : s_i;
    const bf16* tp = TD + ((size_t)b * SEQ + t_i) * 256 + 8 * q;
#pragma unroll
    for (int m = 0; m < 2; ++m) { raw[6 + m] = *(const v4u*)(tp + 32 * m); raw[8 + m] = *(const v4u*)(tp + 64 + 32 * m); }
}
__device__ __forceinline__ f32x4 up4(unsigned w0, unsigned w1, bool rev) {
    const f32x4 t = (f32x4){bflo(w0), bfhi(w0), bflo(w1), bfhi(w1)};
    return rev ? (f32x4){t[3], t[2], t[1], t[0]} : t;
}

__device__ __forceinline__ void prep(const v4u (&raw)[NRAW], const Args& a, int b, int h, int dir, int c, LAS unsigned char* slot, LAS const float* cst, int lane, bool nostore) {
    const int kl = lane & 15, q = lane >> 4;
    LAS const unsigned char* lw_ = (LAS const unsigned char*)cst + (LORA_OFF - CST_OFF) + dir * 2 * LORA_TAB; LAS const unsigned char* la_ = lw_ + LORA_TAB;
    float* BON = (float*)(a.ws + WS_BON) + (size_t)dir * MT * 8;
    const f32x4 z4 = (f32x4){0.f, 0.f, 0.f, 0.f};
    const bool rev = dir != 0;
    f32x4 wp[4], ap[4], rx[4], kx[4], vx[4];
#pragma unroll
    for (int ct = 0; ct < 4; ++ct) { wp[ct] = z4; ap[ct] = z4;
#pragma unroll
        for (int m = 0; m < 2; ++m) { const int off = (16 * ct + kl) * LORA_ROW + (32 * m + 8 * q) * 2;
            wp[ct] = MFMA16(__builtin_bit_cast(bf16x8, raw[6 + m]), *(const LAS bf16x8*)(lw_ + off), wp[ct]); ap[ct] = MFMA16(__builtin_bit_cast(bf16x8, raw[8 + m]), *(const LAS bf16x8*)(la_ + off), ap[ct]); } }
    if (rev) {
#pragma unroll
        for (int cp = 0; cp < 2; ++cp) {
            rx[2 * cp] = up4(raw[0 + cp].x, raw[0 + cp].y, true); rx[2 * cp + 1] = up4(raw[0 + cp].z, raw[0 + cp].w, true);
            kx[2 * cp] = up4(raw[2 + cp].x, raw[2 + cp].y, true); kx[2 * cp + 1] = up4(raw[2 + cp].z, raw[2 + cp].w, true);
            vx[2 * cp] = up4(raw[4 + cp].x, raw[4 + cp].y, true); vx[2 * cp + 1] = up4(raw[4 + cp].z, raw[4 + cp].w, true); }
    } else {
#pragma unroll
        for (int cp = 0; cp < 2; ++cp) {
            rx[2 * cp] = up4(raw[0 + cp].x, raw[0 + cp].y, false); rx[2 * cp + 1] = up4(raw[0 + cp].z, raw[0 + cp].w, false);
            kx[2 * cp] = up4(raw[2 + cp].x, raw[2 + cp].y, false); kx[2 * cp + 1] = up4(raw[2 + cp].z, raw[2 + cp].w, false);
            vx[2 * cp] = up4(raw[4 + cp].x, raw[4 + cp].y, false); vx[2 * cp + 1] = up4(raw[4 + cp].z, raw[4 + cp].w, false); }
    }
    f32x4 n2 = z4, bsum = z4;
    f32x4 av[4], kd[4];
#pragma unroll
    for (int ct = 0; ct < 4; ++ct) { const int cj = 16 * ct + kl;
        const float a0 = cst[(5 + dir) * 64 + cj], kkg = cst[9 * 64 + cj], kag = cst[10 * 64 + cj], rkg = cst[11 * 64 + cj];
#pragma unroll
        for (int e = 0; e < 4; ++e) { av[ct][e] = fsig(ap[ct][e] + a0); const float kkv = kx[ct][e] * kkg; n2[e] += kkv * kkv;
            kd[ct][e] = kx[ct][e] * (1.0f + (av[ct][e] - 1.0f) * kag); bsum[e] += rx[ct][e] * kd[ct][e] * rkg; } }
#pragma unroll
    for (int e = 0; e < 4; ++e) { n2[e] = red16(n2[e]); bsum[e] = red16(bsum[e]); }
    if (kl == 0 && !nostore) {
        const int s0 = c * 16 + 4 * q; const int t0 = rev ? (SEQ - 1 - s0 - 3) : s0;
        *(f32x4*)(BON + ((size_t)b * 8 + h) * SEQ + t0) = rev ? (f32x4){bsum[3], bsum[2], bsum[1], bsum[0]} : bsum; }
    f32x4 rn;
#pragma unroll
    for (int e = 0; e < 4; ++e) rn[e] = __builtin_amdgcn_rsqf(fmaxf(n2[e], 1e-24f));
#pragma unroll
    for (int ct = 0; ct < 4; ++ct) { const int cj = 16 * ct + kl;
        const float w0 = cst[(7 + dir) * 64 + cj], kkg = cst[9 * 64 + cj];
        f32x4 L, lw;
#pragma unroll
        for (int e = 0; e < 4; ++e) lw[e] = -DECAY_SCALE * fsig(wp[ct][e] + w0);
        L[0] = lw[0]; L[1] = L[0] + lw[1]; L[2] = L[1] + lw[2]; L[3] = L[2] + lw[3];
        const float g = L[3];
        const auto ra = __builtin_amdgcn_permlane16_swap(__float_as_uint(g), __float_as_uint(g), false, false);
        const float pair = __uint_as_float(ra[0]) + __uint_as_float(ra[1]);
        const auto rb = __builtin_amdgcn_permlane32_swap(__float_as_uint(pair), __float_as_uint(pair), false, false);
        const float P = ((q & 1) ? __uint_as_float(ra[0]) : 0.f) + ((q & 2) ? __uint_as_float(rb[0]) : 0.f);
        const float Ltot = __uint_as_float(rb[0]) + __uint_as_float(rb[1]);
        f32x4 ah, bh, kh, rh;
#pragma unroll
        for (int e = 0; e < 4; ++e) { const float Le = L[e] + P; const float ep = __expf(Le), en = __expf(-Le), epv = __expf(Le - lw[e]);
            const float kk = kx[ct][e] * kkg * rn[e];
            ah[e] = -kk * epv; bh[e] = kk * av[ct][e] * en; kh[e] = kd[ct][e] * en; rh[e] = rx[ct][e] * ep; }
        const int ro = (16 * ct + kl) * 32 + q * 8;
        *(LAS v2u*)(slot + O_AT + ro) = pack4(ah); *(LAS v2u*)(slot + O_BT + ro) = pack4(bh); *(LAS v2u*)(slot + O_KT + ro) = pack4(kh); *(LAS v2u*)(slot + O_RT + ro) = pack4(rh);
        *(LAS v2u*)(slot + O_VT + ro) = pack4(vx[ct]);
        if (q == 0) *(LAS float*)(slot + O_GC + (16 * ct + kl) * 4) = __expf(Ltot);
    }
    LDS_WAIT();
    f32x4 OA = z4, OAT = z4, OAK = z4, ORB = z4, ORK = z4;
#pragma unroll
    for (int m = 0; m < 2; ++m) { const bf16x8 tA = trop(slot + O_AT, m, lane), tB = trop(slot + O_BT, m, lane), tK = trop(slot + O_KT, m, lane), tR = trop(slot + O_RT, m, lane);
        OA = MFMA16(tA, tB, OA); OAT = MFMA16(tB, tA, OAT); OAK = MFMA16(tK, tA, OAK); ORB = MFMA16(tB, tR, ORB); ORK = MFMA16(tK, tR, ORK); }
    f32x4 Z;
#pragma unroll
    for (int e = 0; e < 4; ++e) { const int rr = 4 * q + e;
        OA[e] = (kl < rr) ? OA[e] : 0.f;
        OAT[e] = (rr < kl) ? OAT[e] : 0.f;
        OAK[e] = (rr < kl) ? OAK[e] : 0.f; ORB[e] = (rr <= kl) ? ORB[e] : 0.f; ORK[e] = (rr <= kl) ? ORK[e] : 0.f;
        Z[e] = OAT[e] + ((rr == kl) ? 1.0f : 0.f); }
    *(LAS v2u*)(slot + O_MAK + lane * 8) = pack4(OAK); *(LAS v2u*)(slot + O_MRB + lane * 8) = pack4(ORB); *(LAS v2u*)(slot + O_MRK + lane * 8) = pack4(ORK);
    const bf16x8 pA = frag4(OA), pAT = frag4(OAT);
    const f32x4 OA2 = MFMA16(pAT, pA, z4), OA2T = MFMA16(pA, pAT, z4);
    const bf16x8 pA2 = frag4(OA2), pA2T = frag4(OA2T);
    const f32x4 OA4 = MFMA16(pA2T, pA2, z4), OA4T = MFMA16(pA2, pA2T, z4);
    const bf16x8 pA4 = frag4(OA4), pA4T = frag4(OA4T);
    const f32x4 OA8 = MFMA16(pA4T, pA4, z4);
    Z = MFMA16(pA2, frag4(Z), Z);
    Z = MFMA16(pA4, frag4(Z), Z);
    Z = MFMA16(frag4(OA8), frag4(Z), Z);
    *(LAS v2u*)(slot + O_MTM + lane * 8) = pack4(Z);
}

__device__ __forceinline__ void scan_chunk(f32x4 (&acc)[4], LAS const unsigned char* slot, int vs, int lane, bf16* Ygrp, bool rev, bool nostore) {
    const int kl = lane & 15, q = lane >> 4;
    const f32x4 z4 = (f32x4){0.f, 0.f, 0.f, 0.f}; const v2u z2 = (v2u){0u, 0u};
    const bf16x8 Sb0 = frag(pack4(acc[0]), pack4(acc[1])), Sb1 = frag(pack4(acc[2]), pack4(acc[3]));
    const v2u Vv = *(const LAS v2u*)(slot + O_VT + (16 * vs + kl) * 32 + q * 8);
    f32x4 X = MFMA16(frag(*(const LAS v2u*)(slot + O_MAK + lane * 8), z2), frag(Vv, z2), z4);
    X = MFMA16(trop(slot + O_AT, 0, lane), Sb0, X); X = MFMA16(trop(slot + O_AT, 1, lane), Sb1, X);
    const f32x4 Ut = MFMA16(frag(*(const LAS v2u*)(slot + O_MTM + lane * 8), z2), frag4(X), z4);
    const bf16x8 UV = frag(pack4(Ut), Vv);
    f32x4 Yt = MFMA16(trop(slot + O_RT, 0, lane), Sb0, z4); Yt = MFMA16(trop(slot + O_RT, 1, lane), Sb1, Yt);
    Yt = MFMA16(frag(*(const LAS v2u*)(slot + O_MRB + lane * 8), *(const LAS v2u*)(slot + O_MRK + lane * 8)), UV, Yt);
    if (!nostore) { v2u w; if (rev) { w.x = cvtpk(Yt[3], Yt[2]); w.y = cvtpk(Yt[1], Yt[0]); } else { w.x = cvtpk(Yt[0], Yt[1]); w.y = cvtpk(Yt[2], Yt[3]); } *(v2u*)Ygrp = w; }
#pragma unroll
    for (int kt = 0; kt < 4; ++kt) {
        const int ro = (16 * kt + kl) * 32 + q * 8;
        acc[kt] = MFMA16(frag(*(const LAS v2u*)(slot + O_BT + ro), *(const LAS v2u*)(slot + O_KT + ro)), UV, acc[kt]);
        acc[kt] = acc[kt] * *(const LAS f32x4*)(slot + O_GC + (16 * kt + 4 * q) * 4);
    }
}

__device__ __forceinline__ void phase(Frame& F, const Args& a) {
    const int b = F.vcu >> 3, h = F.vcu & 7; const int w = F.wave, lane = F.lane;
    const int dir = w >> 2, vs = w & 3;
    LAS unsigned char* slots = F.lds;
    LAS float* cst = (LAS float*)(F.lds + CST_OFF);
    for (int idx = F.tid; idx < 12 * 64; idx += 512) { const int arr = idx >> 6, j = idx & 63; float v = 0.f;
        if (arr < 5) v = 0.f;
        else if (arr < 7) v = a.in[11][(arr - 5) * RW + 64 * h + j];
        else if (arr < 9) v = a.in[9][(arr - 7) * RW + 64 * h + j];
        else v = a.in[14 + (arr - 9)][64 * h + j];
        cst[idx] = v; }
    {
        const bf16* WU = (const bf16*)(a.ws + WS_WUPT); const bf16* AU = (const bf16*)(a.ws + WS_AUPT);
        for (int idx = F.tid; idx < 4 * 64 * 8; idx += 512) { const int ch16 = idx & 7, row = (idx >> 3) & 63, tb = idx >> 9; const int d = tb >> 1;
            const bf16* src = ((tb & 1) ? AU : WU) + ((size_t)d * RW + 64 * h + row) * 64 + 8 * ch16;
            *(LAS v4u*)(F.lds + LORA_OFF + tb * LORA_TAB + row * LORA_ROW + ch16 * 16) = *(const v4u*)src; }
    }
    const bf16* RK = (const bf16*)(a.ws + WS_RKVS); const bf16* TD = (const bf16*)(a.ws + WS_TDS);
    bf16* Y = (bf16*)(a.ws + (dir ? WS_YB : WS_YF)) + ((size_t)b * 8 + h) * (SEQ / 4) * 64 * 4;
    f32x4 acc[4];
#pragma unroll
    for (int kt = 0; kt < 4; ++kt) acc[kt] = (f32x4){0.f, 0.f, 0.f, 0.f};
    const bool f_noscan = (F.flags >> 18) & 1u, f_noprep = (F.flags >> 19) & 1u, f_nostore = (F.flags >> 20) & 1u;
    v4u raw[NRAW];
    prep_load(raw, RK, TD, b, h, dir, vs, lane);
    LDS_WAIT(); __builtin_amdgcn_s_barrier(); asm volatile("" ::: "memory");
    for (int R = 0; R < SEQ / 64; ++R) {
        if (!f_noprep) prep(raw, a, b, h, dir, 4 * R + vs, slots + w * SLOT, cst, lane, f_nostore);
        else { unsigned x = 0;
#pragma unroll
            for (int i = 0; i < NRAW; ++i) x ^= raw[i].x ^ raw[i].y ^ raw[i].z ^ raw[i].w;
            asm volatile("" :: "v"(x)); }
        LDS_WAIT(); __builtin_amdgcn_s_barrier(); asm volatile("" ::: "memory");
        if (R + 1 < SEQ / 64) prep_load(raw, RK, TD, b, h, dir, 4 * (R + 1) + vs, lane);
        asm volatile("" ::: "memory");
        if (!f_noscan)
        for (int ci = 0; ci < 4; ++ci) {
            const int c = 4 * R + ci; const int g = dir ? (SEQ / 4 - 1 - (4 * c + (lane >> 4))) : (4 * c + (lane >> 4));
            scan_chunk(acc, slots + (dir * 4 + ci) * SLOT, vs, lane, Y + ((size_t)g * 64 + 16 * vs + (lane & 15)) * 4, dir != 0, f_nostore);
        }
        LDS_WAIT(); __builtin_amdgcn_s_barrier(); asm volatile("" ::: "memory");
    }
    if (f_nostore) { asm volatile("" :: "v"(acc[0]), "v"(acc[1]), "v"(acc[2]), "v"(acc[3])); }
}
#undef MFMA16
}

__device__ __forceinline__ void p4_finalize(Frame& F, const Args& a) {
    const bf16* __restrict__ RK = (const bf16*)(a.ws + WS_RKVS); const bf16* __restrict__ TD = (const bf16*)(a.ws + WS_TDS); const bf16* __restrict__ GT = (const bf16*)(a.ws + WS_GUPT);
    const bf16* __restrict__ YF = (const bf16*)(a.ws + WS_YF); const bf16* __restrict__ YB = (const bf16*)(a.ws + WS_YB);
    const float* __restrict__ BON = (const float*)(a.ws + WS_BON); bf16* __restrict__ MIX = (bf16*)(a.ws + WS_MIX);
    const float* __restrict__ ln_w = a.in[17]; const float* __restrict__ ln_b = a.in[18];
    const int gw = F.vcu * NWAVES + F.wave; const int kl = F.lane & 15, q = F.lane >> 4; const int b = F.vcu >> 3;
    LAS unsigned char* stg = F.lds + F.wave * (16 * 1040);
    for (int i = 0; i < 2; ++i) {
        const size_t row0 = (size_t)(gw * 2 + i) * 16; const int t0 = (int)(row0 & (SEQ - 1)); const int g = (t0 >> 2) + q;
        bf16x8 sg[4];
#pragma unroll
        for (int ks = 0; ks < 4; ++ks) sg[ks] = *(const bf16x8*)(TD + (row0 + kl) * 256 + 128 + 32 * ks + 8 * q);
        v2u n_yf[4], n_yb[4], n_vv[4]; f32x4 n_bf, n_bb; float n_lw[4], n_lb[4]; bf16x8 n_gt[4][4];
#define P4_LOAD(HH) do { _Pragma("unroll") for (int ct = 0; ct < 4; ++ct) { const int ch_ = 64 * (HH) + 16 * ct + kl; \
            const size_t yo_ = ((((size_t)b * 8 + (HH)) * (SEQ / 4) + g) * 64 + 16 * ct + kl) * 4; \
            n_yf[ct] = *(const v2u*)(YF + yo_); n_yb[ct] = *(const v2u*)(YB + yo_); \
            n_vv[ct] = *(const v2u*)(RK + (((size_t)b * (SEQ / 4) + g) * 1536 + 1024 + ch_) * 4); n_lw[ct] = ln_w[ch_]; n_lb[ct] = ln_b[ch_]; \
            _Pragma("unroll") for (int ks = 0; ks < 4; ++ks) n_gt[ct][ks] = *(const bf16x8*)(GT + (size_t)ch_ * 128 + 32 * ks + 8 * q); } \
            const size_t bo_ = ((size_t)b * 8 + (HH)) * SEQ + t0 + 4 * q; n_bf = *(const f32x4*)(BON + bo_); n_bb = *(const f32x4*)(BON + (size_t)MT * 8 + bo_); } while (0)
        P4_LOAD(0);
#pragma clang loop unroll(disable)
        for (int hh = 0; hh < 8; ++hh) {
            f32x4 acc[4], y[4], vs[4]; float lw[4], lb[4];
#pragma unroll
            for (int ct = 0; ct < 4; ++ct) {
                y[ct] = (f32x4){bflo(n_yf[ct].x) + bflo(n_yb[ct].x), bfhi(n_yf[ct].x) + bfhi(n_yb[ct].x), bflo(n_yf[ct].y) + bflo(n_yb[ct].y), bfhi(n_yf[ct].y) + bfhi(n_yb[ct].y)};
                vs[ct] = (f32x4){bflo(n_vv[ct].x), bfhi(n_vv[ct].x), bflo(n_vv[ct].y), bfhi(n_vv[ct].y)}; lw[ct] = n_lw[ct]; lb[ct] = n_lb[ct]; }
            const f32x4 bon = n_bf + n_bb;
#pragma unroll
            for (int ct = 0; ct < 4; ++ct) { acc[ct] = (f32x4){0.f, 0.f, 0.f, 0.f};
#pragma unroll
                for (int ks = 0; ks < 4; ++ks) acc[ct] = __builtin_amdgcn_mfma_f32_16x16x32_bf16(sg[ks], n_gt[ct][ks], acc[ct], 0, 0, 0); }
            if (hh + 1 < 8) P4_LOAD(hh + 1);
            f32x4 sm = (y[0] + y[1]) + (y[2] + y[3]);
#pragma unroll
            for (int e = 0; e < 4; ++e) sm[e] = wkv::red16(sm[e]);
            const f32x4 mean = sm * (1.0f / 64.0f); f32x4 vq = (f32x4){0.f, 0.f, 0.f, 0.f};
#pragma unroll
            for (int ct = 0; ct < 4; ++ct) { y[ct] = y[ct] - mean; vq += y[ct] * y[ct]; }
            f32x4 rstd;
#pragma unroll
            for (int e = 0; e < 4; ++e) rstd[e] = __builtin_amdgcn_rsqf(wkv::red16(vq[e]) * (1.0f / 64.0f) + GN_EPS);
#pragma unroll
            for (int ct = 0; ct < 4; ++ct) { const f32x4 o = ((y[ct] * rstd) * lw[ct] + lb[ct] + vs[ct] * bon) * acc[ct];
#pragma unroll
                for (int e = 0; e < 4; ++e) *(LAS unsigned short*)(stg + (4 * q + e) * 1040 + (64 * hh + 16 * ct + kl) * 2) = (unsigned short)f2bf(o[e]); }
        }
#undef P4_LOAD
        LDS_WAIT();
#pragma unroll
        for (int r = 0; r < 16; ++r) { const v4u w = *(const LAS v4u*)(stg + r * 1040 + F.lane * 16); *(v4u*)(MIX + (row0 + r) * DM + 512 + F.lane * 8) = w; }
        LDS_WAIT();
    }
}

__device__ __forceinline__ void p6_norm_router(Frame& F, const Args& a) {
    LAS float* wr = (LAS float*)F.lds;
    for (int i = F.tid; i < DM * NE; i += 512) { const int k = i >> 4, e = i & 15; wr[e * DM + k] = a.in[21][i]; }
    __syncthreads();
    const float* mod = (const float*)(a.ws + WS_MOD); unsigned char* H2 = a.ws + WS_H; float* AFF = (float*)(a.ws + WS_AFF);
    const int gw = F.vcu * NWAVES + F.wave; const int b = F.vcu >> 3; const int lane = F.lane;
    f32x4 gs[4], sh[4];
#pragma unroll
    for (int j = 0; j < 4; ++j) { const int c = 4 * lane + 256 * j; const f32x4 g = *(const f32x4*)(a.in[20] + c); const f32x4 sc = *(const f32x4*)(mod + b * 6 * DM + 4 * DM + c);
        gs[j] = g * (sc + 1.0f); sh[j] = *(const f32x4*)(mod + b * 6 * DM + 3 * DM + c); }
    const bf16* X1 = (const bf16*)(a.ws + WS_X1);
    v2u vn[4];
    { const GAS v2u* xr = (const GAS v2u*)(X1 + (size_t)gw * 32 * DM) + lane;
#pragma unroll
      for (int j = 0; j < 4; ++j) vn[j] = xr[64 * j]; }
    for (int i = 0; i < 32; ++i) {
        const size_t row = (size_t)gw * 32 + i;
        f32x4 v[4]; float s2 = 0.f;
#pragma unroll
        for (int j = 0; j < 4; ++j) { v[j] = (f32x4){bflo(vn[j].x), bfhi(vn[j].x), bflo(vn[j].y), bfhi(vn[j].y)}; s2 += (v[j].x * v[j].x + v[j].y * v[j].y) + (v[j].z * v[j].z + v[j].w * v[j].w); }
        if (i + 1 < 32) { const GAS v2u* xr = (const GAS v2u*)(X1 + (row + 1) * DM) + lane;
#pragma unroll
            for (int j = 0; j < 4; ++j) vn[j] = xr[64 * j]; }
        asm volatile("" ::: "memory");
        const float rstd = 1.0f / sqrtf(wave_sum(s2) * (1.0f / DM) + NORM_EPS);
        GAS unsigned* o4 = (GAS unsigned*)(H2 + row * DM) + lane;
#pragma unroll
        for (int j = 0; j < 4; ++j) { v[j] = v[j] * rstd * gs[j] + sh[j]; unsigned w = 0u;
            w = cvt2_fp8(v[j].x * 4.0f, v[j].y * 4.0f, w, false); w = cvt2_fp8(v[j].z * 4.0f, v[j].w * 4.0f, w, true); o4[64 * j] = w; }
        float d[16];
#pragma unroll
        for (int e = 0; e < 16; ++e) { float acc = 0.f;
#pragma unroll
            for (int j = 0; j < 4; ++j) { const f32x4 w = *(const LAS f32x4*)(wr + e * DM + 4 * lane + 256 * j); acc += (v[j].x * w.x + v[j].y * w.y) + (v[j].z * w.z + v[j].w * w.w); }
            d[e] = acc; asm volatile("" ::: "memory"); }
#pragma unroll
        for (int k = 0; k < 8; ++k) { auto r = __builtin_amdgcn_permlane32_swap(__float_as_uint(d[k]), __float_as_uint(d[k + 8]), false, false); d[k] = __uint_as_float(r[0]) + __uint_as_float(r[1]); }
#pragma unroll
        for (int k = 0; k < 4; ++k) { auto r = __builtin_amdgcn_permlane16_swap(__float_as_uint(d[k]), __float_as_uint(d[k + 4]), false, false); d[k] = __uint_as_float(r[0]) + __uint_as_float(r[1]); }
        { const bool up = (lane & 8) != 0;
#pragma unroll
          for (int k = 0; k < 2; ++k) { const float send = up ? d[k] : d[k + 2], keep = up ? d[k + 2] : d[k];
              d[k] = keep + __builtin_bit_cast(float, __builtin_amdgcn_update_dpp(0, __builtin_bit_cast(int, send), 0x128, 0xf, 0xf, false)); } }
        { const bool up = (lane & 4) != 0; const float send = up ? d[0] : d[1], keep = up ? d[1] : d[0]; d[0] = keep + __shfl_xor(send, 4); }
        float lg = d[0]; lg = DPP_ADD(lg, 0x4E); lg = DPP_ADD(lg, 0xB1);
        float mx = lg;
        mx = fmaxf(mx, __shfl_xor(mx, 4)); mx = fmaxf(mx, __builtin_bit_cast(float, __builtin_amdgcn_update_dpp(0, __builtin_bit_cast(int, mx), 0x128, 0xf, 0xf, false)));
        { auto r = __builtin_amdgcn_permlane16_swap(__float_as_uint(mx), __float_as_uint(mx), false, false); mx = fmaxf(__uint_as_float(r[0]), __uint_as_float(r[1])); }
        { auto r = __builtin_amdgcn_permlane32_swap(__float_as_uint(mx), __float_as_uint(mx), false, false); mx = fmaxf(__uint_as_float(r[0]), __uint_as_float(r[1])); }
        const float pe = expf(lg - mx); float sm = pe;
        sm += __shfl_xor(sm, 4); sm = DPP_ADD(sm, 0x128); sm = xor32_sum(xor16_sum(sm));
        if ((lane & 3) == 0) AFF[((size_t)b * NE + (lane >> 2)) * SEQ + (row & (SEQ - 1))] = pe / sm;
    }
    __syncthreads();
}

__device__ __forceinline__ void p7_topk_gather(Frame& F, const Args& a) {
    LAS unsigned* red = (LAS unsigned*)F.lds;
    const float* AFF = (const float*)(a.ws + WS_AFF); int* IDX = (int*)(a.ws + WS_IDX); float* VAL = (float*)(a.ws + WS_VAL); int* INV = (int*)(a.ws + WS_INV);
    const int tid = F.tid, lane = F.lane, wave = F.wave;
    f32x4 v[2]; unsigned u[2][4], T[2] = {0u, 0u};
#pragma unroll
    for (int pr = 0; pr < 2; ++pr) { v[pr] = *(const f32x4*)(AFF + (size_t)(F.vcu * 2 + pr) * SEQ + 4 * tid);
#pragma unroll
        for (int j = 0; j < 4; ++j) u[pr][j] = __float_as_uint(v[pr][j]); }
    constexpr int XITEMS = 3 * NE * (DM / 64) * (FF / 32);
    const int xgw = F.vcu * NWAVES + wave, XNGW = F.G * NWAVES;
    LAS float* xscr = (LAS float*)(F.lds + 4096 + wave * 8448);
    int xit = xgw; float xt[32]; ExpItem xcur;
    if (xit < XITEMS) { xcur = exp_item(a, xit); exp_item_load(xcur, xt, lane); }
    int par = 0;
    for (int bit = 30; bit >= 0; --bit) {
        unsigned cand[2];
#pragma unroll
        for (int pr = 0; pr < 2; ++pr) { cand[pr] = T[pr] | (1u << bit);
            const int c = __builtin_popcountll(__ballot(u[pr][0] >= cand[pr])) + __builtin_popcountll(__ballot(u[pr][1] >= cand[pr])) + __builtin_popcountll(__ballot(u[pr][2] >= cand[pr])) + __builtin_popcountll(__ballot(u[pr][3] >= cand[pr]));
            if (lane == 0) red[(par * 2 + pr) * 8 + wave] = (unsigned)c; }
        LDS_WAIT(); __builtin_amdgcn_s_barrier(); asm volatile("" ::: "memory");
#pragma unroll
        for (int pr = 0; pr < 2; ++pr) { unsigned tot = 0;
#pragma unroll
            for (int w = 0; w < 8; ++w) tot += red[(par * 2 + pr) * 8 + w];
            if (tot >= (unsigned)CAP) T[pr] = cand[pr]; }
        par ^= 1;
        if (xit < XITEMS) { exp_item_store(xcur, xt, xscr, lane); xit += XNGW; if (xit < XITEMS) { xcur = exp_item(a, xit); exp_item_load(xcur, xt, lane); } }
    }
    while (xit < XITEMS) { exp_item_store(xcur, xt, xscr, lane); xit += XNGW; if (xit < XITEMS) { xcur = exp_item(a, xit); exp_item_load(xcur, xt, lane); } }
    int pk[2], inc[2];
#pragma unroll
    for (int pr = 0; pr < 2; ++pr) {
        const int cg = (u[pr][0] > T[pr]) + (u[pr][1] > T[pr]) + (u[pr][2] > T[pr]) + (u[pr][3] > T[pr]), ce = (u[pr][0] == T[pr]) + (u[pr][1] == T[pr]) + (u[pr][2] == T[pr]) + (u[pr][3] == T[pr]);
        pk[pr] = cg | (ce << 16); inc[pr] = pk[pr];
#pragma unroll
        for (int o = 1; o < 64; o <<= 1) { const int n = __shfl_up(inc[pr], o); if (lane >= o) inc[pr] += n; }
        if (lane == 63) red[64 + 16 * pr + wave] = (unsigned)inc[pr]; }
    __syncthreads();
#pragma unroll
    for (int pr = 0; pr < 2; ++pr) {
        const int p = F.vcu * 2 + pr; const int b = p >> 4, e = p & 15;
        int base = 0, total = 0;
#pragma unroll
        for (int w = 0; w < 8; ++w) { const int tw = (int)red[64 + 16 * pr + w]; if (w < wave) base += tw; total += tw; }
        const int excl = base + inc[pr] - pk[pr];
        int gtb = excl & 0xffff, eqb = excl >> 16; const int need_eq = CAP - (total & 0xffff);
#pragma unroll
        for (int j = 0; j < 4; ++j) {
            const bool g = u[pr][j] > T[pr], q = u[pr][j] == T[pr]; const bool sel = g || (q && eqb < need_eq);
            const int slot = gtb + (eqb < need_eq ? eqb : need_eq); const int t = 4 * tid + j;
            if (sel) { IDX[p * CAP + slot] = t; VAL[p * CAP + slot] = v[pr][j]; }
            INV[((size_t)b * SEQ + t) * NE + e] = sel ? slot : -1;
            gtb += g ? 1 : 0; eqb += q ? 1 : 0;
        }
    }
    __syncthreads();
}

struct GuOrder { int vcu; const LAS unsigned short* lidx;
    static constexpr bool GATHER = true;
    __device__ __forceinline__ unsigned a_base(const pg8::Unit& u) const { return (unsigned)(u.pm >> 4) * (unsigned)(SEQ * DM); }
    __device__ __forceinline__ void rows(const pg8::Unit& u, unsigned (&g)[2][2]) const {
        int tid = threadIdx.x; asm volatile("" : "+v"(tid));
#pragma unroll
        for (int i = 0; i < 2; ++i) { int R, C; pg8::stage_rc(tid * 16 + i * 8192, R, C);
#pragma unroll
            for (int h = 0; h < 2; ++h) g[h][i] = (unsigned)lidx[(u.pm & 15) * CAP + 128 * h + R] * (unsigned)DM + (unsigned)C * 2u; } }
    __device__ __forceinline__ bool next(int i, pg8::Unit& u) const { if (i >= NE) return false; const int b = vcu >> 3, pn = vcu & 7; u.pm = b * NE + i; u.pn = pn; u.bt = i * 8 + pn; return true; } };
struct DownOrder { int vcu; static constexpr bool GATHER = false;
    __device__ __forceinline__ bool next(int i, pg8::Unit& u) const { if (i >= NE / 2) return false; const int b = vcu >> 3, j = vcu & 7, e = 2 * i + (j >> 2); u.pm = b * NE + e; u.pn = j & 3; u.bt = e * 4 + (j & 3); return true; } };
struct EpiSwiGLU {
    static constexpr bool PERM = true;
    unsigned char* HID;
    __device__ __forceinline__ void operator()(const f32x4 (&acc)[2][2][4][2], const pg8::Unit& u, int wr, int wc, int fr, int fq) const {
        { int l_ = threadIdx.x; asm volatile("" : "+v"(l_)); fr = l_ & 15; fq = (l_ >> 4) & 3; }
        const int row0 = u.pm * 256 + wr * 64 + fr, col0 = u.pn * 128 + wc * 32 + 8 * fq;
        const __amdgpu_buffer_rsrc_t hrs = __builtin_amdgcn_make_buffer_rsrc((void*)HID, 0, 0x7fffffff, 0x00020000);
#pragma unroll
        for (int ai = 0; ai < 2; ++ai)
#pragma unroll
            for (int m = 0; m < 4; ++m) {
                unsigned w[2];
#pragma unroll
                for (int n = 0; n < 2; ++n) { const f32x4 g = acc[ai][0][m][n], up = acc[ai][1][m][n]; f32x4 h;
#pragma unroll
                    for (int e = 0; e < 4; ++e) { const float gg = g[e] * (1.0f / 128.0f); h[e] = gg * __builtin_amdgcn_rcpf(1.0f + __expf(-gg)) * up[e] * (8.0f / 128.0f); }
                    unsigned x = 0u; x = cvt2_fp8(h[0], h[1], x, false); x = cvt2_fp8(h[2], h[3], x, true); w[n] = x; }
                v2u wv; wv.x = w[0]; wv.y = w[1];
                __builtin_amdgcn_raw_buffer_store_b64(wv, hrs, (unsigned)(row0 + ai * 128 + m * 16) * (unsigned)FF + (unsigned)col0, 0, 0);
            }
    }
};
struct EpiDown {
    static constexpr bool PERM = true;
    unsigned char* Y; const float* VAL; const float* mod;
    __device__ __forceinline__ void operator()(const f32x4 (&acc)[2][2][4][2], const pg8::Unit& u, int wr, int wc, int fr, int fq) const {
        { int l_ = threadIdx.x; asm volatile("" : "+v"(l_)); fr = l_ & 15; fq = (l_ >> 4) & 3; }
        const int row0 = u.pm * 256 + wr * 64 + fr, col0 = u.pn * 256 + wc * 64 + 16 * fq; const int b = u.pm >> 4;
        f32x4 gt[2][2];
#pragma unroll
        for (int bj = 0; bj < 2; ++bj)
#pragma unroll
            for (int n = 0; n < 2; ++n) gt[bj][n] = *(const f32x4*)(mod + b * 6 * DM + 5 * DM + col0 + 8 * bj + 4 * n);
        const __amdgpu_buffer_rsrc_t yrs = __builtin_amdgcn_make_buffer_rsrc((void*)Y, 0, 0x7fffffff, 0x00020000);
        float vls[2][4];
#pragma unroll
        for (int ai = 0; ai < 2; ++ai)
#pragma unroll
            for (int m = 0; m < 4; ++m) vls[ai][m] = VAL[row0 + ai * 128 + m * 16] * (64.0f / 256.0f);
#pragma unroll
        for (int ai = 0; ai < 2; ++ai)
#pragma unroll
            for (int m = 0; m < 4; ++m) { const int row = row0 + ai * 128 + m * 16; const float vl = vls[ai][m];
                unsigned w[4];
#pragma unroll
                for (int bj = 0; bj < 2; ++bj)
#pragma unroll
                    for (int n = 0; n < 2; ++n) { const f32x4 v = acc[ai][bj][m][n] * gt[bj][n] * vl; unsigned x = 0u;
                        x = cvt2_fp8(v[0], v[1], x, false); x = cvt2_fp8(v[2], v[3], x, true); w[2 * bj + n] = x; }
                v4u wv; wv.x = w[0]; wv.y = w[1]; wv.z = w[2]; wv.w = w[3];
                __builtin_amdgcn_raw_buffer_store_b128(wv, yrs, (unsigned)row * (unsigned)DM + (unsigned)col0, 0, 0); }
    }
};

__device__ __forceinline__ void p10_combine(Frame& F, const Args& a) {
    const int* INV = (const int*)(a.ws + WS_INV); const unsigned char* Y = a.ws + WS_Y;
    const int gw = F.vcu * NWAVES + F.wave; const int b = F.vcu >> 3; const int lane = F.lane;
    const bool nostore = (F.flags >> 20) & 1u;
    int inv_n[2];
#pragma unroll
    for (int r = 0; r < 2; ++r) inv_n[r] = INV[((size_t)gw * 32 + r) * NE + (lane & 15)];
    const bf16* X1 = (const bf16*)(a.ws + WS_X1);
    v2u vnx[2][4];
#pragma unroll
    for (int r = 0; r < 2; ++r) { const GAS v2u* xr = (const GAS v2u*)(X1 + ((size_t)gw * 32 + r) * DM) + lane;
#pragma unroll
        for (int j = 0; j < 4; ++j) vnx[r][j] = xr[64 * j]; }
    for (int i = 0; i < 32; i += 2) {
        const size_t row = (size_t)gw * 32 + i;
        int inv[2]; inv[0] = inv_n[0]; inv[1] = inv_n[1];
        if (i + 2 < 32) {
#pragma unroll
            for (int r = 0; r < 2; ++r) inv_n[r] = INV[(row + 2 + r) * NE + (lane & 15)]; }
        f32x4 v[2][4];
#pragma unroll
        for (int r = 0; r < 2; ++r)
#pragma unroll
            for (int j = 0; j < 4; ++j) v[r][j] = (f32x4){bflo(vnx[r][j].x), bfhi(vnx[r][j].x), bflo(vnx[r][j].y), bfhi(vnx[r][j].y)};
        if (i + 2 < 32) {
#pragma unroll
            for (int r = 0; r < 2; ++r) { const GAS v2u* xr = (const GAS v2u*)(X1 + (row + 2 + r) * DM) + lane;
#pragma unroll
                for (int j = 0; j < 4; ++j) vnx[r][j] = xr[64 * j]; } }
        unsigned m0 = (unsigned)(__ballot(inv[0] >= 0) & 0xffffull), m1 = (unsigned)(__ballot(inv[1] >= 0) & 0xffffull);
        while (m0 | m1) {
            unsigned w[2][3][4]; bool hit[2][3];
#pragma unroll
            for (int r = 0; r < 2; ++r)
#pragma unroll
                for (int k = 0; k < 3; ++k) { unsigned& mm = r ? m1 : m0; hit[r][k] = mm != 0u;
                    if (hit[r][k]) { const int e = __builtin_ctz(mm); mm &= mm - 1u; const int sl = __builtin_amdgcn_readlane(inv[r], e);
                        const unsigned char* yr = Y + ((size_t)(b * NE + e) * CAP + sl) * DM + 4 * lane;
#pragma unroll
                        for (int j = 0; j < 4; ++j) w[r][k][j] = *(const unsigned*)(yr + 256 * j); } }
#pragma unroll
            for (int r = 0; r < 2; ++r)
#pragma unroll
                for (int k = 0; k < 3; ++k) if (hit[r][k]) {
#pragma unroll
                    for (int j = 0; j < 4; ++j) { const f32x2 lo = __builtin_amdgcn_cvt_pk_f32_fp8(w[r][k][j], false), hi = __builtin_amdgcn_cvt_pk_f32_fp8(w[r][k][j], true);
                        v[r][j].x += lo.x * (1.0f / 64.0f); v[r][j].y += lo.y * (1.0f / 64.0f); v[r][j].z += hi.x * (1.0f / 64.0f); v[r][j].w += hi.y * (1.0f / 64.0f); } }
        }
        if (!nostore) {
#pragma unroll
            for (int r = 0; r < 2; ++r) { GAS f32x4* xr = (GAS f32x4*)(a.out + (row + r) * DM) + lane;
#pragma unroll
                for (int j = 0; j < 4; ++j) xr[64 * j] = v[r][j]; }
        } else asm volatile("" :: "v"(v[0][0]), "v"(v[0][1]), "v"(v[0][2]), "v"(v[0][3]), "v"(v[1][0]), "v"(v[1][1]), "v"(v[1][2]), "v"(v[1][3]));
    }
}

__global__ void __launch_bounds__(NWAVES * 64, 2) fwd_kernel(Args args) {
    extern __shared__ __attribute__((aligned(16))) unsigned char lds[];
    cg::grid_group grid = cg::this_grid();
    Frame F;
    F.lds = (LAS unsigned char*)lds;
    F.tid = threadIdx.x; F.lane = F.tid & 63; F.wave = __builtin_amdgcn_readfirstlane(F.tid >> 6);
    F.G = gridDim.x; { const int bx = blockIdx.x; F.vcu = (F.G % 8 == 0) ? (bx % 8) * (F.G / 8) + bx / 8 : bx; }
    unsigned char* ws = args.ws;
    const unsigned mask = args.mask; F.flags = mask;
    volatile LAS unsigned* MISC = (volatile LAS unsigned*)(F.lds + MISC_OFF);
    if (F.tid < 32) MISC[F.tid] = 0u;
    __syncthreads();
    XcdBarrier bar; bar.bar = (unsigned*)(ws + WS_CTL) + CW_BAR; bar.x = 0; bar.st = nullptr;
    const bool one_launch = __builtin_popcount(mask & 0x7ffu) > 1;
    if (one_launch) bar = xcd_barrier_post((unsigned*)(ws + WS_CTL) + CW_BAR, MISC + 8);
    if (one_launch) grid.sync();
#define REFRESH() do { F.tid = threadIdx.x; asm volatile("" : "+v"(F.tid)); F.lane = F.tid & 63; } while (0)
#define IN(k) ((mask >> (k)) & 1u)
#define SEAM(k) do { if (IN(k) && ((mask & 0x7ffu) >> ((k) + 1)) != 0u) xcd_barrier(bar); REFRESH(); } while (0)

    if (IN(0)) { p0_prologue(F, args); } SEAM(0);
    if (IN(1)) { p1_norm(F, args); } SEAM(1);
    if (IN(2)) {
        pg8::Gemm g{(const bf16*)(ws + WS_H), (const bf16*)(ws + WS_WIN), MT, NIN, DM}; pg8::StaticOrder S; S.init(MT, NIN, F.G, (int)blockIdx.x);
        EpiInProj E{(bf16*)(ws + WS_Q), (bf16*)(ws + WS_K), (bf16*)(ws + WS_V), (bf16*)(ws + WS_PR), args.in[6], args.in[7], (const float*)(ws + WS_ROPE)};
        pg8::gemm_phase<EpiInProj, pg8::StaticOrder, true, true>(F.lds, g, S, E, (mask >> 22) & 1u);
    } SEAM(2);
    if (IN(3)) {
        const int b = F.vcu >> 3, h = F.vcu & 7;
        if (!((mask >> 16) & 1u)) {
            prs_pass(F, args);
            REFRESH();
            float bref;
            { float gq = fabsf(args.in[6][F.lane]), gk = fabsf(args.in[7][F.lane]);
#pragma unroll
              for (int o_ = 1; o_ < 64; o_ <<= 1) { gq = fmaxf(gq, __shfl_xor(gq, o_)); gk = fmaxf(gk, __shfl_xor(gk, o_)); }
              bref = 64.0f * QSCALE * gq * gk * 1.02f + 0.25f; }
            for (int qb = 0; qb < 8; ++qb)
                attn_body::attn_unit<8>(b, h, qb, (const bf16*)(ws + WS_Q), (const bf16*)(ws + WS_K), (const bf16*)(ws + WS_V), (bf16*)(ws + WS_MIX), (char*)lds, qb > 0, true, bref);
            __syncthreads();
        }
        if (one_launch) xcd_barrier(bar);
        REFRESH();
        if (!((mask >> 17) & 1u)) {
            wkv::phase(F, args);
        }
    } SEAM(3);
    if (IN(4)) { p4_finalize(F, args); } SEAM(4);
    if (IN(5)) {
        pg8::Gemm g{(const bf16*)(ws + WS_MIX), (const bf16*)(ws + WS_WOUT), MT, DM, DM}; pg8::StaticOrder S; S.init(MT, DM, F.G, (int)blockIdx.x);
        EpiOutProj E{args.in[0], (bf16*)(ws + WS_X1), (const float*)(ws + WS_MOD)};
        pg8::gemm_phase<EpiOutProj, pg8::StaticOrder, true, true>(F.lds, g, S, E, (mask >> 22) & 1u);
    } SEAM(5);
    if (IN(6)) { p6_norm_router(F, args); } SEAM(6);
    if (IN(7)) { p7_topk_gather(F, args); } SEAM(7);
    if (IN(8)) {
        LAS unsigned short* lidx = (LAS unsigned short*)(F.lds + LIDX_OFF);
        { const int* IDX = (const int*)(ws + WS_IDX) + (size_t)(F.vcu >> 3) * NE * CAP; for (int i = F.tid; i < NE * CAP; i += 512) lidx[i] = (unsigned short)IDX[i]; }
        __syncthreads();
        pg8::Gemm g{(const bf16*)(ws + WS_H), (const bf16*)(ws + WS_WGU), NGROUP * CAP, 2 * FF, DM / 2}; GuOrder S{F.vcu, lidx};
        EpiSwiGLU E{ws + WS_HID};
        pg8::gemm_phase<EpiSwiGLU, GuOrder, true, true, true>(F.lds, g, S, E, (mask >> 22) & 1u);
    } SEAM(8);
    if (IN(9)) {
        pg8::Gemm g{(const bf16*)(ws + WS_HID), (const bf16*)(ws + WS_WD), NGROUP * CAP, DM, FF / 2}; DownOrder S{F.vcu};
        EpiDown E{ws + WS_Y, (const float*)(ws + WS_VAL), (const float*)(ws + WS_MOD)};
        pg8::gemm_phase<EpiDown, DownOrder, true, true, true>(F.lds, g, S, E, (mask >> 22) & 1u);
    } SEAM(9);
    if (IN(10)) { p10_combine(F, args); }
#undef IN
#undef SEAM
}

extern "C" void kernel_launch(void* const* d_in, const int* in_sizes, int n_in, void* d_out, int out_size, void* d_ws, size_t ws_size, hipStream_t stream) {
    static int grid = 0;
    if (grid == 0) {
        if (n_in != 25 || out_size != MT * DM || ws_size < WS_END) { fprintf(stderr, "kernel_launch: unexpected shapes n_in %d out %d ws %zu\n", n_in, out_size, ws_size); grid = -1; return; }
        int dev = 0, cus = 0, per_cu = 0;
        (void)hipGetDevice(&dev); (void)hipDeviceGetAttribute(&cus, hipDeviceAttributeMultiprocessorCount, dev);
        (void)hipFuncSetAttribute((const void*)fwd_kernel, hipFuncAttributeMaxDynamicSharedMemorySize, LDS_BYTES);
        (void)hipOccupancyMaxActiveBlocksPerMultiprocessor(&per_cu, (const void*)fwd_kernel, NWAVES * 64, LDS_BYTES);
        (void)hipGetLastError();
        if (per_cu < 1) { fprintf(stderr, "kernel_launch: occupancy query says %d blocks per CU\n", per_cu); grid = -1; return; }
        if (cus != NB * 8) { fprintf(stderr, "kernel_launch: built for a %d-CU device (one workgroup per (batch, head)); found %d CUs; nothing launched\n", NB * 8, cus); grid = -1; return; }
        grid = cus;
    }
    if (grid < 0) return;
    (void)hipMemsetAsync((char*)d_ws + WS_CTL, 0, CTL_ZERO_BYTES, stream);
#if !((DBG_MASK >> 5) & 1)
    (void)hipMemcpyAsync(d_out, d_in[0], (size_t)MT * DM * 4, hipMemcpyDeviceToDevice, stream);
#endif
    Args a{};
    for (int i = 0; i < 25; ++i) a.in[i] = (const float*)d_in[i];
    a.out = (float*)d_out; a.ws = (unsigned char*)d_ws;
    constexpr int NPH = 11;
#if MK_N_LAUNCHES == 1
    a.mask = DBG_MASK;
    void* kargs[] = {&a};
    hipError_t e = hipLaunchCooperativeKernel((const void*)fwd_kernel, dim3(grid), dim3(NWAVES * 64), kargs, LDS_BYTES, stream);
    if (e != hipSuccess) fprintf(stderr, "cooperative launch failed: %s (grid %d)\n", hipGetErrorString(e), grid);
#else
    for (int p = 0; p < NPH; ++p) {
        if (!((DBG_MASK >> p) & 1)) continue;
        a.mask = 1u << p;
        if (p == 3) { a.mask |= 1u << 17; hipLaunchKernelGGL(fwd_kernel, dim3(grid), dim3(NWAVES * 64), LDS_BYTES, stream, a); a.mask = (1u << 3) | (1u << 16); }
        hipLaunchKernelGGL(fwd_kernel, dim3(grid), dim3(NWAVES * 64), LDS_BYTES, stream, a);
        const int rp = DBG_REPEAT;
        if (rp == p || ((rp == 31 || rp == 32 || rp == 33) && p == 3)) {
            if (rp == 31) a.mask = (1u << 3) | (1u << 17); if (rp == 32) a.mask = (1u << 3) | (1u << 16); if (rp == 33) a.mask = (1u << 3) | (1u << 16) | (1u << 17); a.mask |= DBG_XFLAGS;
            hipLaunchKernelGGL(fwd_kernel, dim3(grid), dim3(NWAVES * 64), LDS_BYTES, stream, a);
        }
    }
#endif
}
```

```cpp
#include <hip/hip_runtime.h>
#include <hip/hip_cooperative_groups.h>
#include <hip/hip_bf16.h>
#include <cstdio>
#include <cstdint>
#include <cmath>
namespace cg = cooperative_groups;

#ifndef MK_N_LAUNCHES
#define MK_N_LAUNCHES 1
#endif
#ifndef DBG_REPEAT
#define DBG_REPEAT -1
#endif
#ifndef GEMM_GLDS
#define GEMM_GLDS 0
#endif
#ifndef WKV_PREFETCH
#define WKV_PREFETCH 1
#endif
#ifndef DBG_XFLAGS
#define DBG_XFLAGS 0
#endif
#ifndef USE_VALU_SCAN
#define USE_VALU_SCAN 0
#endif
#ifndef DBG_MASK
#define DBG_MASK 0x7ff
#endif

constexpr int DM = 1024, NB = 32, SEQ = 2048, MT = NB * SEQ;
constexpr int NIN = 2560, AW = 512, KVW = 128, RW = 512, NSH = 1792;
constexpr int NE = 16, CAP = 256, FF = 1024;
constexpr int NGROUP = NB * NE;
constexpr float NORM_EPS = 1e-6f, GN_EPS = 64e-5f, DECAY_SCALE = 0.606531f;
constexpr float QSCALE = 0.125f * 1.4426950408889634f;

constexpr size_t MiB = 1u << 20;
constexpr size_t WS_CTL = 0, CTL_ZERO_BYTES = 64 * 1024;
constexpr int CW_BAR = 4096;
constexpr size_t WS_MOD = 1 * MiB;
constexpr size_t WS_ROPE = 2 * MiB;
constexpr size_t WS_AFF = 3 * MiB;
constexpr size_t WS_IDX = 7 * MiB;
constexpr size_t WS_VAL = 7 * MiB + 512 * 1024;
constexpr size_t WS_INV = 8 * MiB;
constexpr size_t WS_BON = 12 * MiB;
constexpr size_t WS_GUPT = 16 * MiB;
constexpr size_t WS_WUPT = 16 * MiB + 128 * 1024;
constexpr size_t WS_AUPT = 16 * MiB + 256 * 1024;
constexpr size_t WS_AUPT2 = 16 * MiB + 384 * 1024;
constexpr size_t WS_WIN = 17 * MiB;
constexpr size_t WS_WOUT = 22 * MiB;
constexpr size_t WS_WGU = 24 * MiB;
constexpr size_t WS_WD = 88 * MiB;
constexpr size_t WS_H = 120 * MiB;
constexpr size_t WS_Q = 248 * MiB;
constexpr size_t WS_K = 312 * MiB;
constexpr size_t WS_V = 328 * MiB;
constexpr size_t WS_PR = 344 * MiB;
constexpr size_t WS_XG = 248 * MiB;
constexpr size_t WS_Y = 248 * MiB;
constexpr size_t WS_MIX = 568 * MiB;
constexpr size_t WS_YF = 696 * MiB;
constexpr size_t WS_YB = 760 * MiB;
constexpr size_t WS_RKVS = 824 * MiB;
constexpr size_t WS_TDS = 120 * MiB;
constexpr size_t WS_HID = 568 * MiB;
constexpr size_t WS_X1 = 696 * MiB;
constexpr size_t WS_END = 1016 * MiB;

constexpr int RING_BYTES = 131072;
constexpr int LIDX_OFF = RING_BYTES + 512;
constexpr int LDS_BYTES = 147456;
constexpr int MISC_OFF = LDS_BYTES - 256;
constexpr int NWAVES = 8;

#define GAS __attribute__((address_space(1)))
#define LAS __attribute__((address_space(3)))
typedef unsigned short bf16;
typedef unsigned v4u __attribute__((ext_vector_type(4)));
typedef unsigned v2u __attribute__((ext_vector_type(2)));
typedef float f32x4 __attribute__((ext_vector_type(4)));
typedef float f32x2 __attribute__((ext_vector_type(2)));
typedef short bf16x8 __attribute__((ext_vector_type(8)));
#define LDS_WAIT() asm volatile("s_waitcnt lgkmcnt(0)" ::: "memory")
#define VM_WAIT() asm volatile("s_waitcnt vmcnt(0)" ::: "memory")
__device__ __forceinline__ unsigned cvt2_fp8(float a, float b, unsigned old, bool hi) { a = __builtin_amdgcn_fmed3f(a, -448.0f, 448.0f); b = __builtin_amdgcn_fmed3f(b, -448.0f, 448.0f); return hi ? __builtin_amdgcn_cvt_pk_fp8_f32(a, b, old, true) : __builtin_amdgcn_cvt_pk_fp8_f32(a, b, old, false); }
typedef __bf16 bf16x2_hw __attribute__((ext_vector_type(2)));
__device__ __forceinline__ unsigned pk2(float lo, float hi) { const f32x2 v = {lo, hi}; return __builtin_bit_cast(unsigned, __builtin_convertvector(v, bf16x2_hw)); }
__device__ __forceinline__ unsigned f2bf(float f) { return pk2(f, 0.f) & 0xffffu; }
__device__ __forceinline__ float bf2f(unsigned short h) { return __builtin_bit_cast(float, (unsigned)h << 16); }
__device__ __forceinline__ float bflo(unsigned w) { return __builtin_bit_cast(float, w << 16); }
__device__ __forceinline__ float bfhi(unsigned w) { return __builtin_bit_cast(float, w & 0xffff0000u); }
#define DPP_ADD(v, CTRL) ((v) + __builtin_bit_cast(float, __builtin_amdgcn_update_dpp(0, __builtin_bit_cast(int, (v)), (CTRL), 0xf, 0xf, false)))
__device__ __forceinline__ float xor16_sum(float v) { auto r = __builtin_amdgcn_permlane16_swap(__float_as_uint(v), __float_as_uint(v), false, false); return __uint_as_float(r[0]) + __uint_as_float(r[1]); }
__device__ __forceinline__ float xor32_sum(float v) { auto r = __builtin_amdgcn_permlane32_swap(__float_as_uint(v), __float_as_uint(v), false, false); return __uint_as_float(r[0]) + __uint_as_float(r[1]); }
__device__ __forceinline__ float wave_sum(float v) {
    v = DPP_ADD(v, 0xB1); v = DPP_ADD(v, 0x4E); v = DPP_ADD(v, 0x141); v = DPP_ADD(v, 0x140);
    return xor32_sum(xor16_sum(v));
}
__device__ __forceinline__ float sigmoidf_(float x) { return 1.0f / (1.0f + __expf(-x)); }

namespace pg8 {
#define PG8_LAS __attribute__((address_space(3)))
typedef unsigned short bf16_t;
typedef short bf16x8 __attribute__((ext_vector_type(8)));
typedef float f32x4 __attribute__((ext_vector_type(4)));
typedef unsigned u32x4 __attribute__((ext_vector_type(4)));
constexpr int BM = 256, BK = 64, HALF = 128, HTB = HALF * BK * 2, STAGE_BYTES = 8 * HTB, NXCD = 8, WGM = 8;

__host__ __device__ __forceinline__ int lds_byte(int r, int c) { const int st = (r >> 4) * 2 + (c >> 5), rr = r & 15, cc = c & 31, ob = rr * 64 + cc * 2; return st * 1024 + (ob ^ (((ob >> 9) & 1) << 5)); }
__host__ __device__ __forceinline__ void stage_rc(int b, int& R, int& C) { const int st = b / 1024, sb = b % 1024, swz = sb ^ (((sb >> 9) & 1) << 5); R = (st >> 1) * 16 + swz / 64; C = (st & 1) * 32 + (swz % 64) / 2; }
__host__ __device__ __forceinline__ int perm32(int rho) { const int n = rho >> 4, i = rho & 15; return 8 * (i >> 2) + 4 * n + (i & 3); }

struct Unit { int pm, pn, bt; };
struct Gemm { const bf16_t* A; const bf16_t* Bt; int M, N, K; };

struct StaticOrder {
    static constexpr bool GATHER = false;
    int nM, nN, nwg, G, c;
    __host__ __device__ void init(int M, int N, int G_, int c_) { nM = M / BM; nN = N / BM; nwg = nM * nN; G = G_; c = c_; }
    __host__ __device__ bool next(int i, Unit& u) const {
        const long L = (long)i * G + c; if (L >= nwg) return false;
        int wgid = (int)L; { const int q = nwg / NXCD, r = nwg % NXCD, xcd = wgid % NXCD, off = wgid / NXCD; wgid = (xcd < r ? xcd * (q + 1) : r * (q + 1) + (xcd - r) * q) + off; }
        const int nig = WGM * nN, gid = wgid / nig, fm = gid * WGM, gsz = (nM - fm) < WGM ? (nM - fm) : WGM;
        u.pm = fm + ((wgid % nig) % gsz); u.pn = (wgid % nig) / gsz; u.bt = u.pn; return true;
    }
};

__device__ __forceinline__ unsigned cvt_pk_bf16(float lo, float hi) { unsigned r; asm volatile("v_cvt_pk_bf16_f32 %0, %1, %2" : "=v"(r) : "v"(lo), "v"(hi)); return r; }

typedef int v8i_t __attribute__((ext_vector_type(8)));
typedef int v4i_t __attribute__((ext_vector_type(4)));
template <class Sched> __device__ __forceinline__ unsigned a_base_of(const Sched& S, const Unit& u, unsigned tstep) { if constexpr (Sched::GATHER) return S.a_base(u); else return (unsigned)u.pm * tstep; }
template <class Epi, class Sched, bool ALIGN_EPI = false, bool SP2 = false, bool FP8 = false>
__device__ __forceinline__ void gemm_phase(PG8_LAS unsigned char* lds, const Gemm g, const Sched& S, const Epi& E, const bool skip_epi = false) {
    const int tid = threadIdx.x, wid = __builtin_amdgcn_readfirstlane(tid >> 6), lane = tid & 63, wr = wid >> 2, wc = wid & 3, fr = lane & 15, fq = lane >> 4;
    int K = g.K; asm volatile("" : "+s"(K));
    const int nt = K / BK;
    unsigned voffA[2], voffB[2];
#pragma unroll
    for (int i = 0; i < 2; ++i) { int R, C; stage_rc(tid * 16 + i * 8192, R, C); const int Rb = Epi::PERM ? ((R & ~31) + perm32(R & 31)) : R;
        voffA[i] = (unsigned)(R * K + C) * 2u; voffB[i] = (unsigned)(Rb * K + C) * 2u; }
    const unsigned kstep = (unsigned)(BK * 2);
    const unsigned hstep = (unsigned)HALF * (unsigned)K * 2u;
    const unsigned tstep = 2u * hstep;
    const unsigned ldsw = (unsigned)wid * 1024u;
    const int aoff = lds_byte(wr * 64 + fr, fq * 8), boff = lds_byte(wc * 32 + fr, fq * 8);
    const __amdgpu_buffer_rsrc_t rsA = __builtin_amdgcn_make_buffer_rsrc((void*)g.A, 0, 0x7fffffff, 0x00020000), rsB = __builtin_amdgcn_make_buffer_rsrc((void*)g.Bt, 0, 0x7fffffff, 0x00020000);
#define PG8_SA(b, h) (((b) * 2 + (h)) * HTB)
#define PG8_SB(b, h) ((4 + (b) * 2 + (h)) * HTB)
#if GEMM_GLDS
#define PG8_STAGE(bufoff, rs, soff, voff) do { _Pragma("unroll") for (int _i = 0; _i < 2; ++_i) { \
        if constexpr (FP8) __builtin_amdgcn_raw_ptr_buffer_load_lds(rs, (PG8_LAS void*)(lds + (bufoff) + ldsw + _i * 8192), 16, (int)(voff)[_i], (int)(soff), 0, 0); \
        else __builtin_amdgcn_global_load_lds((const unsigned*)((&rs == &rsA ? (const char*)g.A : (const char*)g.Bt) + (size_t)(soff) + (voff)[_i]), (PG8_LAS unsigned*)(lds + (bufoff) + ldsw + _i * 8192), 16, 0, 0); } } while (0)
#else
#define PG8_STAGE(bufoff, rs, soff, voff) do { _Pragma("unroll") for (int _i = 0; _i < 2; ++_i) \
        __builtin_amdgcn_raw_ptr_buffer_load_lds(rs, (PG8_LAS void*)(lds + (bufoff) + ldsw + _i * 8192), 16, (int)(voff)[_i], (int)(soff), 0, 0); } while (0)
#endif
#define PG8_STAGE_A(bufoff, half, soff, gsel) do { if constexpr (Sched::GATHER) { PG8_STAGE(bufoff, rsA, soff, gsel[half]); } else { PG8_STAGE(bufoff, rsA, (soff) + (half) * hstep, voffA); } } while (0)
#define PG8_LDA(dst, b, h) do { if constexpr (FP8) { _Pragma("unroll") for (int m = 0; m < 4; ++m) { const v4i_t _lo = *(const PG8_LAS v4i_t*)(lds + PG8_SA(b, h) + aoff + m * 2048), _hi = *(const PG8_LAS v4i_t*)(lds + PG8_SA(b, h) + aoff + m * 2048 + 1024); dst##8[m] = __builtin_shufflevector(_lo, _hi, 0, 1, 2, 3, 4, 5, 6, 7); } } \
    else { _Pragma("unroll") for (int m = 0; m < 4; ++m) _Pragma("unroll") for (int k = 0; k < 2; ++k) dst[m][k] = *(const PG8_LAS bf16x8*)(lds + PG8_SA(b, h) + aoff + m * 2048 + k * 1024); } } while (0)
#define PG8_LDB(dst, b, h) do { if constexpr (FP8) { _Pragma("unroll") for (int n = 0; n < 2; ++n) { const v4i_t _lo = *(const PG8_LAS v4i_t*)(lds + PG8_SB(b, h) + boff + n * 2048), _hi = *(const PG8_LAS v4i_t*)(lds + PG8_SB(b, h) + boff + n * 2048 + 1024); dst##8[n] = __builtin_shufflevector(_lo, _hi, 0, 1, 2, 3, 4, 5, 6, 7); } } \
    else { _Pragma("unroll") for (int n = 0; n < 2; ++n) _Pragma("unroll") for (int k = 0; k < 2; ++k) dst[n][k] = *(const PG8_LAS bf16x8*)(lds + PG8_SB(b, h) + boff + n * 2048 + k * 1024); } } while (0)
#define PG8_MMA(ai, bj, At, Bt) do { __builtin_amdgcn_s_setprio(1); _Pragma("unroll") for (int m = 0; m < 4; ++m) _Pragma("unroll") for (int n = 0; n < 2; ++n) { \
        if constexpr (FP8) acc[ai][bj][m][n] = __builtin_amdgcn_mfma_scale_f32_16x16x128_f8f6f4(Bt##8[n], At##8[m], acc[ai][bj][m][n], 0, 0, 0, 0, 0, 0); \
        else { _Pragma("unroll") for (int k = 0; k < 2; ++k) acc[ai][bj][m][n] = __builtin_amdgcn_mfma_f32_16x16x32_bf16(Bt[n][k], At[m][k], acc[ai][bj][m][n], 0, 0, 0); } } __builtin_amdgcn_s_setprio(0); } while (0)
#define PG8_WAIT_V(n) asm volatile("s_waitcnt vmcnt(" #n ")" ::: "memory")
#define PG8_WAIT_L(n) asm volatile("s_waitcnt lgkmcnt(" #n ")" ::: "memory")
#define PG8_BAR __builtin_amdgcn_s_barrier()
#define PG8_SCHED __builtin_amdgcn_sched_barrier(0)
    Unit cur, nxt; int ui = 0;
    if (!S.next(0, cur)) return;
    f32x4 acc[2][2][4][2];
#pragma unroll
    for (int a = 0; a < 2; ++a)
#pragma unroll
        for (int b = 0; b < 2; ++b)
#pragma unroll
            for (int m = 0; m < 4; ++m)
#pragma unroll
                for (int n = 0; n < 2; ++n) acc[a][b][m][n] = (f32x4){0.f, 0.f, 0.f, 0.f};
    bf16x8 At[4][2], B0[2][2], B1[2][2]; v8i_t At8[4], B08[2], B18[2];
    unsigned cA = a_base_of(S, cur, tstep), cB = (unsigned)cur.bt * tstep;
    unsigned gc[2][2] = {{0u, 0u}, {0u, 0u}};
    if constexpr (Sched::GATHER) S.rows(cur, gc);
    if constexpr (SP2) {
        PG8_STAGE(PG8_SB(0, 0), rsB, cB, voffB); PG8_STAGE(PG8_SB(0, 1), rsB, cB + hstep, voffB); PG8_STAGE_A(PG8_SA(0, 0), 0, cA, gc); PG8_STAGE_A(PG8_SA(0, 1), 1, cA, gc);
        if (wr == 1) PG8_BAR;
        PG8_WAIT_V(2); PG8_BAR;
        PG8_STAGE(PG8_SB(1, 0), rsB, cB + kstep, voffB); PG8_STAGE_A(PG8_SA(1, 0), 0, cA + kstep, gc); PG8_STAGE(PG8_SB(1, 1), rsB, cB + hstep + kstep, voffB);
        PG8_WAIT_V(6); PG8_BAR;
    } else {
        PG8_STAGE(PG8_SB(0, 0), rsB, cB, voffB); PG8_STAGE_A(PG8_SA(0, 0), 0, cA, gc); PG8_STAGE(PG8_SB(0, 1), rsB, cB + hstep, voffB); PG8_STAGE_A(PG8_SA(0, 1), 1, cA, gc);
        if (wr == 1) PG8_BAR;
        PG8_WAIT_V(4); PG8_BAR;
        PG8_STAGE(PG8_SB(1, 0), rsB, cB + kstep, voffB); PG8_STAGE_A(PG8_SA(1, 0), 0, cA + kstep, gc); PG8_STAGE(PG8_SB(1, 1), rsB, cB + hstep + kstep, voffB);
        PG8_WAIT_V(6); PG8_BAR;
    }
    for (;;) {
        const bool has_next = S.next(ui + 1, nxt);
        const unsigned nA = has_next ? a_base_of(S, nxt, tstep) : cA, nB = has_next ? (unsigned)nxt.bt * tstep : cB;
#pragma clang loop unroll(disable)
        for (int t = 0; t < nt; t += 2) {
            const bool last = (t == nt - 2);
            const unsigned a1 = cA + (unsigned)(t + 1) * kstep;
            const unsigned a2 = last ? nA : cA + (unsigned)(t + 2) * kstep, b2 = last ? nB : cB + (unsigned)(t + 2) * kstep;
            const unsigned a3 = a2 + kstep, b3 = b2 + kstep;
            unsigned g23[2][2] = {{gc[0][0], gc[0][1]}, {gc[1][0], gc[1][1]}};
            if constexpr (Sched::GATHER) { if (last && has_next) S.rows(nxt, g23); }
            if constexpr (SP2) {
            PG8_LDB(B0, 0, 0); PG8_LDB(B1, 0, 1); PG8_SCHED; PG8_LDA(At, 0, 0); PG8_STAGE_A(PG8_SA(1, 1), 1, a1, gc);
            PG8_WAIT_V(8); PG8_WAIT_L(0); PG8_BAR; PG8_MMA(0, 0, At, B0); PG8_MMA(0, 1, At, B1); PG8_BAR; PG8_SCHED;
            PG8_LDA(At, 0, 1); PG8_STAGE(PG8_SB(0, 0), rsB, b2, voffB); PG8_STAGE(PG8_SB(0, 1), rsB, b2 + hstep, voffB); PG8_STAGE_A(PG8_SA(0, 0), 0, a2, g23);
            PG8_WAIT_V(8); PG8_WAIT_L(0); PG8_BAR; PG8_MMA(1, 0, At, B0); PG8_MMA(1, 1, At, B1); PG8_BAR; PG8_SCHED;
            PG8_LDB(B0, 1, 0); PG8_LDB(B1, 1, 1); PG8_SCHED; PG8_LDA(At, 1, 0); PG8_STAGE_A(PG8_SA(0, 1), 1, a2, g23);
            PG8_WAIT_V(8); PG8_WAIT_L(0); PG8_BAR; PG8_MMA(0, 0, At, B0); PG8_MMA(0, 1, At, B1); PG8_BAR; PG8_SCHED;
            PG8_LDA(At, 1, 1); PG8_STAGE(PG8_SB(1, 0), rsB, b3, voffB); PG8_STAGE(PG8_SB(1, 1), rsB, b3 + hstep, voffB); PG8_STAGE_A(PG8_SA(1, 0), 0, a3, g23);
            PG8_WAIT_V(8); PG8_WAIT_L(0); PG8_BAR; PG8_MMA(1, 0, At, B0); PG8_MMA(1, 1, At, B1); PG8_BAR; PG8_SCHED;
            } else {
            PG8_LDB(B0, 0, 0); PG8_SCHED; PG8_LDA(At, 0, 0); PG8_STAGE_A(PG8_SA(1, 1), 1, a1, gc);
            PG8_WAIT_L(8); PG8_BAR; PG8_WAIT_L(0); PG8_MMA(0, 0, At, B0); PG8_BAR; PG8_SCHED;
            PG8_LDB(B1, 0, 1); PG8_STAGE(PG8_SB(0, 0), rsB, b2, voffB);
            PG8_BAR; PG8_WAIT_L(0); PG8_MMA(0, 1, At, B1); PG8_BAR;
            PG8_LDA(At, 0, 1); PG8_STAGE_A(PG8_SA(0, 0), 0, a2, g23);
            PG8_BAR; PG8_WAIT_L(0); PG8_MMA(1, 0, At, B0); PG8_BAR; PG8_SCHED;
            PG8_STAGE(PG8_SB(0, 1), rsB, b2 + hstep, voffB);
            PG8_WAIT_V(6); PG8_BAR; PG8_MMA(1, 1, At, B1); PG8_BAR;
            PG8_LDB(B0, 1, 0); PG8_SCHED; PG8_LDA(At, 1, 0); PG8_STAGE_A(PG8_SA(0, 1), 1, a2, g23);
            PG8_WAIT_L(8); PG8_BAR; PG8_WAIT_L(0); PG8_MMA(0, 0, At, B0); PG8_BAR; PG8_SCHED;
            PG8_LDB(B1, 1, 1); PG8_STAGE(PG8_SB(1, 0), rsB, b3, voffB);
            PG8_BAR; PG8_WAIT_L(0); PG8_MMA(0, 1, At, B1); PG8_BAR;
            PG8_LDA(At, 1, 1); PG8_STAGE_A(PG8_SA(1, 0), 0, a3, g23);
            PG8_BAR; PG8_WAIT_L(0); PG8_MMA(1, 0, At, B0); PG8_BAR; PG8_SCHED;
            PG8_STAGE(PG8_SB(1, 1), rsB, b3 + hstep, voffB);
            PG8_WAIT_V(6); PG8_BAR; PG8_MMA(1, 1, At, B1); PG8_BAR;
            }
        }
        if constexpr (ALIGN_EPI) { if (wr == 0) PG8_BAR; }
        if (!skip_epi) E(acc, cur, wr, wc, fr, fq); else asm volatile("" :: "v"(acc[0][0][0][0]), "v"(acc[1][1][3][1]), "v"(acc[0][1][2][0]), "v"(acc[1][0][1][1]));
        if (!has_next) break;
#pragma unroll
        for (int a = 0; a < 2; ++a)
#pragma unroll
            for (int b = 0; b < 2; ++b)
#pragma unroll
                for (int m = 0; m < 4; ++m)
#pragma unroll
                    for (int n = 0; n < 2; ++n) acc[a][b][m][n] = (f32x4){0.f, 0.f, 0.f, 0.f};
        cur = nxt; cA = nA; cB = nB; ++ui;
        if constexpr (Sched::GATHER) S.rows(cur, gc);
        if constexpr (ALIGN_EPI) { if (wr == 1) PG8_BAR; }
    }
    PG8_WAIT_V(0);
    if constexpr (!ALIGN_EPI) { if (wr == 0) PG8_BAR; }
    PG8_BAR;
#undef PG8_SA
#undef PG8_SB
#undef PG8_STAGE
#undef PG8_STAGE_A
#undef PG8_LDA
#undef PG8_LDB
#undef PG8_MMA
#undef PG8_WAIT_V
#undef PG8_WAIT_L
#undef PG8_BAR
#undef PG8_SCHED
}
}

namespace attn_body {
using bf16x8=__attribute__((ext_vector_type(8)))short;
using s16x4=__attribute__((ext_vector_type(4)))short;
using f32x16=__attribute__((ext_vector_type(16)))float;
using u32x4=__attribute__((ext_vector_type(4)))unsigned;
typedef unsigned short bf16r;
constexpr int D=64, QP=AW, KP=KVW, OP=DM;
constexpr int NW=8,QBLK=32,QB=QBLK*NW,KVBLK=64;
__device__ __forceinline__ int crow(int r,int hi){return (r&3)+8*(r>>2)+4*hi;}
#define SBAR() __builtin_amdgcn_sched_barrier(0)
constexpr int NSLOT=3, SLOTB=8192;
constexpr int LDS_K=0, LDS_V=NSLOT*SLOTB, LDS_WS=2*NSLOT*SLOTB, LDS_OST=LDS_WS+NW*64*4, LDS_BYTES_A=LDS_OST+NW*4096;
__device__ __forceinline__ void glds16(const void*gsrc,unsigned lds_dst){unsigned keep;
  asm volatile("s_mov_b32 %0, m0\n\ts_mov_b32 m0, %2\n\ts_nop 0\n\tglobal_load_lds_dwordx4 %1, off\n\ts_mov_b32 m0, %0":"=&s"(keep):"v"(gsrc),"s"(lds_dst):"memory");}
__device__ __forceinline__ float max3f(float a,float b,float c){float r;asm("v_max3_f32 %0, %1, %2, %3":"=v"(r):"v"(a),"v"(b),"v"(c));return r;}
__device__ __forceinline__ float max2f(float a,float b){float r;asm("v_max_f32_e32 %0, %1, %2":"=v"(r):"v"(a),"v"(b));return r;}
__device__ __forceinline__ float fadd_s(float a,float b){float r;asm("v_add_f32_e32 %0, %1, %2":"=v"(r):"v"(a),"v"(b));return r;}
__device__ __forceinline__ float fsub_s(float a,float b){float r;asm("v_sub_f32_e32 %0, %1, %2":"=v"(r):"v"(a),"v"(b));return r;}
typedef float f32x2_t __attribute__((ext_vector_type(2))); typedef __bf16 bf16x2_t __attribute__((ext_vector_type(2)));
__device__ __forceinline__ unsigned cvtpk_s(float lo,float hi){f32x2_t v={lo,hi};bf16x2_t b=__builtin_convertvector(v,bf16x2_t);return __builtin_bit_cast(unsigned,b);}
#define WAIT_BAR(N) asm volatile("s_waitcnt vmcnt(" #N ") lgkmcnt(0)\n\ts_barrier":::"memory")
__device__ __forceinline__ void qkt(f32x16&p0,f32x16&p1,const char*Kslot,const bf16x8*qr,const f32x16&negm,int r32,int hi){
  const char*kb=Kslot+hi*1024+r32*16;
  #pragma unroll
  for(int d0=0;d0<4;++d0){
    const bf16x8 b0=*reinterpret_cast<const bf16x8*>(kb+d0*2048);
    const bf16x8 b1=*reinterpret_cast<const bf16x8*>(kb+d0*2048+512);
    if(d0==0){p0=__builtin_amdgcn_mfma_f32_32x32x16_bf16(b0,qr[0],negm,0,0,0);p1=__builtin_amdgcn_mfma_f32_32x32x16_bf16(b1,qr[0],negm,0,0,0);}
    else{p0=__builtin_amdgcn_mfma_f32_32x32x16_bf16(b0,qr[d0],p0,0,0,0);p1=__builtin_amdgcn_mfma_f32_32x32x16_bf16(b1,qr[d0],p1,0,0,0);}}
}
typedef __attribute__((address_space(3))) const char* lds_cptr;
typedef short v4i16_t __attribute__((ext_vector_type(4)));
__device__ __forceinline__ void kload8(bf16x8*kf,lds_cptr kp){
  kf[0]=*(const __attribute__((address_space(3))) bf16x8*)(kp);      kf[1]=*(const __attribute__((address_space(3))) bf16x8*)(kp+512);
  kf[2]=*(const __attribute__((address_space(3))) bf16x8*)(kp+2048); kf[3]=*(const __attribute__((address_space(3))) bf16x8*)(kp+2560);
  kf[4]=*(const __attribute__((address_space(3))) bf16x8*)(kp+4096); kf[5]=*(const __attribute__((address_space(3))) bf16x8*)(kp+4608);
  kf[6]=*(const __attribute__((address_space(3))) bf16x8*)(kp+6144); kf[7]=*(const __attribute__((address_space(3))) bf16x8*)(kp+6656);
}
__device__ __forceinline__ void kload2(bf16x8*kf,lds_cptr kp,int j){ kf[2*j]=*(const __attribute__((address_space(3))) bf16x8*)(kp+j*2048); kf[2*j+1]=*(const __attribute__((address_space(3))) bf16x8*)(kp+j*2048+512); }
__device__ __forceinline__ s16x4 vtr(lds_cptr p){ return __builtin_bit_cast(s16x4,__builtin_amdgcn_ds_read_tr16_b64_v4i16((__attribute__((address_space(3))) v4i16_t*)p)); }
__device__ __forceinline__ float rowmax(const f32x16&p0,const f32x16&p1){
  float a=max3f(p0[0],p0[1],p1[0]),b=max3f(p0[2],p0[3],p1[1]);a=max3f(a,p1[2],p1[3]);
  #pragma unroll
  for(int r=4;r<16;r+=4){a=max3f(a,p0[r],p0[r+1]);b=max3f(b,p0[r+2],p0[r+3]);a=max3f(a,p1[r],p1[r+1]);b=max3f(b,p1[r+2],p1[r+3]);}
  const float m=max2f(a,b);
  auto rr=__builtin_amdgcn_permlane32_swap(__float_as_uint(m),__float_as_uint(m),false,false);
  return max2f(__uint_as_float(rr[0]),__uint_as_float(rr[1]));
}
__device__ __forceinline__ void pv(f32x16*o,int vb,bf16x8 pa0,bf16x8 pa1,bf16x8 pa2,bf16x8 pa3){
  #pragma unroll
  for(int d0=0;d0<2;++d0){s16x4 lo[4],hi[4];
    #pragma unroll
    for(int ks=0;ks<4;++ks){
      asm volatile("ds_read_b64_tr_b16 %0,%1 offset:%c2":"=&v"(lo[ks]):"v"(vb),"i"(d0*4096+ks*1024):"memory");
      asm volatile("ds_read_b64_tr_b16 %0,%1 offset:%c2":"=&v"(hi[ks]):"v"(vb),"i"(d0*4096+ks*1024+512):"memory");}
    asm volatile("s_waitcnt lgkmcnt(0)":::"memory");SBAR();
    #define PK(k) (bf16x8){lo[k][0],lo[k][1],lo[k][2],lo[k][3],hi[k][0],hi[k][1],hi[k][2],hi[k][3]}
    o[d0]=__builtin_amdgcn_mfma_f32_32x32x16_bf16(pa0,PK(0),o[d0],0,0,0);
    o[d0]=__builtin_amdgcn_mfma_f32_32x32x16_bf16(pa1,PK(1),o[d0],0,0,0);
    o[d0]=__builtin_amdgcn_mfma_f32_32x32x16_bf16(pa2,PK(2),o[d0],0,0,0);
    o[d0]=__builtin_amdgcn_mfma_f32_32x32x16_bf16(pa3,PK(3),o[d0],0,0,0);
    #undef PK
  }
}
template<int THRL> __device__ __forceinline__ void attn_unit(int b,int h,int qb,const bf16r*Q,const bf16r*__restrict__ K,const bf16r*__restrict__ V,bf16r*O,char*shm,bool pre_issued,bool issue_next,float bref){
  const int tid=threadIdx.x,lane=tid&63,r32=lane&31,hi=lane>>5; const int wid=__builtin_amdgcn_readfirstlane(tid>>6);
  const long rowbase=(long)b*SEQ; const int q0=qb*QB; const int hk=h>>2;
  const bf16r*Qw=Q+(rowbase+q0+wid*QBLK)*QP+h*D;
  const bf16r*Kh=K+rowbase*KP+hk*D,*Vh=V+rowbase*KP+hk*D;
  const unsigned lds0=(unsigned)(uintptr_t)shm;
  float*wsf=(float*)(shm+LDS_WS)+wid*64;
  const bf16r*ksrc=Kh+(long)lane*KP+wid*8;
  const bf16r*vsrc=Vh+(long)(16*(wid&3)+(lane>>2))*KP+(wid>>2)*32+(lane&3)*8;
  const unsigned kdst=lds0+LDS_K+wid*1024, vdst=lds0+LDS_V+wid*1024;
  #define DMA_K(t,slot) glds16(ksrc+(long)(t)*KVBLK*KP,(unsigned)__builtin_amdgcn_readfirstlane(kdst+(slot)))
  #define DMA_V(t,slot) glds16(vsrc+(long)(t)*KVBLK*KP,(unsigned)__builtin_amdgcn_readfirstlane(vdst+(slot)))
  const int vb0=(int)(lds0+LDS_V)+((lane>>4)&1)*32+(lane&3)*8+(4*hi+((lane&15)>>2))*64;
  const char*Kbase=shm+LDS_K; bf16x8 kf[8];
  const lds_cptr shm3=(lds_cptr)shm; const lds_cptr kp0=shm3+LDS_K+hi*1024+r32*16; const lds_cptr vp0=shm3+LDS_V+((lane>>4)&1)*32+(lane&3)*8+(4*hi+((lane&15)>>2))*64;
  constexpr int NT=SEQ/KVBLK;
  if(!pre_issued){DMA_K(0,0);DMA_V(0,0);DMA_K(1,SLOTB);}
  bf16x8 qr[4];
  #pragma unroll
  for(int d0=0;d0<4;++d0)qr[d0]=*reinterpret_cast<const bf16x8*>(&Qw[(long)r32*QP+d0*16+hi*8]);
  float l_reg=0.f;f32x16 o[2];o[0]=f32x16{};o[1]=f32x16{};f32x16 negm;
  _Pragma("unroll") for(int r=0;r<16;++r)negm[r]=-bref; asm volatile("":"+v"(negm));
  bool resc=false;
  #define START(P0,P1) do{ _Pragma("unroll") for(int r=0;r<16;++r)P0[r]=__builtin_amdgcn_exp2f(P0[r]); }while(0)
  #define RESC() do{ if(resc){ asm volatile("s_waitcnt lgkmcnt(0)":::"memory"); \
      _Pragma("unroll") for(int d_=0;d_<2;++d_) _Pragma("unroll") for(int r=0;r<16;++r)o[d_][r]*=wsf[crow(r,hi)]; } }while(0)
  f32x16 pA0,pA1,pB0,pB1;
  int sl_prev=0,sl_cur=0,sl_next=SLOTB;
  #define ROT() do{sl_prev=sl_cur;sl_cur=sl_next;sl_next=(sl_next==(NSLOT-1)*SLOTB)?0:sl_next+SLOTB;}while(0)
  if(!pre_issued){DMA_K(2,2*SLOTB);}
  WAIT_BAR(3);
  qkt(pA0,pA1,Kbase,qr,negm,r32,hi);asm volatile("s_nop 15\n\ts_nop 7":"+v"(pA0),"+v"(pA1));
  START(pA0,pA1);
  _Pragma("unroll") for(int r=0;r<16;++r)pA1[r]=__builtin_amdgcn_exp2f(pA1[r]);
  WAIT_BAR(0);
  DMA_K(3,0);DMA_V(1,SLOTB);
  ROT();
  kload8(kf,kp0+sl_cur);
  WAIT_BAR(2);
  s16x4 vlo[8],vhi[8]; u32x4 pw0,pw1,pw2,pw3;
  #define PKW(P,B) cvtpk_s(P[B],P[B+1])
  #define PAF(k) __builtin_bit_cast(bf16x8,pw##k)
  #define VFR(i) (bf16x8){vlo[i][0],vlo[i][1],vlo[i][2],vlo[i][3],vhi[i][0],vhi[i][1],vhi[i][2],vhi[i][3]}
  #define PIN(x) asm volatile("":"+v"(x))
  #define MX3(a,b,c) __builtin_fmaxf(__builtin_fmaxf((a),(b)),(c))
  #define GAPA(MF,A0,A1,A2,A3,W0,W1,PW) do{ MF; sacc+=A0; sacc+=A1; sacc+=A2; sacc+=A3; PIN(sacc); W0; W1; PIN(PW); SBAR(); }while(0)
  #define EX(v) __builtin_amdgcn_exp2f(v)
  #define GAPB(MF,X,B) do{ MF; X[B]=EX(X[B]); X[B+1]=EX(X[B+1]); X[B+2]=EX(X[B+2]); X[B+3]=EX(X[B+3]); PIN(X); SBAR(); }while(0)
  #define VRD(i) do{ vlo[i]=vtr(vp_+(((i)>>2)*4096+((i)&3)*1024)); vhi[i]=vtr(vp_+(((i)>>2)*4096+((i)&3)*1024+512)); }while(0)
  #define KRD(G,j) do{ if(G){ kload2(kf,kp0+sl_next,j); SBAR(); } }while(0)
  #define STEP(C0,C1,P0,P1,t,GK,GV,GL) do{ SBAR(); \
    const lds_cptr vp_=vp0+sl_prev; \
    VRD(0); SBAR(); float sacc=(P0[0]+P0[1]); \
    GAPA(C0=__builtin_amdgcn_mfma_f32_32x32x16_bf16(kf[0],qr[0],negm,0,0,0), P0[2],P0[3],P0[4],P0[5],     pw0[0]=PKW(P0,0), pw0[1]=PKW(P0,2), pw0); \
    VRD(4); SBAR(); GAPA(C1=__builtin_amdgcn_mfma_f32_32x32x16_bf16(kf[1],qr[0],negm,0,0,0), P0[6],P0[7],P0[8],P0[9],     pw0[2]=PKW(P0,4), pw0[3]=PKW(P0,6), pw0); \
    VRD(1); SBAR(); GAPA(C0=__builtin_amdgcn_mfma_f32_32x32x16_bf16(kf[2],qr[1],C0,0,0,0),   P0[10],P0[11],P0[12],P0[13], pw1[0]=PKW(P0,8), pw1[1]=PKW(P0,10), pw1); \
    VRD(5); SBAR(); GAPA(C1=__builtin_amdgcn_mfma_f32_32x32x16_bf16(kf[3],qr[1],C1,0,0,0),   P0[14],P0[15],P1[0],P1[1],   pw1[2]=PKW(P0,12),pw1[3]=PKW(P0,14), pw1); \
    VRD(2); SBAR(); GAPA(C0=__builtin_amdgcn_mfma_f32_32x32x16_bf16(kf[4],qr[2],C0,0,0,0),   P1[2],P1[3],P1[4],P1[5],     pw2[0]=PKW(P1,0), pw2[1]=PKW(P1,2), pw2); \
    VRD(6); SBAR(); GAPA(C1=__builtin_amdgcn_mfma_f32_32x32x16_bf16(kf[5],qr[2],C1,0,0,0),   P1[6],P1[7],P1[8],P1[9],     pw2[2]=PKW(P1,4), pw2[3]=PKW(P1,6), pw2); \
    VRD(3); SBAR(); GAPA(C0=__builtin_amdgcn_mfma_f32_32x32x16_bf16(kf[6],qr[3],C0,0,0,0),   P1[10],P1[11],P1[12],P1[13], pw3[0]=PKW(P1,8), pw3[1]=PKW(P1,10), pw3); \
    VRD(7); SBAR(); GAPA(C1=__builtin_amdgcn_mfma_f32_32x32x16_bf16(kf[7],qr[3],C1,0,0,0),   P1[14],P1[15],0.f,0.f,       pw3[2]=PKW(P1,12),pw3[3]=PKW(P1,14), pw3); \
    l_reg+=sacc; \
    if(GK){DMA_K((t)+3,sl_cur);} if(GV){DMA_V((t)+1,sl_next);} \
    SBAR(); \
    GAPB(o[0]=__builtin_amdgcn_mfma_f32_32x32x16_bf16(PAF(0),VFR(0),o[0],0,0,0), C0,0); \
    GAPB(o[1]=__builtin_amdgcn_mfma_f32_32x32x16_bf16(PAF(0),VFR(4),o[1],0,0,0), C0,4); \
    KRD(GL,0); GAPB(o[0]=__builtin_amdgcn_mfma_f32_32x32x16_bf16(PAF(1),VFR(1),o[0],0,0,0), C0,8); \
    KRD(GL,1); GAPB(o[1]=__builtin_amdgcn_mfma_f32_32x32x16_bf16(PAF(1),VFR(5),o[1],0,0,0), C0,12); \
    KRD(GL,2); GAPB(o[0]=__builtin_amdgcn_mfma_f32_32x32x16_bf16(PAF(2),VFR(2),o[0],0,0,0), C1,0); \
    KRD(GL,3); GAPB(o[1]=__builtin_amdgcn_mfma_f32_32x32x16_bf16(PAF(2),VFR(6),o[1],0,0,0), C1,4); \
    GAPB(o[0]=__builtin_amdgcn_mfma_f32_32x32x16_bf16(PAF(3),VFR(3),o[0],0,0,0), C1,8); \
    GAPB(o[1]=__builtin_amdgcn_mfma_f32_32x32x16_bf16(PAF(3),VFR(7),o[1],0,0,0), C1,12); \
    }while(0)
  int t=1;
  for(;t+5<NT;t+=2){
    STEP(pB0,pB1,pA0,pA1,t,true,true,true);     WAIT_BAR(2); RESC(); ROT();
    STEP(pA0,pA1,pB0,pB1,t+1,true,true,true);   WAIT_BAR(2); RESC(); ROT();
  }
  #define ENDW(tt) do{ if((tt)+3<NT){WAIT_BAR(2);} else if((tt)+2<NT){WAIT_BAR(1);} else {WAIT_BAR(0);} }while(0)
  for(;t+1<NT;t+=2){
    STEP(pB0,pB1,pA0,pA1,t,(t+3<NT),(t+1<NT),(t+1<NT));       ENDW(t);   RESC(); ROT();
    STEP(pA0,pA1,pB0,pB1,t+1,(t+4<NT),(t+2<NT),(t+2<NT));     ENDW(t+1); RESC(); ROT();
  }
  STEP(pB0,pB1,pA0,pA1,NT-1,false,false,false); RESC();
  { float sacc=pB0[0]+pB0[1]; _Pragma("unroll") for(int r=2;r<16;++r)sacc+=pB0[r]; _Pragma("unroll") for(int r=0;r<16;++r)sacc+=pB1[r]; l_reg+=sacc;
    pw0=(u32x4){PKW(pB0,0),PKW(pB0,2),PKW(pB0,4),PKW(pB0,6)};pw1=(u32x4){PKW(pB0,8),PKW(pB0,10),PKW(pB0,12),PKW(pB0,14)};pw2=(u32x4){PKW(pB1,0),PKW(pB1,2),PKW(pB1,4),PKW(pB1,6)};pw3=(u32x4){PKW(pB1,8),PKW(pB1,10),PKW(pB1,12),PKW(pB1,14)};
    SBAR(); pv(o,vb0+sl_cur,PAF(0),PAF(1),PAF(2),PAF(3)); }
  #undef PKW
  #undef PAF
  #undef VFR
  #undef PIN
  #undef MX3
  #undef GAPA
  #undef GAPB
  #undef EX
  #undef VRD
  #undef KRD
  #undef STEP
  #undef ENDW
  if(issue_next){ asm volatile("s_waitcnt lgkmcnt(0)\n\ts_barrier":::"memory");
    DMA_K(0,0);DMA_V(0,0);DMA_K(1,SLOTB);DMA_K(2,2*SLOTB); }
  {auto rr=__builtin_amdgcn_permlane32_swap(__float_as_uint(l_reg),__float_as_uint(l_reg),false,false);l_reg=__uint_as_float(rr[0])+__uint_as_float(rr[1]);}
  if(hi==0)wsf[32+r32]=l_reg;asm volatile("s_waitcnt lgkmcnt(0)":::"memory");
  float rli[16];
  #pragma unroll
  for(int r=0;r<16;++r)rli[r]=__builtin_amdgcn_rcpf(wsf[32+crow(r,hi)]);
  bf16r*Ow=O+(rowbase+q0+wid*QBLK)*OP+h*D;
  { __hip_bfloat16*stg=(__hip_bfloat16*)(shm+LDS_OST)+wid*2048;
    #pragma unroll
    for(int r=0;r<16;++r){const int orow=crow(r,hi);
      #pragma unroll
      for(int d0=0;d0<2;++d0)stg[orow*64+d0*32+r32]=__float2bfloat16(o[d0][r]*rli[r]);}
    asm volatile("s_waitcnt lgkmcnt(0)":::"memory");
    #pragma unroll
    for(int i=0;i<4;++i){const int row=i*8+(lane>>3),ch=lane&7; const u32x4 v=*(const u32x4*)(stg+row*64+ch*8); *(u32x4*)(Ow+(long)row*OP+ch*8)=v;} }
  asm volatile("s_waitcnt lgkmcnt(0)\n\ts_barrier":::"memory");
  #undef DMA_K
  #undef DMA_V
  #undef START
  #undef RESC
  #undef ROT
}
#undef SBAR
#undef WAIT_BAR
}

#define XB_TMO      128
#define XB_XCNT(j)  (256  + 64 * (j))
#define XB_XSUB(j)  (1280 + 64 * (j))
#define XB_XGEN(j)  (2304 + 64 * (j))
#define XB_TOP      3328
#define XB_TOPGEN   3392
#define XCD_BAR_WORDS 3456
#define XB_SPIN_CAP (1u << 18)

__device__ __forceinline__ unsigned xb_ld(unsigned* p)              { return __hip_atomic_load(p, __ATOMIC_RELAXED, __HIP_MEMORY_SCOPE_AGENT); }
__device__ __forceinline__ unsigned xb_add(unsigned* p, unsigned v) { return __hip_atomic_fetch_add(p, v, __ATOMIC_RELAXED, __HIP_MEMORY_SCOPE_AGENT); }
__device__ __forceinline__ unsigned xb_xcc_id() { return (unsigned)__builtin_amdgcn_s_getreg((3 << 11) | 20) & 0xFu; }
#define XB_SPIN(cond, bar) do { unsigned _sp = 0; while (cond) { __builtin_amdgcn_s_sleep(1); \
    if ((++_sp & 255u) == 0u) { if (xb_ld(&(bar)[XB_TMO])) break; if (_sp > XB_SPIN_CAP) { atomicAdd(&(bar)[XB_TMO], 1u); break; } } } } while (0)

struct XcdBarrier {
    unsigned* bar; unsigned x;
    volatile LAS unsigned* st;
};

__device__ __forceinline__ XcdBarrier xcd_barrier_post(unsigned* bar, volatile LAS unsigned* st) {
    XcdBarrier b; b.bar = bar; b.x = xb_xcc_id(); b.st = st;
    if (threadIdx.x == 0) (void)xb_add(&bar[XB_XCNT(b.x)], 1u);
    return b;
}
__device__ __forceinline__ void xcd_barrier_complete(unsigned* bar, unsigned x, unsigned& nloc, unsigned& nx) {
    const unsigned G = gridDim.x * gridDim.y * gridDim.z;
    unsigned sum, cnt, mine, sp = 0u;
    for (;;) {
        sum = 0u; cnt = 0u; mine = 0u;
#pragma unroll
        for (unsigned j = 0; j < 16; ++j) { const unsigned c = xb_ld(&bar[XB_XCNT(j)]); sum += c; cnt += (c > 0u) ? 1u : 0u; mine = (j == x) ? c : mine; }
        if (sum == G) break;
        __builtin_amdgcn_s_sleep(1);
        if ((++sp & 255u) == 0u) { if (xb_ld(&bar[XB_TMO])) break; if (sp > XB_SPIN_CAP) { atomicAdd(&bar[XB_TMO], 1u); break; } }
    }
    nloc = mine > 0u ? mine : 1u; nx = cnt > 0u ? cnt : 1u;
}

__device__ __forceinline__ void xcd_barrier(const XcdBarrier& b) {
    asm volatile("s_waitcnt vmcnt(0)" ::: "memory");
    __syncthreads();
    if (threadIdx.x == 0) {
        unsigned* bar = b.bar;
        __builtin_amdgcn_s_waitcnt(0);
        unsigned nloc = b.st[0], nx = b.st[1];
        if (nloc == 0u) { xcd_barrier_complete(bar, b.x, nloc, nx); b.st[0] = nloc; b.st[1] = nx; }
        const unsigned old = xb_add(&bar[XB_XSUB(b.x)], 1u);
        const unsigned gen = old / nloc;
        if (old + 1u == (gen + 1u) * nloc) {
            __builtin_amdgcn_fence(__ATOMIC_RELEASE, "agent");
            asm volatile("s_waitcnt vmcnt(0)" ::: "memory");
            const unsigned og = xb_add(&bar[XB_TOP], 1u);
            const unsigned tg = og / nx;
            if (og + 1u == (tg + 1u) * nx) xb_add(&bar[XB_TOPGEN], 1u);
            else XB_SPIN(xb_ld(&bar[XB_TOPGEN]) == tg, bar);
            __builtin_amdgcn_fence(__ATOMIC_ACQUIRE, "agent");
            xb_add(&bar[XB_XGEN(b.x)], 1u);
            asm volatile("s_waitcnt vmcnt(0)" ::: "memory");
        } else {
            XB_SPIN(xb_ld(&bar[XB_XGEN(b.x)]) == gen, bar);
            __builtin_amdgcn_fence(__ATOMIC_ACQUIRE, "agent");
            asm volatile("s_waitcnt vmcnt(0)" ::: "memory");
        }
    }
    __syncthreads();
}


struct Frame {
    LAS unsigned char* lds;
    int tid, lane, wave;
    int vcu, G;
    unsigned flags;
};
struct Args { const float* in[25]; float* out; unsigned char* ws; unsigned mask, pad; };

__device__ __forceinline__ void p0_transpose_item(const float* W, int K, int N, bf16* WT, int k0, int n0, int v0, LAS float* scr, int lane, const float* ksc = nullptr, int kmode = 0) {
#pragma unroll 8
    for (int i = 0; i < 32; ++i) { const int kk = 2 * i + (lane >> 5); float wv = W[(size_t)(k0 + kk) * N + n0 + (lane & 31)];
        if (ksc) { const float mv = ksc[k0 + kk]; wv *= (kmode == 1) ? (1.0f - mv) : (0.5f * mv); }
        scr[kk * 33 + (lane & 31)] = wv; }
    LDS_WAIT(); asm volatile("" ::: "memory");
    const int c = lane & 7;
#pragma unroll
    for (int j = 0; j < 4; ++j) { const int n = (lane >> 3) + 8 * j; const LAS float* s = scr + (8 * c) * 33 + n;
        v4u o; o.x = pk2(s[0 * 33], s[1 * 33]); o.y = pk2(s[2 * 33], s[3 * 33]); o.z = pk2(s[4 * 33], s[5 * 33]); o.w = pk2(s[6 * 33], s[7 * 33]);
        *(GAS v4u*)(WT + (size_t)(v0 + n) * K + k0 + 8 * c) = o; }
    LDS_WAIT(); asm volatile("" ::: "memory");
}
__device__ __forceinline__ void p0_transpose_item_fp8(const float* W, int K, int N, unsigned char* WT, int k0, int n0, int v0, LAS float* scr, int lane, float sc, bool remap16 = false) {
#pragma unroll 8
    for (int i = 0; i < 32; ++i) { const int kk = 2 * i + (lane >> 5); scr[kk * 33 + (lane & 31)] = W[(size_t)(k0 + kk) * N + n0 + (lane & 31)] * sc; }
    LDS_WAIT(); asm volatile("" ::: "memory");
    const int c = lane & 7;
#pragma unroll
    for (int j = 0; j < 4; ++j) { const int n = (lane >> 3) + 8 * j; const LAS float* s = scr + (8 * c) * 33 + n;
        unsigned w0 = 0u, w1 = 0u;
        w0 = cvt2_fp8(s[0 * 33], s[1 * 33], w0, false); w0 = cvt2_fp8(s[2 * 33], s[3 * 33], w0, true);
        w1 = cvt2_fp8(s[4 * 33], s[5 * 33], w1, false); w1 = cvt2_fp8(s[6 * 33], s[7 * 33], w1, true);
        v2u o; o.x = w0; o.y = w1;
        int vr = v0 + n;
        if (remap16) { const int t = (n0 & 255) + n, wc = t >> 6, fq = (t >> 4) & 3, bj = (t >> 3) & 1; vr = (n0 & ~255) + 128 * bj + 32 * wc + 8 * fq + (t & 7); }
        *(GAS v2u*)(WT + (size_t)vr * K + k0 + 8 * c) = o; }
    LDS_WAIT(); asm volatile("" ::: "memory");
}
struct ExpItem { const float* W; unsigned char* WT; int k0, n0, v0; bool remap; };
__device__ __forceinline__ ExpItem exp_item(const Args& a, int r) {
    constexpr int I_E = (DM / 64) * (FF / 32);
    const int mat = r / I_E, rr = r % I_E, which = mat / NE, e = mat % NE; const int nblk = FF / 32, kb = rr / nblk, nb = rr % nblk, n0 = 32 * nb;
    ExpItem it; it.k0 = 64 * kb; it.n0 = n0; it.remap = false;
    if (which == 0) { it.W = a.in[22] + (size_t)e * DM * FF; it.WT = a.ws + WS_WGU + (size_t)e * 2 * FF * DM; it.v0 = 256 * (n0 >> 7) + (n0 & 127); }
    else if (which == 1) { it.W = a.in[23] + (size_t)e * DM * FF; it.WT = a.ws + WS_WGU + (size_t)e * 2 * FF * DM; it.v0 = 256 * (n0 >> 7) + 128 + (n0 & 127); }
    else { it.W = a.in[24] + (size_t)e * FF * DM; it.WT = a.ws + WS_WD + (size_t)e * DM * FF; it.v0 = n0; it.remap = true; }
    return it;
}
__device__ __forceinline__ void exp_item_load(const ExpItem& it, float (&t)[32], int lane) {
#pragma unroll
    for (int i = 0; i < 32; ++i) { const int kk = 2 * i + (lane >> 5); t[i] = it.W[(size_t)(it.k0 + kk) * FF + it.n0 + (lane & 31)]; }
}
__device__ __forceinline__ void exp_item_store(const ExpItem& it, const float (&t)[32], LAS float* scr, int lane) {
#pragma unroll
    for (int i = 0; i < 32; ++i) { const int kk = 2 * i + (lane >> 5); scr[kk * 33 + (lane & 31)] = t[i] * 32.0f; }
    LDS_WAIT(); asm volatile("" ::: "memory");
    const int c = lane & 7;
#pragma unroll
    for (int j = 0; j < 4; ++j) { const int n = (lane >> 3) + 8 * j; const LAS float* s = scr + (8 * c) * 33 + n;
        unsigned w0 = 0u, w1 = 0u;
        w0 = cvt2_fp8(s[0 * 33], s[1 * 33], w0, false); w0 = cvt2_fp8(s[2 * 33], s[3 * 33], w0, true);
        w1 = cvt2_fp8(s[4 * 33], s[5 * 33], w1, false); w1 = cvt2_fp8(s[6 * 33], s[7 * 33], w1, true);
        v2u o; o.x = w0; o.y = w1;
        int vr = it.v0 + n;
        if (it.remap) { const int tt = (it.n0 & 255) + n, wc = tt >> 6, fq = (tt >> 4) & 3, bj = (tt >> 3) & 1; vr = (it.n0 & ~255) + 128 * bj + 32 * wc + 8 * fq + (tt & 7); }
        *(GAS v2u*)(it.WT + (size_t)vr * 1024 + it.k0 + 8 * c) = o; }
    LDS_WAIT(); asm volatile("" ::: "memory");
}
__host__ __device__ __forceinline__ int win_virt32(int n0) { const int tile = n0 >> 8, t = n0 & 255, wc = t >> 6, bj = (t >> 5) & 1; return 256 * tile + 128 * bj + 32 * wc; }

__device__ __forceinline__ void p0_prologue(Frame& F, const Args& a) {
    unsigned char* ws = a.ws;
    if (F.vcu < 192) {
        LAS float* st = (LAS float*)F.lds;
        const float* c = a.in[1];
        for (int i = F.tid; i < NB * DM; i += 512) { const float v = c[i]; st[i] = v / (1.0f + __expf(-v)); }
        __syncthreads();
        const int cc = F.tid & 31, kg = F.tid >> 5, col0 = F.vcu * 32;
        const float* wa = a.in[2] + (size_t)(kg * 64) * (6 * DM) + col0 + cc;
        float acc[32];
#pragma unroll
        for (int b = 0; b < 32; ++b) acc[b] = 0.f;
        for (int k = 0; k < 64; ++k) {
            const float wv = wa[(size_t)k * (6 * DM)];
            const LAS float* sp = st + kg * 64 + k;
#pragma unroll
            for (int b = 0; b < 32; ++b) acc[b] += sp[b * DM] * wv;
        }
        __syncthreads();
        LAS float* part = (LAS float*)F.lds;
#pragma unroll
        for (int b = 0; b < 32; ++b) part[(kg * 32 + b) * 32 + cc] = acc[b];
        __syncthreads();
        float* mod = (float*)(ws + WS_MOD);
        for (int o = F.tid; o < 1024; o += 512) { const int b = o >> 5, c2 = o & 31; float s = a.in[3][col0 + c2];
#pragma unroll
            for (int g = 0; g < 16; ++g) s += part[(g * 32 + b) * 32 + c2];
            mod[b * (6 * DM) + col0 + c2] = s; }
        __syncthreads();
    } else {
        float* rope = (float*)(ws + WS_ROPE);
        for (int j = (F.vcu - 192) * 512 + F.tid; j < SEQ * 32; j += 64 * 512) {
            const int t = j >> 5, i = j & 31;
            const float pos = (i < 16) ? (float)(t >> 6) : (float)(t & 63);
            const float freq = powf(10000.0f, -(float)(i & 15) / 16.0f);
            const float ang = pos * freq;
            rope[2 * j] = cosf(ang); rope[2 * j + 1] = sinf(ang);
        }
    }
    LAS float* scr = (LAS float*)(F.lds + F.wave * 16384);
    const int gw = F.vcu * NWAVES + F.wave, NGW = F.G * NWAVES;
    constexpr int I_IN = (DM / 64) * (NIN / 32), I_OUT = (DM / 64) * (DM / 32), I_E = (DM / 64) * (FF / 32), I_GUP = (128 / 64) * (RW / 32);
    constexpr int I_LORA = 6 * (RW / 32);
    constexpr int NITEMS = I_IN + I_OUT + I_GUP + I_LORA;
    for (int it = gw; it < NITEMS; it += NGW) {
        int r = it;
        if (r < I_IN) { const int nblk = NIN / 32, kb = r / nblk, nb = r % nblk; p0_transpose_item(a.in[5], DM, NIN, (bf16*)(ws + WS_WIN), 64 * kb, 32 * nb, win_virt32(32 * nb), scr, F.lane); continue; } r -= I_IN;
        if (r < I_OUT) { const int nblk = DM / 32, kb = r / nblk, nb = r % nblk; p0_transpose_item(a.in[19], DM, DM, (bf16*)(ws + WS_WOUT), 64 * kb, 32 * nb, 32 * nb, scr, F.lane); continue; } r -= I_OUT;
        if (r < I_GUP) { const int nblk = RW / 32, kb = r / nblk, nb = r % nblk; p0_transpose_item(a.in[13], 128, RW, (bf16*)(ws + WS_GUPT), 64 * kb, 32 * nb, 32 * nb, scr, F.lane); continue; } r -= I_GUP;
        { const int nblk = RW / 32, md = r / nblk, nb = r % nblk, which = md >> 1, d = md & 1;
          if (which == 0) p0_transpose_item(a.in[10] + (size_t)d * 64 * RW, 64, RW, (bf16*)(ws + WS_WUPT) + (size_t)d * RW * 64, 0, 32 * nb, 32 * nb, scr, F.lane);
          else if (which == 1) p0_transpose_item(a.in[12] + (size_t)d * 64 * RW, 64, RW, (bf16*)(ws + WS_AUPT) + (size_t)d * RW * 64, 0, 32 * nb, 32 * nb, scr, F.lane); }
    }
}

__device__ __forceinline__ void p1_norm(Frame& F, const Args& a) {
    const float* mod = (const float*)(a.ws + WS_MOD); bf16* H = (bf16*)(a.ws + WS_H);
    const int gw = F.vcu * NWAVES + F.wave; const int b = F.vcu >> 3;
    f32x4 gs[4], sh[4];
#pragma unroll
    for (int j = 0; j < 4; ++j) { const int c = 4 * F.lane + 256 * j; const f32x4 g = *(const f32x4*)(a.in[4] + c); const f32x4 sc = *(const f32x4*)(mod + b * 6 * DM + DM + c);
        gs[j] = g * (sc + 1.0f); sh[j] = *(const f32x4*)(mod + b * 6 * DM + c); }
    f32x4 vn[4][4];
#pragma unroll
    for (int r = 0; r < 4; ++r) { const GAS f32x4* xr = (const GAS f32x4*)(a.in[0] + ((size_t)gw * 32 + r) * DM) + F.lane;
#pragma unroll
        for (int j = 0; j < 4; ++j) vn[r][j] = xr[64 * j]; }
    for (int i = 0; i < 32; i += 4) {
        const size_t row = (size_t)gw * 32 + i;
        f32x4 v[4][4]; float s2[4];
#pragma unroll
        for (int r = 0; r < 4; ++r)
#pragma unroll
            for (int j = 0; j < 4; ++j) v[r][j] = vn[r][j];
        if (i + 4 < 32) {
#pragma unroll
            for (int r = 0; r < 4; ++r) { const GAS f32x4* xr = (const GAS f32x4*)(a.in[0] + (row + 4 + r) * DM) + F.lane;
#pragma unroll
                for (int j = 0; j < 4; ++j) vn[r][j] = xr[64 * j]; } }
        asm volatile("" ::: "memory");
#pragma unroll
        for (int r = 0; r < 4; ++r) { float t = 0.f;
#pragma unroll
            for (int j = 0; j < 4; ++j) t += (v[r][j].x * v[r][j].x + v[r][j].y * v[r][j].y) + (v[r][j].z * v[r][j].z + v[r][j].w * v[r][j].w);
            s2[r] = t; }
#pragma unroll
        for (int r = 0; r < 4; ++r) s2[r] = wave_sum(s2[r]);
#pragma unroll
        for (int r = 0; r < 4; ++r) { const float rstd = 1.0f / sqrtf(s2[r] * (1.0f / DM) + NORM_EPS);
            GAS unsigned long long* o8 = (GAS unsigned long long*)(H + (row + r) * DM) + F.lane;
#pragma unroll
            for (int j = 0; j < 4; ++j) { const f32x4 y = v[r][j] * rstd * gs[j] + sh[j]; o8[64 * j] = (unsigned long long)pk2(y.x, y.y) | ((unsigned long long)pk2(y.z, y.w) << 32); } }
    }
}

struct EpiInProj {
    static constexpr bool PERM = true;
    bf16 *Q, *K, *V, *PR; const float *qn, *kn, *rope;
    __device__ __forceinline__ void operator()(const f32x4 (&acc)[2][2][4][2], const pg8::Unit& u, int wr, int wc, int fr, int fq) const {
        { int l_ = threadIdx.x; asm volatile("" : "+v"(l_)); fr = l_ & 15; fq = (l_ >> 4) & 3; }
        const int row0 = u.pm * 256 + wr * 64 + fr;
        if (u.pn >= 3) {
            const int col0 = 256 * (u.pn - 3) + 64 * wc + 8 * fq;
#pragma unroll
            for (int ai = 0; ai < 2; ++ai)
#pragma unroll
                for (int m = 0; m < 4; ++m) { bf16* rowp = PR + (size_t)(row0 + ai * 128 + m * 16) * NSH + col0;
#pragma unroll
                    for (int bj = 0; bj < 2; ++bj) { const f32x4 v0 = acc[ai][bj][m][0], v1 = acc[ai][bj][m][1];
                        v4u w; w.x = pk2(v0[0], v0[1]); w.y = pk2(v0[2], v0[3]); w.z = pk2(v1[0], v1[1]); w.w = pk2(v1[2], v1[3]);
                        *(v4u*)(rowp + 32 * bj) = w; } }
            return;
        }
        const bool isV = (u.pn == 2 && wc >= 2);
        if (isV) {
            const int col0 = 64 * (wc - 2) + 8 * fq;
#pragma unroll
            for (int ai = 0; ai < 2; ++ai)
#pragma unroll
                for (int m = 0; m < 4; ++m) { bf16* rowp = V + (size_t)(row0 + ai * 128 + m * 16) * KVW + col0;
#pragma unroll
                    for (int bj = 0; bj < 2; ++bj) { const f32x4 v0 = acc[ai][bj][m][0], v1 = acc[ai][bj][m][1];
                        v4u w; w.x = pk2(v0[0], v0[1]); w.y = pk2(v0[2], v0[3]); w.z = pk2(v1[0], v1[1]); w.w = pk2(v1[2], v1[3]);
                        *(v4u*)(rowp + 32 * bj) = w; } }
            return;
        }
        const bool isQ = (u.pn < 2);
        const float* gn = isQ ? qn : kn;
        bf16* dst = isQ ? (Q + 64 * (4 * u.pn + wc)) : (K + 64 * wc);
        const int pitch = isQ ? AW : KVW;
        const float osc = isQ ? QSCALE : 1.0f;
        f32x4 gv[2][2];
#pragma unroll
        for (int bj = 0; bj < 2; ++bj)
#pragma unroll
            for (int n = 0; n < 2; ++n) gv[bj][n] = *(const f32x4*)(gn + 32 * bj + 8 * fq + 4 * n);
#pragma unroll
        for (int ai = 0; ai < 2; ++ai) {
            f32x4 csv[4][2][2];
#pragma unroll
            for (int m = 0; m < 4; ++m) { const int t = (row0 + ai * 128 + m * 16) & (SEQ - 1);
#pragma unroll
                for (int bj = 0; bj < 2; ++bj)
#pragma unroll
                    for (int n = 0; n < 2; ++n) csv[m][bj][n] = *(const f32x4*)(rope + ((size_t)t * 32 + 16 * bj + 4 * fq + 2 * n) * 2); }
            asm volatile("" ::: "memory");
#pragma unroll
            for (int m = 0; m < 4; ++m) {
                const int row = row0 + ai * 128 + m * 16;
                float ss = 0.f;
#pragma unroll
                for (int bj = 0; bj < 2; ++bj)
#pragma unroll
                    for (int n = 0; n < 2; ++n) { const f32x4 x = acc[ai][bj][m][n]; ss += (x[0] * x[0] + x[1] * x[1]) + (x[2] * x[2] + x[3] * x[3]); }
                ss = xor32_sum(xor16_sum(ss));
                const float rstd = 1.0f / sqrtf(ss * (1.0f / 64.0f) + NORM_EPS);
                bf16* rowp = dst + (size_t)row * pitch + 8 * fq;
#pragma unroll
                for (int bj = 0; bj < 2; ++bj) {
                    unsigned w[4];
#pragma unroll
                    for (int n = 0; n < 2; ++n) {
                        const f32x4 x = acc[ai][bj][m][n] * rstd * gv[bj][n];
                        const f32x4 cs = csv[m][bj][n];
                        const float o0 = x[0] * cs[0] - x[1] * cs[1], o1 = x[0] * cs[1] + x[1] * cs[0];
                        const float o2 = x[2] * cs[2] - x[3] * cs[3], o3 = x[2] * cs[3] + x[3] * cs[2];
                        w[2 * n] = pk2(o0 * osc, o1 * osc); w[2 * n + 1] = pk2(o2 * osc, o3 * osc);
                    }
                    v4u wv; wv.x = w[0]; wv.y = w[1]; wv.z = w[2]; wv.w = w[3];
                    *(v4u*)(rowp + 32 * bj) = wv;
                }
            }
            asm volatile("" ::: "memory");
        }
    }
};

struct EpiOutProj {
    static constexpr bool PERM = true;
    const float* x; bf16* x1; const float* mod;
    __device__ __forceinline__ void operator()(const f32x4 (&acc)[2][2][4][2], const pg8::Unit& u, int wr, int wc, int fr, int fq) const {
        { int l_ = threadIdx.x; asm volatile("" : "+v"(l_)); fr = l_ & 15; fq = (l_ >> 4) & 3; }
        const int row0 = u.pm * 256 + wr * 64 + fr, col0 = u.pn * 256 + wc * 32 + 8 * fq; const int b = u.pm >> 3;
        f32x4 gt[2][2];
#pragma unroll
        for (int bj = 0; bj < 2; ++bj)
#pragma unroll
            for (int n = 0; n < 2; ++n) gt[bj][n] = *(const f32x4*)(mod + b * 6 * DM + 2 * DM + col0 + bj * 128 + n * 4);
#pragma unroll
        for (int ai = 0; ai < 2; ++ai) {
            f32x4 xv[4][2][2];
#pragma unroll
            for (int m = 0; m < 4; ++m) { const size_t off = (size_t)(row0 + ai * 128 + m * 16) * DM + col0;
#pragma unroll
                for (int bj = 0; bj < 2; ++bj)
#pragma unroll
                    for (int n = 0; n < 2; ++n) xv[m][bj][n] = *(const f32x4*)(x + off + bj * 128 + n * 4); }
            asm volatile("" ::: "memory");
#pragma unroll
            for (int m = 0; m < 4; ++m) { const size_t off = (size_t)(row0 + ai * 128 + m * 16) * DM + col0;
#pragma unroll
                for (int bj = 0; bj < 2; ++bj) { const f32x4 v0 = xv[m][bj][0] + gt[bj][0] * acc[ai][bj][m][0], v1 = xv[m][bj][1] + gt[bj][1] * acc[ai][bj][m][1];
                    v4u w; w.x = pk2(v0[0], v0[1]); w.y = pk2(v0[2], v0[3]); w.z = pk2(v1[0], v1[1]); w.w = pk2(v1[2], v1[3]);
                    *(v4u*)(x1 + off + bj * 128) = w; } }
            asm volatile("" ::: "memory");
        }
    }
};


__device__ __forceinline__ void prs_pass(Frame& F, const Args& a) {
    const bf16* __restrict__ PR = (const bf16*)(a.ws + WS_PR); bf16* __restrict__ RK = (bf16*)(a.ws + WS_RKVS); bf16* __restrict__ TD = (bf16*)(a.ws + WS_TDS);
    const float* __restrict__ mu = a.in[8];
    const int lane = F.lane; const int b = F.vcu >> 3;
    f32x4 mus[7];
#pragma unroll
    for (int cs = 0; cs < 7; ++cs) mus[cs] = *(const f32x4*)(mu + 256 * cs + 4 * lane);
    v2u xn[7][6];
#define PRS_LOAD(G) do { _Pragma("unroll") for (int r = 0; r < 6; ++r) { int t_ = 4 * (G) - 1 + r; t_ = t_ < 0 ? 0 : t_ > SEQ - 1 ? SEQ - 1 : t_; \
            const bf16* rp_ = PR + ((size_t)b * SEQ + t_) * NSH + 4 * lane; _Pragma("unroll") for (int cs = 0; cs < 7; ++cs) xn[cs][r] = *(const v2u*)(rp_ + 256 * cs); } } while (0)
    PRS_LOAD((F.vcu & 7) * 64 + F.wave * 8);
    for (int it = 0; it < 8; ++it) {
        const int g = (F.vcu & 7) * 64 + F.wave * 8 + it;
        const size_t row0 = (size_t)b * SEQ + 4 * g;
        v2u x[7][6];
#pragma unroll
        for (int cs = 0; cs < 7; ++cs)
#pragma unroll
            for (int r = 0; r < 6; ++r) x[cs][r] = xn[cs][r];
        if (it + 1 < 8) PRS_LOAD(g + 1);
        asm volatile("" ::: "memory");
        if (g == 0) {
#pragma unroll
            for (int cs = 0; cs < 7; ++cs) x[cs][0] = (v2u){0u, 0u}; }
        if (g == SEQ / 4 - 1) {
#pragma unroll
            for (int cs = 0; cs < 7; ++cs) x[cs][5] = (v2u){0u, 0u}; }
#pragma unroll
        for (int cs = 0; cs < 7; ++cs) {
            float y[4][4];
#pragma unroll
            for (int e = 0; e < 4; ++e) { const v2u c = x[cs][e + 1], p = x[cs][e], n = x[cs][e + 2];
                const float c0 = bflo(c.x), c1 = bfhi(c.x), c2 = bflo(c.y), c3 = bfhi(c.y);
                y[e][0] = c0 + mus[cs][0] * (0.5f * (bflo(p.x) + bflo(n.x)) - c0); y[e][1] = c1 + mus[cs][1] * (0.5f * (bfhi(p.x) + bfhi(n.x)) - c1);
                y[e][2] = c2 + mus[cs][2] * (0.5f * (bflo(p.y) + bflo(n.y)) - c2); y[e][3] = c3 + mus[cs][3] * (0.5f * (bfhi(p.y) + bfhi(n.y)) - c3); }
            if (cs < 6) {
                bf16* dst = RK + (((size_t)b * (SEQ / 4) + g) * 1536 + 256 * cs + 4 * lane) * 4;
                v4u w0, w1;
                w0.x = pk2(y[0][0], y[1][0]); w0.y = pk2(y[2][0], y[3][0]); w0.z = pk2(y[0][1], y[1][1]); w0.w = pk2(y[2][1], y[3][1]);
                w1.x = pk2(y[0][2], y[1][2]); w1.y = pk2(y[2][2], y[3][2]); w1.z = pk2(y[0][3], y[1][3]); w1.w = pk2(y[2][3], y[3][3]);
                *(v4u*)dst = w0; *(v4u*)(dst + 8) = w1;
            } else {
#pragma unroll
                for (int e = 0; e < 4; ++e) { float o[4];
#pragma unroll
                    for (int j = 0; j < 4; ++j) { const float v = y[e][j]; const float th = 1.0f - 2.0f * __builtin_amdgcn_rcpf(__expf(2.0f * v) + 1.0f), sg = __builtin_amdgcn_rcpf(1.0f + __expf(-v));
                        o[j] = lane < 16 ? th : lane < 32 ? v : sg; }
                    v2u w; w.x = pk2(o[0], o[1]); w.y = pk2(o[2], o[3]);
                    *(v2u*)(TD + (row0 + e) * 256 + 4 * lane) = w; }
            }
        }
    }
}

#undef PRS_LOAD
namespace wkv {
constexpr int SLOT = 12544, O_AT = 0, O_RT = 2048, O_BT = 4096, O_KT = 6144, O_VT = 8192, O_MAK = 10240, O_MTM = 10752, O_MRB = 11264, O_MRK = 11776, O_GC = 12288;
typedef short v4i16_t __attribute__((ext_vector_type(4)));
typedef __bf16 bf16x2_t __attribute__((ext_vector_type(2)));
__device__ __forceinline__ unsigned cvtpk(float lo, float hi) { f32x2 v = {lo, hi}; bf16x2_t b = __builtin_convertvector(v, bf16x2_t); return __builtin_bit_cast(unsigned, b); }
__device__ __forceinline__ v2u pack4(const f32x4 v) { v2u r; r.x = cvtpk(v[0], v[1]); r.y = cvtpk(v[2], v[3]); return r; }
__device__ __forceinline__ bf16x8 frag(v2u lo, v2u hi) { v4u w; w.x = lo.x; w.y = lo.y; w.z = hi.x; w.w = hi.y; return __builtin_bit_cast(bf16x8, w); }
__device__ __forceinline__ bf16x8 frag4(const f32x4 v) { return frag(pack4(v), (v2u){0u, 0u}); }
__device__ __forceinline__ v2u trrd(LAS const unsigned char* p) { return __builtin_bit_cast(v2u, __builtin_amdgcn_ds_read_tr16_b64_v4i16((LAS v4i16_t*)p)); }
__device__ __forceinline__ bf16x8 trop(LAS const unsigned char* arr, int m, int lane) {
    LAS const unsigned char* p = arr + (32 * m + 4 * (lane >> 4) + ((lane & 15) >> 2)) * 32 + (lane & 3) * 8;
    return frag(trrd(p), trrd(p + 16 * 32));
}
#define MFMA16(A, B, C) __builtin_amdgcn_mfma_f32_16x16x32_bf16((A), (B), (C), 0, 0, 0)
__device__ __forceinline__ void up8(const v4u w, float (&o)[8]) { o[0] = bflo(w.x); o[1] = bfhi(w.x); o[2] = bflo(w.y); o[3] = bfhi(w.y); o[4] = bflo(w.z); o[5] = bfhi(w.z); o[6] = bflo(w.w); o[7] = bfhi(w.w); }
__device__ __forceinline__ bf16x8 pack8(const float (&o)[8]) { v4u w; w.x = cvtpk(o[0], o[1]); w.y = cvtpk(o[2], o[3]); w.z = cvtpk(o[4], o[5]); w.w = cvtpk(o[6], o[7]); return __builtin_bit_cast(bf16x8, w); }
__device__ __forceinline__ float dppf(float v, int ctrl_tag);
#define WKV_DPP_ADD(v, CTRL) ((v) + __builtin_bit_cast(float, __builtin_amdgcn_update_dpp(0, __builtin_bit_cast(int, (v)), (CTRL), 0xf, 0xf, false)))
__device__ __forceinline__ float red16(float v) { v = WKV_DPP_ADD(v, 0xB1); v = WKV_DPP_ADD(v, 0x4E); v = WKV_DPP_ADD(v, 0x141); v = WKV_DPP_ADD(v, 0x140); return v; }
__device__ __forceinline__ float fsig(float x) { return __builtin_amdgcn_rcpf(1.0f + __expf(-x)); }
constexpr int NRAW = 10;
constexpr int LORA_OFF = 8 * SLOT + 12 * 64 * 4, LORA_ROW = 144, LORA_TAB = 64 * LORA_ROW;
constexpr int CST_OFF = 8 * SLOT;
__device__ __forceinline__ void prep_load(v4u (&raw)[NRAW], const bf16* RK, const bf16* TD, int b, int h, int dir, int c, int lane) {
    const int kl = lane & 15, q = lane >> 4;
    const int g = dir ? (SEQ / 4 - 1 - (4 * c + q)) : (4 * c + q);
    const bf16* rp = RK + (((size_t)b * (SEQ / 4) + g) * 1536 + 64 * h + kl) * 4;
#pragma unroll
    for (int X = 0; X < 3; ++X)
#pragma unroll
        for (int cp = 0; cp < 2; ++cp) { const v2u lo = *(const v2u*)(rp + (512 * X + 16 * (2 * cp)) * 4), hi = *(const v2u*)(rp + (512 * X + 16 * (2 * cp + 1)) * 4);
            raw[X * 2 + cp] = (v4u){lo.x, lo.y, hi.x, hi.y}; }
    const int s_i = c * 16 + kl; const int t_i = dir ? (SEQ - 1 - s_i) : s_i;
    const bf16* tp = TD + ((size_t)b * SEQ + t_i) * 256 + 8 * q;
#pragma unroll
    for (int m = 0; m < 2; ++m) { raw[6 + m] = *(const v4u*)(tp + 32 * m); raw[8 + m] = *(const v4u*)(tp + 64 + 32 * m); }
}
__device__ __forceinline__ f32x4 up4(unsigned w0, unsigned w1, bool rev) {
    const f32x4 t = (f32x4){bflo(w0), bfhi(w0), bflo(w1), bfhi(w1)};
    return rev ? (f32x4){t[3], t[2], t[1], t[0]} : t;
}

__device__ __forceinline__ void prep(const v4u (&raw)[NRAW], const Args& a, int b, int h, int dir, int c, LAS unsigned char* slot, LAS const float* cst, int lane, bool nostore) {
    const int kl = lane & 15, q = lane >> 4;
    LAS const unsigned char* lw_ = (LAS const unsigned char*)cst + (LORA_OFF - CST_OFF) + dir * 2 * LORA_TAB; LAS const unsigned char* la_ = lw_ + LORA_TAB;
    float* BON = (float*)(a.ws + WS_BON) + (size_t)dir * MT * 8;
    const f32x4 z4 = (f32x4){0.f, 0.f, 0.f, 0.f};
    const bool rev = dir != 0;
    f32x4 wp[4], ap[4], rx[4], kx[4], vx[4];
#pragma unroll
    for (int ct = 0; ct < 4; ++ct) { wp[ct] = z4; ap[ct] = z4;
#pragma unroll
        for (int m = 0; m < 2; ++m) { const int off = (16 * ct + kl) * LORA_ROW + (32 * m + 8 * q) * 2;
            wp[ct] = MFMA16(__builtin_bit_cast(bf16x8, raw[6 + m]), *(const LAS bf16x8*)(lw_ + off), wp[ct]); ap[ct] = MFMA16(__builtin_bit_cast(bf16x8, raw[8 + m]), *(const LAS bf16x8*)(la_ + off), ap[ct]); } }
    if (rev) {
#pragma unroll
        for (int cp = 0; cp < 2; ++cp) {
            rx[2 * cp] = up4(raw[0 + cp].x, raw[0 + cp].y, true); rx[2 * cp + 1] = up4(raw[0 + cp].z, raw[0 + cp].w, true);
            kx[2 * cp] = up4(raw[2 + cp].x, raw[2 + cp].y, true); kx[2 * cp + 1] = up4(raw[2 + cp].z, raw[2 + cp].w, true);
            vx[2 * cp] = up4(raw[4 + cp].x, raw[4 + cp].y, true); vx[2 * cp + 1] = up4(raw[4 + cp].z, raw[4 + cp].w, true); }
    } else {
#pragma unroll
        for (int cp = 0; cp < 2; ++cp) {
            rx[2 * cp] = up4(raw[0 + cp].x, raw[0 + cp].y, false); rx[2 * cp + 1] = up4(raw[0 + cp].z, raw[0 + cp].w, false);
            kx[2 * cp] = up4(raw[2 + cp].x, raw[2 + cp].y, false); kx[2 * cp + 1] = up4(raw[2 + cp].z, raw[2 + cp].w, false);
            vx[2 * cp] = up4(raw[4 + cp].x, raw[4 + cp].y, false); vx[2 * cp + 1] = up4(raw[4 + cp].z, raw[4 + cp].w, false); }
    }
    f32x4 n2 = z4, bsum = z4;
    f32x4 av[4], kd[4];
#pragma unroll
    for (int ct = 0; ct < 4; ++ct) { const int cj = 16 * ct + kl;
        const float a0 = cst[(5 + dir) * 64 + cj], kkg = cst[9 * 64 + cj], kag = cst[10 * 64 + cj], rkg = cst[11 * 64 + cj];
#pragma unroll
        for (int e = 0; e < 4; ++e) { av[ct][e] = fsig(ap[ct][e] + a0); const float kkv = kx[ct][e] * kkg; n2[e] += kkv * kkv;
            kd[ct][e] = kx[ct][e] * (1.0f + (av[ct][e] - 1.0f) * kag); bsum[e] += rx[ct][e] * kd[ct][e] * rkg; } }
#pragma unroll
    for (int e = 0; e < 4; ++e) { n2[e] = red16(n2[e]); bsum[e] = red16(bsum[e]); }
    if (kl == 0 && !nostore) {
        const int s0 = c * 16 + 4 * q; const int t0 = rev ? (SEQ - 1 - s0 - 3) : s0;
        *(f32x4*)(BON + ((size_t)b * 8 + h) * SEQ + t0) = rev ? (f32x4){bsum[3], bsum[2], bsum[1], bsum[0]} : bsum; }
    f32x4 rn;
#pragma unroll
    for (int e = 0; e < 4; ++e) rn[e] = __builtin_amdgcn_rsqf(fmaxf(n2[e], 1e-24f));
#pragma unroll
    for (int ct = 0; ct < 4; ++ct) { const int cj = 16 * ct + kl;
        const float w0 = cst[(7 + dir) * 64 + cj], kkg = cst[9 * 64 + cj];
        f32x4 L, lw;
#pragma unroll
        for (int e = 0; e < 4; ++e) lw[e] = -DECAY_SCALE * fsig(wp[ct][e] + w0);
        L[0] = lw[0]; L[1] = L[0] + lw[1]; L[2] = L[1] + lw[2]; L[3] = L[2] + lw[3];
        const float g = L[3];
        const auto ra = __builtin_amdgcn_permlane16_swap(__float_as_uint(g), __float_as_uint(g), false, false);
        const float pair = __uint_as_float(ra[0]) + __uint_as_float(ra[1]);
        const auto rb = __builtin_amdgcn_permlane32_swap(__float_as_uint(pair), __float_as_uint(pair), false, false);
        const float P = ((q & 1) ? __uint_as_float(ra[0]) : 0.f) + ((q & 2) ? __uint_as_float(rb[0]) : 0.f);
        const float Ltot = __uint_as_float(rb[0]) + __uint_as_float(rb[1]);
        f32x4 ah, bh, kh, rh;
#pragma unroll
        for (int e = 0; e < 4; ++e) { const float Le = L[e] + P; const float ep = __expf(Le), en = __expf(-Le), epv = __expf(Le - lw[e]);
            const float kk = kx[ct][e] * kkg * rn[e];
            ah[e] = -kk * epv; bh[e] = kk * av[ct][e] * en; kh[e] = kd[ct][e] * en; rh[e] = rx[ct][e] * ep; }
        const int ro = (16 * ct + kl) * 32 + q * 8;
        *(LAS v2u*)(slot + O_AT + ro) = pack4(ah); *(LAS v2u*)(slot + O_BT + ro) = pack4(bh); *(LAS v2u*)(slot + O_KT + ro) = pack4(kh); *(LAS v2u*)(slot + O_RT + ro) = pack4(rh);
        *(LAS v2u*)(slot + O_VT + ro) = pack4(vx[ct]);
        if (q == 0) *(LAS float*)(slot + O_GC + (16 * ct + kl) * 4) = __expf(Ltot);
    }
    LDS_WAIT();
    f32x4 OA = z4, OAT = z4, OAK = z4, ORB = z4, ORK = z4;
#pragma unroll
    for (int m = 0; m < 2; ++m) { const bf16x8 tA = trop(slot + O_AT, m, lane), tB = trop(slot + O_BT, m, lane), tK = trop(slot + O_KT, m, lane), tR = trop(slot + O_RT, m, lane);
        OA = MFMA16(tA, tB, OA); OAT = MFMA16(tB, tA, OAT); OAK = MFMA16(tK, tA, OAK); ORB = MFMA16(tB, tR, ORB); ORK = MFMA16(tK, tR, ORK); }
    f32x4 Z;
#pragma unroll
    for (int e = 0; e < 4; ++e) { const int rr = 4 * q + e;
        OA[e] = (kl < rr) ? OA[e] : 0.f;
        OAT[e] = (rr < kl) ? OAT[e] : 0.f;
        OAK[e] = (rr < kl) ? OAK[e] : 0.f; ORB[e] = (rr <= kl) ? ORB[e] : 0.f; ORK[e] = (rr <= kl) ? ORK[e] : 0.f;
        Z[e] = OAT[e] + ((rr == kl) ? 1.0f : 0.f); }
    *(LAS v2u*)(slot + O_MAK + lane * 8) = pack4(OAK); *(LAS v2u*)(slot + O_MRB + lane * 8) = pack4(ORB); *(LAS v2u*)(slot + O_MRK + lane * 8) = pack4(ORK);
    const bf16x8 pA = frag4(OA), pAT = frag4(OAT);
    const f32x4 OA2 = MFMA16(pAT, pA, z4), OA2T = MFMA16(pA, pAT, z4);
    const bf16x8 pA2 = frag4(OA2), pA2T = frag4(OA2T);
    const f32x4 OA4 = MFMA16(pA2T, pA2, z4), OA4T = MFMA16(pA2, pA2T, z4);
    const bf16x8 pA4 = frag4(OA4), pA4T = frag4(OA4T);
    const f32x4 OA8 = MFMA16(pA4T, pA4, z4);
    Z = MFMA16(pA2, frag4(Z), Z);
    Z = MFMA16(pA4, frag4(Z), Z);
    Z = MFMA16(frag4(OA8), frag4(Z), Z);
    *(LAS v2u*)(slot + O_MTM + lane * 8) = pack4(Z);
}

__device__ __forceinline__ v2u scan_chunk(f32x4 (&acc)[4], LAS const unsigned char* slot, int vs, int lane, bool rev) {
    const int kl = lane & 15, q = lane >> 4;
    const f32x4 z4 = (f32x4){0.f, 0.f, 0.f, 0.f}; const v2u z2 = (v2u){0u, 0u};
    const bf16x8 Sb0 = frag(pack4(acc[0]), pack4(acc[1])), Sb1 = frag(pack4(acc[2]), pack4(acc[3]));
    const v2u Vv = *(const LAS v2u*)(slot + O_VT + (16 * vs + kl) * 32 + q * 8);
    f32x4 X = MFMA16(frag(*(const LAS v2u*)(slot + O_MAK + lane * 8), z2), frag(Vv, z2), z4);
    X = MFMA16(trop(slot + O_AT, 0, lane), Sb0, X); X = MFMA16(trop(slot + O_AT, 1, lane), Sb1, X);
    const f32x4 Ut = MFMA16(frag(*(const LAS v2u*)(slot + O_MTM + lane * 8), z2), frag4(X), z4);
    const bf16x8 UV = frag(pack4(Ut), Vv);
    f32x4 Yt = MFMA16(trop(slot + O_RT, 0, lane), Sb0, z4); Yt = MFMA16(trop(slot + O_RT, 1, lane), Sb1, Yt);
    Yt = MFMA16(frag(*(const LAS v2u*)(slot + O_MRB + lane * 8), *(const LAS v2u*)(slot + O_MRK + lane * 8)), UV, Yt);
    v2u w; if (rev) { w.x = cvtpk(Yt[3], Yt[2]); w.y = cvtpk(Yt[1], Yt[0]); } else { w.x = cvtpk(Yt[0], Yt[1]); w.y = cvtpk(Yt[2], Yt[3]); }
#pragma unroll
    for (int kt = 0; kt < 4; ++kt) {
        const int ro = (16 * kt + kl) * 32 + q * 8;
        acc[kt] = MFMA16(frag(*(const LAS v2u*)(slot + O_BT + ro), *(const LAS v2u*)(slot + O_KT + ro)), UV, acc[kt]);
        acc[kt] = acc[kt] * *(const LAS f32x4*)(slot + O_GC + (16 * kt + 4 * q) * 4);
    }
    return w;
}

__device__ __forceinline__ void phase(Frame& F, const Args& a) {
    const int b = F.vcu >> 3, h = F.vcu & 7; const int w = F.wave, lane = F.lane;
    const int dir = w >> 2, vs = w & 3;
    LAS unsigned char* slots = F.lds;
    LAS float* cst = (LAS float*)(F.lds + CST_OFF);
    for (int idx = F.tid; idx < 12 * 64; idx += 512) { const int arr = idx >> 6, j = idx & 63; float v = 0.f;
        if (arr < 5) v = 0.f;
        else if (arr < 7) v = a.in[11][(arr - 5) * RW + 64 * h + j];
        else if (arr < 9) v = a.in[9][(arr - 7) * RW + 64 * h + j];
        else v = a.in[14 + (arr - 9)][64 * h + j];
        cst[idx] = v; }
    {
        const bf16* WU = (const bf16*)(a.ws + WS_WUPT); const bf16* AU = (const bf16*)(a.ws + WS_AUPT);
        for (int idx = F.tid; idx < 4 * 64 * 8; idx += 512) { const int ch16 = idx & 7, row = (idx >> 3) & 63, tb = idx >> 9; const int d = tb >> 1;
            const bf16* src = ((tb & 1) ? AU : WU) + ((size_t)d * RW + 64 * h + row) * 64 + 8 * ch16;
            *(LAS v4u*)(F.lds + LORA_OFF + tb * LORA_TAB + row * LORA_ROW + ch16 * 16) = *(const v4u*)src; }
    }
    const bf16* RK = (const bf16*)(a.ws + WS_RKVS); const bf16* TD = (const bf16*)(a.ws + WS_TDS);
    bf16* Y = (bf16*)(a.ws + (dir ? WS_YB : WS_YF)) + ((size_t)b * 8 + h) * (SEQ / 4) * 64 * 4;
    f32x4 acc[4];
#pragma unroll
    for (int kt = 0; kt < 4; ++kt) acc[kt] = (f32x4){0.f, 0.f, 0.f, 0.f};
    const bool f_noscan = (F.flags >> 18) & 1u, f_noprep = (F.flags >> 19) & 1u, f_nostore = (F.flags >> 20) & 1u;
    v4u raw[NRAW]; v2u yq[4] = {{0u, 0u}, {0u, 0u}, {0u, 0u}, {0u, 0u}};
    prep_load(raw, RK, TD, b, h, dir, vs, lane);
    LDS_WAIT(); __builtin_amdgcn_s_barrier(); asm volatile("" ::: "memory");
    for (int R = 0; R < SEQ / 64; ++R) {
        if (!f_noprep) prep(raw, a, b, h, dir, 4 * R + vs, slots + w * SLOT, cst, lane, f_nostore);
        else { unsigned x = 0;
#pragma unroll
            for (int i = 0; i < NRAW; ++i) x ^= raw[i].x ^ raw[i].y ^ raw[i].z ^ raw[i].w;
            asm volatile("" :: "v"(x)); }
        LDS_WAIT(); __builtin_amdgcn_s_barrier(); asm volatile("" ::: "memory");
        if (R > 0 && !f_nostore) {
#pragma unroll
            for (int ci = 0; ci < 4; ++ci) { const int c = 4 * (R - 1) + ci; const int g = dir ? (SEQ / 4 - 1 - (4 * c + (lane >> 4))) : (4 * c + (lane >> 4));
                *(v2u*)(Y + ((size_t)g * 64 + 16 * vs + (lane & 15)) * 4) = yq[ci]; } }
        if (R + 1 < SEQ / 64) prep_load(raw, RK, TD, b, h, dir, 4 * (R + 1) + vs, lane);
        asm volatile("" ::: "memory");
        if (!f_noscan) {
#pragma unroll
            for (int ci = 0; ci < 4; ++ci) yq[ci] = scan_chunk(acc, slots + (dir * 4 + ci) * SLOT, vs, lane, dir != 0);
        }
        LDS_WAIT(); __builtin_amdgcn_s_barrier(); asm volatile("" ::: "memory");
    }
    if (!f_nostore) {
#pragma unroll
        for (int ci = 0; ci < 4; ++ci) { const int c = 4 * (SEQ / 64 - 1) + ci; const int g = dir ? (SEQ / 4 - 1 - (4 * c + (lane >> 4))) : (4 * c + (lane >> 4));
            *(v2u*)(Y + ((size_t)g * 64 + 16 * vs + (lane & 15)) * 4) = yq[ci]; } }
    if (f_nostore) { asm volatile("" :: "v"(acc[0]), "v"(acc[1]), "v"(acc[2]), "v"(acc[3])); }
}
#undef MFMA16
}

__device__ __forceinline__ void p4_finalize(Frame& F, const Args& a) {
    const bf16* __restrict__ RK = (const bf16*)(a.ws + WS_RKVS); const bf16* __restrict__ TD = (const bf16*)(a.ws + WS_TDS); const bf16* __restrict__ GT = (const bf16*)(a.ws + WS_GUPT);
    const bf16* __restrict__ YF = (const bf16*)(a.ws + WS_YF); const bf16* __restrict__ YB = (const bf16*)(a.ws + WS_YB);
    const float* __restrict__ BON = (const float*)(a.ws + WS_BON); bf16* __restrict__ MIX = (bf16*)(a.ws + WS_MIX);
    const float* __restrict__ ln_w = a.in[17]; const float* __restrict__ ln_b = a.in[18];
    const int gw = F.vcu * NWAVES + F.wave; const int kl = F.lane & 15, q = F.lane >> 4; const int b = F.vcu >> 3;
    LAS unsigned char* stg = F.lds + F.wave * (16 * 1040);
    for (int i = 0; i < 2; ++i) {
        const size_t row0 = (size_t)(gw * 2 + i) * 16; const int t0 = (int)(row0 & (SEQ - 1)); const int g = (t0 >> 2) + q;
        bf16x8 sg[4];
#pragma unroll
        for (int ks = 0; ks < 4; ++ks) sg[ks] = *(const bf16x8*)(TD + (row0 + kl) * 256 + 128 + 32 * ks + 8 * q);
        v2u n_yf[4], n_yb[4], n_vv[4]; f32x4 n_bf, n_bb; float n_lw[4], n_lb[4]; bf16x8 n_gt[4][4];
#define P4_LOAD(HH) do { _Pragma("unroll") for (int ct = 0; ct < 4; ++ct) { const int ch_ = 64 * (HH) + 16 * ct + kl; \
            const size_t yo_ = ((((size_t)b * 8 + (HH)) * (SEQ / 4) + g) * 64 + 16 * ct + kl) * 4; \
            n_yf[ct] = *(const v2u*)(YF + yo_); n_yb[ct] = *(const v2u*)(YB + yo_); \
            n_vv[ct] = *(const v2u*)(RK + (((size_t)b * (SEQ / 4) + g) * 1536 + 1024 + ch_) * 4); n_lw[ct] = ln_w[ch_]; n_lb[ct] = ln_b[ch_]; \
            _Pragma("unroll") for (int ks = 0; ks < 4; ++ks) n_gt[ct][ks] = *(const bf16x8*)(GT + (size_t)ch_ * 128 + 32 * ks + 8 * q); } \
            const size_t bo_ = ((size_t)b * 8 + (HH)) * SEQ + t0 + 4 * q; n_bf = *(const f32x4*)(BON + bo_); n_bb = *(const f32x4*)(BON + (size_t)MT * 8 + bo_); } while (0)
        P4_LOAD(0);
#pragma clang loop unroll(disable)
        for (int hh = 0; hh < 8; ++hh) {
            f32x4 acc[4], y[4], vs[4]; float lw[4], lb[4];
#pragma unroll
            for (int ct = 0; ct < 4; ++ct) {
                y[ct] = (f32x4){bflo(n_yf[ct].x) + bflo(n_yb[ct].x), bfhi(n_yf[ct].x) + bfhi(n_yb[ct].x), bflo(n_yf[ct].y) + bflo(n_yb[ct].y), bfhi(n_yf[ct].y) + bfhi(n_yb[ct].y)};
                vs[ct] = (f32x4){bflo(n_vv[ct].x), bfhi(n_vv[ct].x), bflo(n_vv[ct].y), bfhi(n_vv[ct].y)}; lw[ct] = n_lw[ct]; lb[ct] = n_lb[ct]; }
            const f32x4 bon = n_bf + n_bb;
#pragma unroll
            for (int ct = 0; ct < 4; ++ct) { acc[ct] = (f32x4){0.f, 0.f, 0.f, 0.f};
#pragma unroll
                for (int ks = 0; ks < 4; ++ks) acc[ct] = __builtin_amdgcn_mfma_f32_16x16x32_bf16(sg[ks], n_gt[ct][ks], acc[ct], 0, 0, 0); }
            if (hh + 1 < 8) P4_LOAD(hh + 1);
            f32x4 sm = (y[0] + y[1]) + (y[2] + y[3]);
#pragma unroll
            for (int e = 0; e < 4; ++e) sm[e] = wkv::red16(sm[e]);
            const f32x4 mean = sm * (1.0f / 64.0f); f32x4 vq = (f32x4){0.f, 0.f, 0.f, 0.f};
#pragma unroll
            for (int ct = 0; ct < 4; ++ct) { y[ct] = y[ct] - mean; vq += y[ct] * y[ct]; }
            f32x4 rstd;
#pragma unroll
            for (int e = 0; e < 4; ++e) rstd[e] = __builtin_amdgcn_rsqf(wkv::red16(vq[e]) * (1.0f / 64.0f) + GN_EPS);
#pragma unroll
            for (int ct = 0; ct < 4; ++ct) { const f32x4 o = ((y[ct] * rstd) * lw[ct] + lb[ct] + vs[ct] * bon) * acc[ct];
#pragma unroll
                for (int e = 0; e < 4; ++e) *(LAS unsigned short*)(stg + (4 * q + e) * 1040 + (64 * hh + 16 * ct + kl) * 2) = (unsigned short)f2bf(o[e]); }
        }
#undef P4_LOAD
        LDS_WAIT();
#pragma unroll
        for (int r = 0; r < 16; ++r) { const v4u w = *(const LAS v4u*)(stg + r * 1040 + F.lane * 16); *(v4u*)(MIX + (row0 + r) * DM + 512 + F.lane * 8) = w; }
        LDS_WAIT();
    }
}

__device__ __forceinline__ void p6_norm_router(Frame& F, const Args& a) {
    LAS float* wr = (LAS float*)F.lds;
    for (int i = F.tid; i < DM * NE; i += 512) { const int k = i >> 4, e = i & 15; wr[e * DM + k] = a.in[21][i]; }
    __syncthreads();
    const float* mod = (const float*)(a.ws + WS_MOD); unsigned char* H2 = a.ws + WS_H; float* AFF = (float*)(a.ws + WS_AFF);
    const int gw = F.vcu * NWAVES + F.wave; const int b = F.vcu >> 3; const int lane = F.lane;
    f32x4 gs[4], sh[4];
#pragma unroll
    for (int j = 0; j < 4; ++j) { const int c = 4 * lane + 256 * j; const f32x4 g = *(const f32x4*)(a.in[20] + c); const f32x4 sc = *(const f32x4*)(mod + b * 6 * DM + 4 * DM + c);
        gs[j] = g * (sc + 1.0f); sh[j] = *(const f32x4*)(mod + b * 6 * DM + 3 * DM + c); }
    const bf16* X1 = (const bf16*)(a.ws + WS_X1);
    v2u vn[4];
    { const GAS v2u* xr = (const GAS v2u*)(X1 + (size_t)gw * 32 * DM) + lane;
#pragma unroll
      for (int j = 0; j < 4; ++j) vn[j] = xr[64 * j]; }
    for (int i = 0; i < 32; ++i) {
        const size_t row = (size_t)gw * 32 + i;
        f32x4 v[4]; float s2 = 0.f;
#pragma unroll
        for (int j = 0; j < 4; ++j) { v[j] = (f32x4){bflo(vn[j].x), bfhi(vn[j].x), bflo(vn[j].y), bfhi(vn[j].y)}; s2 += (v[j].x * v[j].x + v[j].y * v[j].y) + (v[j].z * v[j].z + v[j].w * v[j].w); }
        if (i + 1 < 32) { const GAS v2u* xr = (const GAS v2u*)(X1 + (row + 1) * DM) + lane;
#pragma unroll
            for (int j = 0; j < 4; ++j) vn[j] = xr[64 * j]; }
        asm volatile("" ::: "memory");
        const float rstd = 1.0f / sqrtf(wave_sum(s2) * (1.0f / DM) + NORM_EPS);
        GAS unsigned* o4 = (GAS unsigned*)(H2 + row * DM) + lane;
#pragma unroll
        for (int j = 0; j < 4; ++j) { v[j] = v[j] * rstd * gs[j] + sh[j]; unsigned w = 0u;
            w = cvt2_fp8(v[j].x * 4.0f, v[j].y * 4.0f, w, false); w = cvt2_fp8(v[j].z * 4.0f, v[j].w * 4.0f, w, true); o4[64 * j] = w; }
        float d[16];
#pragma unroll
        for (int e = 0; e < 16; ++e) { float acc = 0.f;
#pragma unroll
            for (int j = 0; j < 4; ++j) { const f32x4 w = *(const LAS f32x4*)(wr + e * DM + 4 * lane + 256 * j); acc += (v[j].x * w.x + v[j].y * w.y) + (v[j].z * w.z + v[j].w * w.w); }
            d[e] = acc; asm volatile("" ::: "memory"); }
#pragma unroll
        for (int k = 0; k < 8; ++k) { auto r = __builtin_amdgcn_permlane32_swap(__float_as_uint(d[k]), __float_as_uint(d[k + 8]), false, false); d[k] = __uint_as_float(r[0]) + __uint_as_float(r[1]); }
#pragma unroll
        for (int k = 0; k < 4; ++k) { auto r = __builtin_amdgcn_permlane16_swap(__float_as_uint(d[k]), __float_as_uint(d[k + 4]), false, false); d[k] = __uint_as_float(r[0]) + __uint_as_float(r[1]); }
        { const bool up = (lane & 8) != 0;
#pragma unroll
          for (int k = 0; k < 2; ++k) { const float send = up ? d[k] : d[k + 2], keep = up ? d[k + 2] : d[k];
              d[k] = keep + __builtin_bit_cast(float, __builtin_amdgcn_update_dpp(0, __builtin_bit_cast(int, send), 0x128, 0xf, 0xf, false)); } }
        { const bool up = (lane & 4) != 0; const float send = up ? d[0] : d[1], keep = up ? d[1] : d[0]; d[0] = keep + __shfl_xor(send, 4); }
        float lg = d[0]; lg = DPP_ADD(lg, 0x4E); lg = DPP_ADD(lg, 0xB1);
        float mx = lg;
        mx = fmaxf(mx, __shfl_xor(mx, 4)); mx = fmaxf(mx, __builtin_bit_cast(float, __builtin_amdgcn_update_dpp(0, __builtin_bit_cast(int, mx), 0x128, 0xf, 0xf, false)));
        { auto r = __builtin_amdgcn_permlane16_swap(__float_as_uint(mx), __float_as_uint(mx), false, false); mx = fmaxf(__uint_as_float(r[0]), __uint_as_float(r[1])); }
        { auto r = __builtin_amdgcn_permlane32_swap(__float_as_uint(mx), __float_as_uint(mx), false, false); mx = fmaxf(__uint_as_float(r[0]), __uint_as_float(r[1])); }
        const float pe = expf(lg - mx); float sm = pe;
        sm += __shfl_xor(sm, 4); sm = DPP_ADD(sm, 0x128); sm = xor32_sum(xor16_sum(sm));
        if ((lane & 3) == 0) AFF[((size_t)b * NE + (lane >> 2)) * SEQ + (row & (SEQ - 1))] = pe / sm;
    }
    __syncthreads();
}

__device__ __forceinline__ void p7_topk_gather(Frame& F, const Args& a) {
    LAS unsigned* red = (LAS unsigned*)F.lds;
    const float* AFF = (const float*)(a.ws + WS_AFF); int* IDX = (int*)(a.ws + WS_IDX); float* VAL = (float*)(a.ws + WS_VAL); int* INV = (int*)(a.ws + WS_INV);
    const int tid = F.tid, lane = F.lane, wave = F.wave;
    f32x4 v[2]; unsigned u[2][4], T[2] = {0u, 0u};
#pragma unroll
    for (int pr = 0; pr < 2; ++pr) { v[pr] = *(const f32x4*)(AFF + (size_t)(F.vcu * 2 + pr) * SEQ + 4 * tid);
#pragma unroll
        for (int j = 0; j < 4; ++j) u[pr][j] = __float_as_uint(v[pr][j]); }
    constexpr int XITEMS = 3 * NE * (DM / 64) * (FF / 32);
    const int xgw = F.vcu * NWAVES + wave, XNGW = F.G * NWAVES;
    LAS float* xscr = (LAS float*)(F.lds + 4096 + wave * 8448);
    int xit = xgw; float xt[32]; ExpItem xcur;
    if (xit < XITEMS) { xcur = exp_item(a, xit); exp_item_load(xcur, xt, lane); }
    int par = 0;
    for (int bit = 30; bit >= 0; --bit) {
        unsigned cand[2];
#pragma unroll
        for (int pr = 0; pr < 2; ++pr) { cand[pr] = T[pr] | (1u << bit);
            const int c = __builtin_popcountll(__ballot(u[pr][0] >= cand[pr])) + __builtin_popcountll(__ballot(u[pr][1] >= cand[pr])) + __builtin_popcountll(__ballot(u[pr][2] >= cand[pr])) + __builtin_popcountll(__ballot(u[pr][3] >= cand[pr]));
            if (lane == 0) red[(par * 2 + pr) * 8 + wave] = (unsigned)c; }
        LDS_WAIT(); __builtin_amdgcn_s_barrier(); asm volatile("" ::: "memory");
#pragma unroll
        for (int pr = 0; pr < 2; ++pr) { unsigned tot = 0;
#pragma unroll
            for (int w = 0; w < 8; ++w) tot += red[(par * 2 + pr) * 8 + w];
            if (tot >= (unsigned)CAP) T[pr] = cand[pr]; }
        par ^= 1;
        if (xit < XITEMS) { exp_item_store(xcur, xt, xscr, lane); xit += XNGW; if (xit < XITEMS) { xcur = exp_item(a, xit); exp_item_load(xcur, xt, lane); } }
    }
    while (xit < XITEMS) { exp_item_store(xcur, xt, xscr, lane); xit += XNGW; if (xit < XITEMS) { xcur = exp_item(a, xit); exp_item_load(xcur, xt, lane); } }
    int pk[2], inc[2];
#pragma unroll
    for (int pr = 0; pr < 2; ++pr) {
        const int cg = (u[pr][0] > T[pr]) + (u[pr][1] > T[pr]) + (u[pr][2] > T[pr]) + (u[pr][3] > T[pr]), ce = (u[pr][0] == T[pr]) + (u[pr][1] == T[pr]) + (u[pr][2] == T[pr]) + (u[pr][3] == T[pr]);
        pk[pr] = cg | (ce << 16); inc[pr] = pk[pr];
#pragma unroll
        for (int o = 1; o < 64; o <<= 1) { const int n = __shfl_up(inc[pr], o); if (lane >= o) inc[pr] += n; }
        if (lane == 63) red[64 + 16 * pr + wave] = (unsigned)inc[pr]; }
    __syncthreads();
#pragma unroll
    for (int pr = 0; pr < 2; ++pr) {
        const int p = F.vcu * 2 + pr; const int b = p >> 4, e = p & 15;
        int base = 0, total = 0;
#pragma unroll
        for (int w = 0; w < 8; ++w) { const int tw = (int)red[64 + 16 * pr + w]; if (w < wave) base += tw; total += tw; }
        const int excl = base + inc[pr] - pk[pr];
        int gtb = excl & 0xffff, eqb = excl >> 16; const int need_eq = CAP - (total & 0xffff);
#pragma unroll
        for (int j = 0; j < 4; ++j) {
            const bool g = u[pr][j] > T[pr], q = u[pr][j] == T[pr]; const bool sel = g || (q && eqb < need_eq);
            const int slot = gtb + (eqb < need_eq ? eqb : need_eq); const int t = 4 * tid + j;
            if (sel) { IDX[p * CAP + slot] = t; VAL[p * CAP + slot] = v[pr][j]; }
            INV[((size_t)b * SEQ + t) * NE + e] = sel ? slot : -1;
            gtb += g ? 1 : 0; eqb += q ? 1 : 0;
        }
    }
    __syncthreads();
}

struct GuOrder { int vcu; const LAS unsigned short* lidx;
    static constexpr bool GATHER = true;
    __device__ __forceinline__ unsigned a_base(const pg8::Unit& u) const { return (unsigned)(u.pm >> 4) * (unsigned)(SEQ * DM); }
    __device__ __forceinline__ void rows(const pg8::Unit& u, unsigned (&g)[2][2]) const {
        int tid = threadIdx.x; asm volatile("" : "+v"(tid));
#pragma unroll
        for (int i = 0; i < 2; ++i) { int R, C; pg8::stage_rc(tid * 16 + i * 8192, R, C);
#pragma unroll
            for (int h = 0; h < 2; ++h) g[h][i] = (unsigned)lidx[(u.pm & 15) * CAP + 128 * h + R] * (unsigned)DM + (unsigned)C * 2u; } }
    __device__ __forceinline__ bool next(int i, pg8::Unit& u) const { if (i >= NE) return false; const int b = vcu >> 3, pn = vcu & 7; u.pm = b * NE + i; u.pn = pn; u.bt = i * 8 + pn; return true; } };
struct DownOrder { int vcu; static constexpr bool GATHER = false;
    __device__ __forceinline__ bool next(int i, pg8::Unit& u) const { if (i >= NE / 2) return false; const int b = vcu >> 3, j = vcu & 7, e = 2 * i + (j >> 2); u.pm = b * NE + e; u.pn = j & 3; u.bt = e * 4 + (j & 3); return true; } };
struct EpiSwiGLU {
    static constexpr bool PERM = true;
    unsigned char* HID;
    __device__ __forceinline__ void operator()(const f32x4 (&acc)[2][2][4][2], const pg8::Unit& u, int wr, int wc, int fr, int fq) const {
        { int l_ = threadIdx.x; asm volatile("" : "+v"(l_)); fr = l_ & 15; fq = (l_ >> 4) & 3; }
        const int row0 = u.pm * 256 + wr * 64 + fr, col0 = u.pn * 128 + wc * 32 + 8 * fq;
        const __amdgpu_buffer_rsrc_t hrs = __builtin_amdgcn_make_buffer_rsrc((void*)HID, 0, 0x7fffffff, 0x00020000);
#pragma unroll
        for (int ai = 0; ai < 2; ++ai)
#pragma unroll
            for (int m = 0; m < 4; ++m) {
                unsigned w[2];
#pragma unroll
                for (int n = 0; n < 2; ++n) { const f32x4 g = acc[ai][0][m][n], up = acc[ai][1][m][n]; f32x4 h;
#pragma unroll
                    for (int e = 0; e < 4; ++e) { const float gg = g[e] * (1.0f / 128.0f); h[e] = gg * __builtin_amdgcn_rcpf(1.0f + __expf(-gg)) * up[e] * (8.0f / 128.0f); }
                    unsigned x = 0u; x = cvt2_fp8(h[0], h[1], x, false); x = cvt2_fp8(h[2], h[3], x, true); w[n] = x; }
                v2u wv; wv.x = w[0]; wv.y = w[1];
                __builtin_amdgcn_raw_buffer_store_b64(wv, hrs, (unsigned)(row0 + ai * 128 + m * 16) * (unsigned)FF + (unsigned)col0, 0, 0);
            }
    }
};
struct EpiDown {
    static constexpr bool PERM = true;
    unsigned char* Y; const float* VAL; const float* mod;
    __device__ __forceinline__ void operator()(const f32x4 (&acc)[2][2][4][2], const pg8::Unit& u, int wr, int wc, int fr, int fq) const {
        { int l_ = threadIdx.x; asm volatile("" : "+v"(l_)); fr = l_ & 15; fq = (l_ >> 4) & 3; }
        const int row0 = u.pm * 256 + wr * 64 + fr, col0 = u.pn * 256 + wc * 64 + 16 * fq; const int b = u.pm >> 4;
        f32x4 gt[2][2];
#pragma unroll
        for (int bj = 0; bj < 2; ++bj)
#pragma unroll
            for (int n = 0; n < 2; ++n) gt[bj][n] = *(const f32x4*)(mod + b * 6 * DM + 5 * DM + col0 + 8 * bj + 4 * n);
        const __amdgpu_buffer_rsrc_t yrs = __builtin_amdgcn_make_buffer_rsrc((void*)Y, 0, 0x7fffffff, 0x00020000);
        float vls[2][4];
#pragma unroll
        for (int ai = 0; ai < 2; ++ai)
#pragma unroll
            for (int m = 0; m < 4; ++m) vls[ai][m] = VAL[row0 + ai * 128 + m * 16] * (64.0f / 256.0f);
#pragma unroll
        for (int ai = 0; ai < 2; ++ai)
#pragma unroll
            for (int m = 0; m < 4; ++m) { const int row = row0 + ai * 128 + m * 16; const float vl = vls[ai][m];
                unsigned w[4];
#pragma unroll
                for (int bj = 0; bj < 2; ++bj)
#pragma unroll
                    for (int n = 0; n < 2; ++n) { const f32x4 v = acc[ai][bj][m][n] * gt[bj][n] * vl; unsigned x = 0u;
                        x = cvt2_fp8(v[0], v[1], x, false); x = cvt2_fp8(v[2], v[3], x, true); w[2 * bj + n] = x; }
                v4u wv; wv.x = w[0]; wv.y = w[1]; wv.z = w[2]; wv.w = w[3];
                __builtin_amdgcn_raw_buffer_store_b128(wv, yrs, (unsigned)row * (unsigned)DM + (unsigned)col0, 0, 0); }
    }
};

__device__ __forceinline__ void p10_combine(Frame& F, const Args& a) {
    const int* INV = (const int*)(a.ws + WS_INV); const unsigned char* Y = a.ws + WS_Y;
    const int gw = F.vcu * NWAVES + F.wave; const int b = F.vcu >> 3; const int lane = F.lane;
    const bool nostore = (F.flags >> 20) & 1u;
    int inv_n[2];
#pragma unroll
    for (int r = 0; r < 2; ++r) inv_n[r] = INV[((size_t)gw * 32 + r) * NE + (lane & 15)];
    const bf16* X1 = (const bf16*)(a.ws + WS_X1);
    v2u vnx[2][4];
#pragma unroll
    for (int r = 0; r < 2; ++r) { const GAS v2u* xr = (const GAS v2u*)(X1 + ((size_t)gw * 32 + r) * DM) + lane;
#pragma unroll
        for (int j = 0; j < 4; ++j) vnx[r][j] = xr[64 * j]; }
    for (int i = 0; i < 32; i += 2) {
        const size_t row = (size_t)gw * 32 + i;
        int inv[2]; inv[0] = inv_n[0]; inv[1] = inv_n[1];
        if (i + 2 < 32) {
#pragma unroll
            for (int r = 0; r < 2; ++r) inv_n[r] = INV[(row + 2 + r) * NE + (lane & 15)]; }
        f32x4 v[2][4];
#pragma unroll
        for (int r = 0; r < 2; ++r)
#pragma unroll
            for (int j = 0; j < 4; ++j) v[r][j] = (f32x4){bflo(vnx[r][j].x), bfhi(vnx[r][j].x), bflo(vnx[r][j].y), bfhi(vnx[r][j].y)};
        if (i + 2 < 32) {
#pragma unroll
            for (int r = 0; r < 2; ++r) { const GAS v2u* xr = (const GAS v2u*)(X1 + (row + 2 + r) * DM) + lane;
#pragma unroll
                for (int j = 0; j < 4; ++j) vnx[r][j] = xr[64 * j]; } }
        unsigned m0 = (unsigned)(__ballot(inv[0] >= 0) & 0xffffull), m1 = (unsigned)(__ballot(inv[1] >= 0) & 0xffffull);
        while (m0 | m1) {
            unsigned w[2][3][4]; bool hit[2][3];
#pragma unroll
            for (int r = 0; r < 2; ++r)
#pragma unroll
                for (int k = 0; k < 3; ++k) { unsigned& mm = r ? m1 : m0; hit[r][k] = mm != 0u;
                    if (hit[r][k]) { const int e = __builtin_ctz(mm); mm &= mm - 1u; const int sl = __builtin_amdgcn_readlane(inv[r], e);
                        const unsigned char* yr = Y + ((size_t)(b * NE + e) * CAP + sl) * DM + 4 * lane;
#pragma unroll
                        for (int j = 0; j < 4; ++j) w[r][k][j] = *(const unsigned*)(yr + 256 * j); } }
#pragma unroll
            for (int r = 0; r < 2; ++r)
#pragma unroll
                for (int k = 0; k < 3; ++k) if (hit[r][k]) {
#pragma unroll
                    for (int j = 0; j < 4; ++j) { const f32x2 lo = __builtin_amdgcn_cvt_pk_f32_fp8(w[r][k][j], false), hi = __builtin_amdgcn_cvt_pk_f32_fp8(w[r][k][j], true);
                        v[r][j].x += lo.x * (1.0f / 64.0f); v[r][j].y += lo.y * (1.0f / 64.0f); v[r][j].z += hi.x * (1.0f / 64.0f); v[r][j].w += hi.y * (1.0f / 64.0f); } }
        }
        if (!nostore) {
#pragma unroll
            for (int r = 0; r < 2; ++r) { GAS f32x4* xr = (GAS f32x4*)(a.out + (row + r) * DM) + lane;
#pragma unroll
                for (int j = 0; j < 4; ++j) xr[64 * j] = v[r][j]; }
        } else asm volatile("" :: "v"(v[0][0]), "v"(v[0][1]), "v"(v[0][2]), "v"(v[0][3]), "v"(v[1][0]), "v"(v[1][1]), "v"(v[1][2]), "v"(v[1][3]));
    }
}

__global__ void __launch_bounds__(NWAVES * 64, 2) fwd_kernel(Args args) {
    extern __shared__ __attribute__((aligned(16))) unsigned char lds[];
    cg::grid_group grid = cg::this_grid();
    Frame F;
    F.lds = (LAS unsigned char*)lds;
    F.tid = threadIdx.x; F.lane = F.tid & 63; F.wave = __builtin_amdgcn_readfirstlane(F.tid >> 6);
    F.G = gridDim.x; { const int bx = blockIdx.x; F.vcu = (F.G % 8 == 0) ? (bx % 8) * (F.G / 8) + bx / 8 : bx; }
    unsigned char* ws = args.ws;
    const unsigned mask = args.mask; F.flags = mask;
    volatile LAS unsigned* MISC = (volatile LAS unsigned*)(F.lds + MISC_OFF);
    if (F.tid < 32) MISC[F.tid] = 0u;
    __syncthreads();
    XcdBarrier bar; bar.bar = (unsigned*)(ws + WS_CTL) + CW_BAR; bar.x = 0; bar.st = nullptr;
    const bool one_launch = __builtin_popcount(mask & 0x7ffu) > 1;
    if (one_launch) bar = xcd_barrier_post((unsigned*)(ws + WS_CTL) + CW_BAR, MISC + 8);
    if (one_launch) grid.sync();
#define REFRESH() do { F.tid = threadIdx.x; asm volatile("" : "+v"(F.tid)); F.lane = F.tid & 63; } while (0)
#define IN(k) ((mask >> (k)) & 1u)
#define SEAM(k) do { if (IN(k) && ((mask & 0x7ffu) >> ((k) + 1)) != 0u) xcd_barrier(bar); REFRESH(); } while (0)

    if (IN(0)) { p0_prologue(F, args); } SEAM(0);
    if (IN(1)) { p1_norm(F, args); } SEAM(1);
    if (IN(2)) {
        pg8::Gemm g{(const bf16*)(ws + WS_H), (const bf16*)(ws + WS_WIN), MT, NIN, DM}; pg8::StaticOrder S; S.init(MT, NIN, F.G, (int)blockIdx.x);
        EpiInProj E{(bf16*)(ws + WS_Q), (bf16*)(ws + WS_K), (bf16*)(ws + WS_V), (bf16*)(ws + WS_PR), args.in[6], args.in[7], (const float*)(ws + WS_ROPE)};
        pg8::gemm_phase<EpiInProj, pg8::StaticOrder, true, true>(F.lds, g, S, E, (mask >> 22) & 1u);
    } SEAM(2);
    if (IN(3)) {
        const int b = F.vcu >> 3, h = F.vcu & 7;
        if (!((mask >> 16) & 1u)) {
            prs_pass(F, args);
            REFRESH();
            float bref;
            { float gq = fabsf(args.in[6][F.lane]), gk = fabsf(args.in[7][F.lane]);
#pragma unroll
              for (int o_ = 1; o_ < 64; o_ <<= 1) { gq = fmaxf(gq, __shfl_xor(gq, o_)); gk = fmaxf(gk, __shfl_xor(gk, o_)); }
              bref = 64.0f * QSCALE * gq * gk * 1.02f + 0.25f; }
            for (int qb = 0; qb < 8; ++qb)
                attn_body::attn_unit<8>(b, h, qb, (const bf16*)(ws + WS_Q), (const bf16*)(ws + WS_K), (const bf16*)(ws + WS_V), (bf16*)(ws + WS_MIX), (char*)lds, qb > 0, true, bref);
            __syncthreads();
        }
        if (one_launch) xcd_barrier(bar);
        REFRESH();
        if (!((mask >> 17) & 1u)) {
            wkv::phase(F, args);
        }
    } SEAM(3);
    if (IN(4)) { p4_finalize(F, args); } SEAM(4);
    if (IN(5)) {
        pg8::Gemm g{(const bf16*)(ws + WS_MIX), (const bf16*)(ws + WS_WOUT), MT, DM, DM}; pg8::StaticOrder S; S.init(MT, DM, F.G, (int)blockIdx.x);
        EpiOutProj E{args.in[0], (bf16*)(ws + WS_X1), (const float*)(ws + WS_MOD)};
        pg8::gemm_phase<EpiOutProj, pg8::StaticOrder, true, true>(F.lds, g, S, E, (mask >> 22) & 1u);
    } SEAM(5);
    if (IN(6)) { p6_norm_router(F, args); } SEAM(6);
    if (IN(7)) { p7_topk_gather(F, args); } SEAM(7);
    if (IN(8)) {
        LAS unsigned short* lidx = (LAS unsigned short*)(F.lds + LIDX_OFF);
        { const int* IDX = (const int*)(ws + WS_IDX) + (size_t)(F.vcu >> 3) * NE * CAP; for (int i = F.tid; i < NE * CAP; i += 512) lidx[i] = (unsigned short)IDX[i]; }
        __syncthreads();
        pg8::Gemm g{(const bf16*)(ws + WS_H), (const bf16*)(ws + WS_WGU), NGROUP * CAP, 2 * FF, DM / 2}; GuOrder S{F.vcu, lidx};
        EpiSwiGLU E{ws + WS_HID};
        pg8::gemm_phase<EpiSwiGLU, GuOrder, true, true, true>(F.lds, g, S, E, (mask >> 22) & 1u);
    } SEAM(8);
    if (IN(9)) {
        pg8::Gemm g{(const bf16*)(ws + WS_HID), (const bf16*)(ws + WS_WD), NGROUP * CAP, DM, FF / 2}; DownOrder S{F.vcu};
        EpiDown E{ws + WS_Y, (const float*)(ws + WS_VAL), (const float*)(ws + WS_MOD)};
        pg8::gemm_phase<EpiDown, DownOrder, true, true, true>(F.lds, g, S, E, (mask >> 22) & 1u);
    } SEAM(9);
    if (IN(10)) { p10_combine(F, args); }
#undef IN
#undef SEAM
}

extern "C" void kernel_launch(void* const* d_in, const int* in_sizes, int n_in, void* d_out, int out_size, void* d_ws, size_t ws_size, hipStream_t stream) {
    static int grid = 0;
    if (grid == 0) {
        if (n_in != 25 || out_size != MT * DM || ws_size < WS_END) { fprintf(stderr, "kernel_launch: unexpected shapes n_in %d out %d ws %zu\n", n_in, out_size, ws_size); grid = -1; return; }
        int dev = 0, cus = 0, per_cu = 0;
        (void)hipGetDevice(&dev); (void)hipDeviceGetAttribute(&cus, hipDeviceAttributeMultiprocessorCount, dev);
        (void)hipFuncSetAttribute((const void*)fwd_kernel, hipFuncAttributeMaxDynamicSharedMemorySize, LDS_BYTES);
        (void)hipOccupancyMaxActiveBlocksPerMultiprocessor(&per_cu, (const void*)fwd_kernel, NWAVES * 64, LDS_BYTES);
        (void)hipGetLastError();
        if (per_cu < 1) { fprintf(stderr, "kernel_launch: occupancy query says %d blocks per CU\n", per_cu); grid = -1; return; }
        if (cus != NB * 8) { fprintf(stderr, "kernel_launch: built for a %d-CU device (one workgroup per (batch, head)); found %d CUs; nothing launched\n", NB * 8, cus); grid = -1; return; }
        grid = cus;
    }
    if (grid < 0) return;
    (void)hipMemsetAsync((char*)d_ws + WS_CTL, 0, CTL_ZERO_BYTES, stream);
#if !((DBG_MASK >> 5) & 1)
    (void)hipMemcpyAsync(d_out, d_in[0], (size_t)MT * DM * 4, hipMemcpyDeviceToDevice, stream);
#endif
    Args a{};
    for (int i = 0; i < 25; ++i) a.in[i] = (const float*)d_in[i];
    a.out = (float*)d_out; a.ws = (unsigned char*)d_ws;
    constexpr int NPH = 11;
#if MK_N_LAUNCHES == 1
    a.mask = DBG_MASK;
    void* kargs[] = {&a};
    hipError_t e = hipLaunchCooperativeKernel((const void*)fwd_kernel, dim3(grid), dim3(NWAVES * 64), kargs, LDS_BYTES, stream);
    if (e != hipSuccess) fprintf(stderr, "cooperative launch failed: %s (grid %d)\n", hipGetErrorString(e), grid);
#else
    for (int p = 0; p < NPH; ++p) {
        if (!((DBG_MASK >> p) & 1)) continue;
        a.mask = 1u << p;
        if (p == 3) { a.mask |= 1u << 17; hipLaunchKernelGGL(fwd_kernel, dim3(grid), dim3(NWAVES * 64), LDS_BYTES, stream, a); a.mask = (1u << 3) | (1u << 16); }
        hipLaunchKernelGGL(fwd_kernel, dim3(grid), dim3(NWAVES * 64), LDS_BYTES, stream, a);
        const int rp = DBG_REPEAT;
        if (rp == p || ((rp == 31 || rp == 32 || rp == 33) && p == 3)) {
            if (rp == 31) a.mask = (1u << 3) | (1u << 17); if (rp == 32) a.mask = (1u << 3) | (1u << 16); if (rp == 33) a.mask = (1u << 3) | (1u << 16) | (1u << 17); a.mask |= DBG_XFLAGS;
            hipLaunchKernelGGL(fwd_kernel, dim3(grid), dim3(NWAVES * 64), LDS_BYTES, stream, a);
        }
    }
#endif
}
```

```cpp
#include <hip/hip_runtime.h>
#include <hip/hip_cooperative_groups.h>
#include <hip/hip_bf16.h>
#include <cstdio>
#include <cstdint>
#include <cmath>
namespace cg = cooperative_groups;

#ifndef MK_N_LAUNCHES
#define MK_N_LAUNCHES 1
#endif
#ifndef DBG_REPEAT
#define DBG_REPEAT -1
#endif
#ifndef GEMM_GLDS
#define GEMM_GLDS 0
#endif
#ifndef WKV_PREFETCH
#define WKV_PREFETCH 1
#endif
#ifndef DBG_WKV_FLAGS
#define DBG_WKV_FLAGS 0
#endif
#ifndef DBG_XFLAGS
#define DBG_XFLAGS 0
#endif
#ifndef USE_VALU_SCAN
#define USE_VALU_SCAN 0
#endif
#ifndef DBG_MASK
#define DBG_MASK 0x7ff
#endif

constexpr int DM = 1024, NB = 32, SEQ = 2048, MT = NB * SEQ;
constexpr int NIN = 2560, AW = 512, KVW = 128, RW = 512, NSH = 1792;
constexpr int NE = 16, CAP = 256, FF = 1024;
constexpr int NGROUP = NB * NE;
constexpr float NORM_EPS = 1e-6f, GN_EPS = 64e-5f, DECAY_SCALE = 0.606531f;
constexpr float QSCALE = 0.125f * 1.4426950408889634f;

constexpr size_t MiB = 1u << 20;
constexpr size_t WS_CTL = 0, CTL_ZERO_BYTES = 64 * 1024;
constexpr int CW_BAR = 4096;
constexpr size_t WS_MOD = 1 * MiB;
constexpr size_t WS_ROPE = 2 * MiB;
constexpr size_t WS_AFF = 3 * MiB;
constexpr size_t WS_IDX = 7 * MiB;
constexpr size_t WS_VAL = 7 * MiB + 512 * 1024;
constexpr size_t WS_INV = 8 * MiB;
constexpr size_t WS_BON = 12 * MiB;
constexpr size_t WS_GUPT = 16 * MiB;
constexpr size_t WS_WUPT = 16 * MiB + 128 * 1024;
constexpr size_t WS_AUPT = 16 * MiB + 256 * 1024;
constexpr size_t WS_AUPT2 = 16 * MiB + 384 * 1024;
constexpr size_t WS_WIN = 17 * MiB;
constexpr size_t WS_WOUT = 22 * MiB;
constexpr size_t WS_WGU = 24 * MiB;
constexpr size_t WS_WD = 88 * MiB;
constexpr size_t WS_H = 120 * MiB;
constexpr size_t WS_Q = 248 * MiB;
constexpr size_t WS_K = 312 * MiB;
constexpr size_t WS_V = 328 * MiB;
constexpr size_t WS_PR = 344 * MiB;
constexpr size_t WS_XG = 248 * MiB;
constexpr size_t WS_Y = 248 * MiB;
constexpr size_t WS_MIX = 568 * MiB;
constexpr size_t WS_YF = 696 * MiB;
constexpr size_t WS_YB = 760 * MiB;
constexpr size_t WS_RKVS = 824 * MiB;
constexpr size_t WS_TDS = 120 * MiB;
constexpr size_t WS_HID = 568 * MiB;
constexpr size_t WS_X1 = 696 * MiB;
constexpr size_t WS_END = 1016 * MiB;

constexpr int RING_BYTES = 131072;
constexpr int LIDX_OFF = RING_BYTES + 512;
constexpr int LDS_BYTES = 147456;
constexpr int MISC_OFF = LDS_BYTES - 256;
constexpr int NWAVES = 8;

#define GAS __attribute__((address_space(1)))
#define LAS __attribute__((address_space(3)))
typedef unsigned short bf16;
typedef unsigned v4u __attribute__((ext_vector_type(4)));
typedef unsigned v2u __attribute__((ext_vector_type(2)));
typedef float f32x4 __attribute__((ext_vector_type(4)));
typedef float f32x2 __attribute__((ext_vector_type(2)));
typedef short bf16x8 __attribute__((ext_vector_type(8)));
#define LDS_WAIT() asm volatile("s_waitcnt lgkmcnt(0)" ::: "memory")
#define VM_WAIT() asm volatile("s_waitcnt vmcnt(0)" ::: "memory")
__device__ __forceinline__ unsigned cvt2_fp8(float a, float b, unsigned old, bool hi) { a = __builtin_amdgcn_fmed3f(a, -448.0f, 448.0f); b = __builtin_amdgcn_fmed3f(b, -448.0f, 448.0f); return hi ? __builtin_amdgcn_cvt_pk_fp8_f32(a, b, old, true) : __builtin_amdgcn_cvt_pk_fp8_f32(a, b, old, false); }
typedef __bf16 bf16x2_hw __attribute__((ext_vector_type(2)));
__device__ __forceinline__ unsigned pk2(float lo, float hi) { const f32x2 v = {lo, hi}; return __builtin_bit_cast(unsigned, __builtin_convertvector(v, bf16x2_hw)); }
__device__ __forceinline__ unsigned f2bf(float f) { return pk2(f, 0.f) & 0xffffu; }
__device__ __forceinline__ float bf2f(unsigned short h) { return __builtin_bit_cast(float, (unsigned)h << 16); }
__device__ __forceinline__ float bflo(unsigned w) { return __builtin_bit_cast(float, w << 16); }
__device__ __forceinline__ float bfhi(unsigned w) { return __builtin_bit_cast(float, w & 0xffff0000u); }
#define DPP_ADD(v, CTRL) ((v) + __builtin_bit_cast(float, __builtin_amdgcn_update_dpp(0, __builtin_bit_cast(int, (v)), (CTRL), 0xf, 0xf, false)))
__device__ __forceinline__ float xor16_sum(float v) { auto r = __builtin_amdgcn_permlane16_swap(__float_as_uint(v), __float_as_uint(v), false, false); return __uint_as_float(r[0]) + __uint_as_float(r[1]); }
__device__ __forceinline__ float xor32_sum(float v) { auto r = __builtin_amdgcn_permlane32_swap(__float_as_uint(v), __float_as_uint(v), false, false); return __uint_as_float(r[0]) + __uint_as_float(r[1]); }
__device__ __forceinline__ float wave_sum(float v) {
    v = DPP_ADD(v, 0xB1); v = DPP_ADD(v, 0x4E); v = DPP_ADD(v, 0x141); v = DPP_ADD(v, 0x140);
    return xor32_sum(xor16_sum(v));
}
__device__ __forceinline__ float sigmoidf_(float x) { return 1.0f / (1.0f + __expf(-x)); }

namespace pg8 {
#define PG8_LAS __attribute__((address_space(3)))
typedef unsigned short bf16_t;
typedef short bf16x8 __attribute__((ext_vector_type(8)));
typedef float f32x4 __attribute__((ext_vector_type(4)));
typedef unsigned u32x4 __attribute__((ext_vector_type(4)));
constexpr int BM = 256, BK = 64, HALF = 128, HTB = HALF * BK * 2, STAGE_BYTES = 8 * HTB, NXCD = 8, WGM = 8;

__host__ __device__ __forceinline__ int lds_byte(int r, int c) { const int st = (r >> 4) * 2 + (c >> 5), rr = r & 15, cc = c & 31, ob = rr * 64 + cc * 2; return st * 1024 + (ob ^ (((ob >> 9) & 1) << 5)); }
__host__ __device__ __forceinline__ void stage_rc(int b, int& R, int& C) { const int st = b / 1024, sb = b % 1024, swz = sb ^ (((sb >> 9) & 1) << 5); R = (st >> 1) * 16 + swz / 64; C = (st & 1) * 32 + (swz % 64) / 2; }
__host__ __device__ __forceinline__ int perm32(int rho) { const int n = rho >> 4, i = rho & 15; return 8 * (i >> 2) + 4 * n + (i & 3); }

struct Unit { int pm, pn, bt; };
struct Gemm { const bf16_t* A; const bf16_t* Bt; int M, N, K; };

struct StaticOrder {
    static constexpr bool GATHER = false;
    int nM, nN, nwg, G, c;
    __host__ __device__ void init(int M, int N, int G_, int c_) { nM = M / BM; nN = N / BM; nwg = nM * nN; G = G_; c = c_; }
    __host__ __device__ bool next(int i, Unit& u) const {
        const long L = (long)i * G + c; if (L >= nwg) return false;
        int wgid = (int)L; { const int q = nwg / NXCD, r = nwg % NXCD, xcd = wgid % NXCD, off = wgid / NXCD; wgid = (xcd < r ? xcd * (q + 1) : r * (q + 1) + (xcd - r) * q) + off; }
        const int nig = WGM * nN, gid = wgid / nig, fm = gid * WGM, gsz = (nM - fm) < WGM ? (nM - fm) : WGM;
        u.pm = fm + ((wgid % nig) % gsz); u.pn = (wgid % nig) / gsz; u.bt = u.pn; return true;
    }
};

__device__ __forceinline__ unsigned cvt_pk_bf16(float lo, float hi) { unsigned r; asm volatile("v_cvt_pk_bf16_f32 %0, %1, %2" : "=v"(r) : "v"(lo), "v"(hi)); return r; }

typedef int v8i_t __attribute__((ext_vector_type(8)));
typedef int v4i_t __attribute__((ext_vector_type(4)));
template <class Sched> __device__ __forceinline__ unsigned a_base_of(const Sched& S, const Unit& u, unsigned tstep) { if constexpr (Sched::GATHER) return S.a_base(u); else return (unsigned)u.pm * tstep; }
template <class Epi, class Sched, bool ALIGN_EPI = false, bool SP2 = false, bool FP8 = false>
__device__ __forceinline__ void gemm_phase(PG8_LAS unsigned char* lds, const Gemm g, const Sched& S, const Epi& E, const bool skip_epi = false) {
    const int tid = threadIdx.x, wid = __builtin_amdgcn_readfirstlane(tid >> 6), lane = tid & 63, wr = wid >> 2, wc = wid & 3, fr = lane & 15, fq = lane >> 4;
    int K = g.K; asm volatile("" : "+s"(K));
    const int nt = K / BK;
    unsigned voffA[2], voffB[2];
#pragma unroll
    for (int i = 0; i < 2; ++i) { int R, C; stage_rc(tid * 16 + i * 8192, R, C); const int Rb = Epi::PERM ? ((R & ~31) + perm32(R & 31)) : R;
        voffA[i] = (unsigned)(R * K + C) * 2u; voffB[i] = (unsigned)(Rb * K + C) * 2u; }
    const unsigned kstep = (unsigned)(BK * 2);
    const unsigned hstep = (unsigned)HALF * (unsigned)K * 2u;
    const unsigned tstep = 2u * hstep;
    const unsigned ldsw = (unsigned)wid * 1024u;
    const int aoff = lds_byte(wr * 64 + fr, fq * 8), boff = lds_byte(wc * 32 + fr, fq * 8);
    const __amdgpu_buffer_rsrc_t rsA = __builtin_amdgcn_make_buffer_rsrc((void*)g.A, 0, 0x7fffffff, 0x00020000), rsB = __builtin_amdgcn_make_buffer_rsrc((void*)g.Bt, 0, 0x7fffffff, 0x00020000);
#define PG8_SA(b, h) (((b) * 2 + (h)) * HTB)
#define PG8_SB(b, h) ((4 + (b) * 2 + (h)) * HTB)
#if GEMM_GLDS
#define PG8_STAGE(bufoff, rs, soff, voff) do { _Pragma("unroll") for (int _i = 0; _i < 2; ++_i) { \
        if constexpr (FP8) __builtin_amdgcn_raw_ptr_buffer_load_lds(rs, (PG8_LAS void*)(lds + (bufoff) + ldsw + _i * 8192), 16, (int)(voff)[_i], (int)(soff), 0, 0); \
        else __builtin_amdgcn_global_load_lds((const unsigned*)((&rs == &rsA ? (const char*)g.A : (const char*)g.Bt) + (size_t)(soff) + (voff)[_i]), (PG8_LAS unsigned*)(lds + (bufoff) + ldsw + _i * 8192), 16, 0, 0); } } while (0)
#else
#define PG8_STAGE(bufoff, rs, soff, voff) do { _Pragma("unroll") for (int _i = 0; _i < 2; ++_i) \
        __builtin_amdgcn_raw_ptr_buffer_load_lds(rs, (PG8_LAS void*)(lds + (bufoff) + ldsw + _i * 8192), 16, (int)(voff)[_i], (int)(soff), 0, 0); } while (0)
#endif
#define PG8_STAGE_A(bufoff, half, soff, gsel) do { if constexpr (Sched::GATHER) { PG8_STAGE(bufoff, rsA, soff, gsel[half]); } else { PG8_STAGE(bufoff, rsA, (soff) + (half) * hstep, voffA); } } while (0)
#define PG8_LDA(dst, b, h) do { if constexpr (FP8) { _Pragma("unroll") for (int m = 0; m < 4; ++m) { const v4i_t _lo = *(const PG8_LAS v4i_t*)(lds + PG8_SA(b, h) + aoff + m * 2048), _hi = *(const PG8_LAS v4i_t*)(lds + PG8_SA(b, h) + aoff + m * 2048 + 1024); dst##8[m] = __builtin_shufflevector(_lo, _hi, 0, 1, 2, 3, 4, 5, 6, 7); } } \
    else { _Pragma("unroll") for (int m = 0; m < 4; ++m) _Pragma("unroll") for (int k = 0; k < 2; ++k) dst[m][k] = *(const PG8_LAS bf16x8*)(lds + PG8_SA(b, h) + aoff + m * 2048 + k * 1024); } } while (0)
#define PG8_LDB(dst, b, h) do { if constexpr (FP8) { _Pragma("unroll") for (int n = 0; n < 2; ++n) { const v4i_t _lo = *(const PG8_LAS v4i_t*)(lds + PG8_SB(b, h) + boff + n * 2048), _hi = *(const PG8_LAS v4i_t*)(lds + PG8_SB(b, h) + boff + n * 2048 + 1024); dst##8[n] = __builtin_shufflevector(_lo, _hi, 0, 1, 2, 3, 4, 5, 6, 7); } } \
    else { _Pragma("unroll") for (int n = 0; n < 2; ++n) _Pragma("unroll") for (int k = 0; k < 2; ++k) dst[n][k] = *(const PG8_LAS bf16x8*)(lds + PG8_SB(b, h) + boff + n * 2048 + k * 1024); } } while (0)
#define PG8_MMA(ai, bj, At, Bt) do { __builtin_amdgcn_s_setprio(1); _Pragma("unroll") for (int m = 0; m < 4; ++m) _Pragma("unroll") for (int n = 0; n < 2; ++n) { \
        if constexpr (FP8) acc[ai][bj][m][n] = __builtin_amdgcn_mfma_scale_f32_16x16x128_f8f6f4(Bt##8[n], At##8[m], acc[ai][bj][m][n], 0, 0, 0, 0, 0, 0); \
        else { _Pragma("unroll") for (int k = 0; k < 2; ++k) acc[ai][bj][m][n] = __builtin_amdgcn_mfma_f32_16x16x32_bf16(Bt[n][k], At[m][k], acc[ai][bj][m][n], 0, 0, 0); } } __builtin_amdgcn_s_setprio(0); } while (0)
#define PG8_WAIT_V(n) asm volatile("s_waitcnt vmcnt(" #n ")" ::: "memory")
#define PG8_WAIT_L(n) asm volatile("s_waitcnt lgkmcnt(" #n ")" ::: "memory")
#define PG8_BAR __builtin_amdgcn_s_barrier()
#define PG8_SCHED __builtin_amdgcn_sched_barrier(0)
    Unit cur, nxt; int ui = 0;
    if (!S.next(0, cur)) return;
    f32x4 acc[2][2][4][2];
#pragma unroll
    for (int a = 0; a < 2; ++a)
#pragma unroll
        for (int b = 0; b < 2; ++b)
#pragma unroll
            for (int m = 0; m < 4; ++m)
#pragma unroll
                for (int n = 0; n < 2; ++n) acc[a][b][m][n] = (f32x4){0.f, 0.f, 0.f, 0.f};
    bf16x8 At[4][2], B0[2][2], B1[2][2]; v8i_t At8[4], B08[2], B18[2];
    unsigned cA = a_base_of(S, cur, tstep), cB = (unsigned)cur.bt * tstep;
    unsigned gc[2][2] = {{0u, 0u}, {0u, 0u}};
    if constexpr (Sched::GATHER) S.rows(cur, gc);
    if constexpr (SP2) {
        PG8_STAGE(PG8_SB(0, 0), rsB, cB, voffB); PG8_STAGE(PG8_SB(0, 1), rsB, cB + hstep, voffB); PG8_STAGE_A(PG8_SA(0, 0), 0, cA, gc); PG8_STAGE_A(PG8_SA(0, 1), 1, cA, gc);
        if (wr == 1) PG8_BAR;
        PG8_WAIT_V(2); PG8_BAR;
        PG8_STAGE(PG8_SB(1, 0), rsB, cB + kstep, voffB); PG8_STAGE_A(PG8_SA(1, 0), 0, cA + kstep, gc); PG8_STAGE(PG8_SB(1, 1), rsB, cB + hstep + kstep, voffB);
        PG8_WAIT_V(6); PG8_BAR;
    } else {
        PG8_STAGE(PG8_SB(0, 0), rsB, cB, voffB); PG8_STAGE_A(PG8_SA(0, 0), 0, cA, gc); PG8_STAGE(PG8_SB(0, 1), rsB, cB + hstep, voffB); PG8_STAGE_A(PG8_SA(0, 1), 1, cA, gc);
        if (wr == 1) PG8_BAR;
        PG8_WAIT_V(4); PG8_BAR;
        PG8_STAGE(PG8_SB(1, 0), rsB, cB + kstep, voffB); PG8_STAGE_A(PG8_SA(1, 0), 0, cA + kstep, gc); PG8_STAGE(PG8_SB(1, 1), rsB, cB + hstep + kstep, voffB);
        PG8_WAIT_V(6); PG8_BAR;
    }
    for (;;) {
        const bool has_next = S.next(ui + 1, nxt);
        const unsigned nA = has_next ? a_base_of(S, nxt, tstep) : cA, nB = has_next ? (unsigned)nxt.bt * tstep : cB;
#pragma clang loop unroll(disable)
        for (int t = 0; t < nt; t += 2) {
            const bool last = (t == nt - 2);
            const unsigned a1 = cA + (unsigned)(t + 1) * kstep;
            const unsigned a2 = last ? nA : cA + (unsigned)(t + 2) * kstep, b2 = last ? nB : cB + (unsigned)(t + 2) * kstep;
            const unsigned a3 = a2 + kstep, b3 = b2 + kstep;
            unsigned g23[2][2] = {{gc[0][0], gc[0][1]}, {gc[1][0], gc[1][1]}};
            if constexpr (Sched::GATHER) { if (last && has_next) S.rows(nxt, g23); }
            if constexpr (SP2) {
            PG8_LDB(B0, 0, 0); PG8_LDB(B1, 0, 1); PG8_SCHED; PG8_LDA(At, 0, 0); PG8_STAGE_A(PG8_SA(1, 1), 1, a1, gc);
            PG8_WAIT_V(8); PG8_WAIT_L(0); PG8_BAR; PG8_MMA(0, 0, At, B0); PG8_MMA(0, 1, At, B1); PG8_BAR; PG8_SCHED;
            PG8_LDA(At, 0, 1); PG8_STAGE(PG8_SB(0, 0), rsB, b2, voffB); PG8_STAGE(PG8_SB(0, 1), rsB, b2 + hstep, voffB); PG8_STAGE_A(PG8_SA(0, 0), 0, a2, g23);
            PG8_WAIT_V(8); PG8_WAIT_L(0); PG8_BAR; PG8_MMA(1, 0, At, B0); PG8_MMA(1, 1, At, B1); PG8_BAR; PG8_SCHED;
            PG8_LDB(B0, 1, 0); PG8_LDB(B1, 1, 1); PG8_SCHED; PG8_LDA(At, 1, 0); PG8_STAGE_A(PG8_SA(0, 1), 1, a2, g23);
            PG8_WAIT_V(8); PG8_WAIT_L(0); PG8_BAR; PG8_MMA(0, 0, At, B0); PG8_MMA(0, 1, At, B1); PG8_BAR; PG8_SCHED;
            PG8_LDA(At, 1, 1); PG8_STAGE(PG8_SB(1, 0), rsB, b3, voffB); PG8_STAGE(PG8_SB(1, 1), rsB, b3 + hstep, voffB); PG8_STAGE_A(PG8_SA(1, 0), 0, a3, g23);
            PG8_WAIT_V(8); PG8_WAIT_L(0); PG8_BAR; PG8_MMA(1, 0, At, B0); PG8_MMA(1, 1, At, B1); PG8_BAR; PG8_SCHED;
            } else {
            PG8_LDB(B0, 0, 0); PG8_SCHED; PG8_LDA(At, 0, 0); PG8_STAGE_A(PG8_SA(1, 1), 1, a1, gc);
            PG8_WAIT_L(8); PG8_BAR; PG8_WAIT_L(0); PG8_MMA(0, 0, At, B0); PG8_BAR; PG8_SCHED;
            PG8_LDB(B1, 0, 1); PG8_STAGE(PG8_SB(0, 0), rsB, b2, voffB);
            PG8_BAR; PG8_WAIT_L(0); PG8_MMA(0, 1, At, B1); PG8_BAR;
            PG8_LDA(At, 0, 1); PG8_STAGE_A(PG8_SA(0, 0), 0, a2, g23);
            PG8_BAR; PG8_WAIT_L(0); PG8_MMA(1, 0, At, B0); PG8_BAR; PG8_SCHED;
            PG8_STAGE(PG8_SB(0, 1), rsB, b2 + hstep, voffB);
            PG8_WAIT_V(6); PG8_BAR; PG8_MMA(1, 1, At, B1); PG8_BAR;
            PG8_LDB(B0, 1, 0); PG8_SCHED; PG8_LDA(At, 1, 0); PG8_STAGE_A(PG8_SA(0, 1), 1, a2, g23);
            PG8_WAIT_L(8); PG8_BAR; PG8_WAIT_L(0); PG8_MMA(0, 0, At, B0); PG8_BAR; PG8_SCHED;
            PG8_LDB(B1, 1, 1); PG8_STAGE(PG8_SB(1, 0), rsB, b3, voffB);
            PG8_BAR; PG8_WAIT_L(0); PG8_MMA(0, 1, At, B1); PG8_BAR;
            PG8_LDA(At, 1, 1); PG8_STAGE_A(PG8_SA(1, 0), 0, a3, g23);
            PG8_BAR; PG8_WAIT_L(0); PG8_MMA(1, 0, At, B0); PG8_BAR; PG8_SCHED;
            PG8_STAGE(PG8_SB(1, 1), rsB, b3 + hstep, voffB);
            PG8_WAIT_V(6); PG8_BAR; PG8_MMA(1, 1, At, B1); PG8_BAR;
            }
        }
        if constexpr (ALIGN_EPI) { if (wr == 0) PG8_BAR; }
        if (!skip_epi) E(acc, cur, wr, wc, fr, fq); else asm volatile("" :: "v"(acc[0][0][0][0]), "v"(acc[1][1][3][1]), "v"(acc[0][1][2][0]), "v"(acc[1][0][1][1]));
        if (!has_next) break;
#pragma unroll
        for (int a = 0; a < 2; ++a)
#pragma unroll
            for (int b = 0; b < 2; ++b)
#pragma unroll
                for (int m = 0; m < 4; ++m)
#pragma unroll
                    for (int n = 0; n < 2; ++n) acc[a][b][m][n] = (f32x4){0.f, 0.f, 0.f, 0.f};
        cur = nxt; cA = nA; cB = nB; ++ui;
        if constexpr (Sched::GATHER) S.rows(cur, gc);
        if constexpr (ALIGN_EPI) { if (wr == 1) PG8_BAR; }
    }
    PG8_WAIT_V(0);
    if constexpr (!ALIGN_EPI) { if (wr == 0) PG8_BAR; }
    PG8_BAR;
#undef PG8_SA
#undef PG8_SB
#undef PG8_STAGE
#undef PG8_STAGE_A
#undef PG8_LDA
#undef PG8_LDB
#undef PG8_MMA
#undef PG8_WAIT_V
#undef PG8_WAIT_L
#undef PG8_BAR
#undef PG8_SCHED
}
}

namespace attn_body {
using bf16x8=__attribute__((ext_vector_type(8)))short;
using s16x4=__attribute__((ext_vector_type(4)))short;
using f32x16=__attribute__((ext_vector_type(16)))float;
using u32x4=__attribute__((ext_vector_type(4)))unsigned;
typedef unsigned short bf16r;
constexpr int D=64, QP=AW, KP=KVW, OP=DM;
constexpr int NW=8,QBLK=32,QB=QBLK*NW,KVBLK=64;
__device__ __forceinline__ int crow(int r,int hi){return (r&3)+8*(r>>2)+4*hi;}
#define SBAR() __builtin_amdgcn_sched_barrier(0)
constexpr int NSLOT=3, SLOTB=8192;
constexpr int LDS_K=0, LDS_V=NSLOT*SLOTB, LDS_WS=2*NSLOT*SLOTB, LDS_OST=LDS_WS+NW*64*4, LDS_BYTES_A=LDS_OST+NW*4096;
__device__ __forceinline__ void glds16(const void*gsrc,unsigned lds_dst){unsigned keep;
  asm volatile("s_mov_b32 %0, m0\n\ts_mov_b32 m0, %2\n\ts_nop 0\n\tglobal_load_lds_dwordx4 %1, off\n\ts_mov_b32 m0, %0":"=&s"(keep):"v"(gsrc),"s"(lds_dst):"memory");}
__device__ __forceinline__ float max3f(float a,float b,float c){float r;asm("v_max3_f32 %0, %1, %2, %3":"=v"(r):"v"(a),"v"(b),"v"(c));return r;}
__device__ __forceinline__ float max2f(float a,float b){float r;asm("v_max_f32_e32 %0, %1, %2":"=v"(r):"v"(a),"v"(b));return r;}
__device__ __forceinline__ float fadd_s(float a,float b){float r;asm("v_add_f32_e32 %0, %1, %2":"=v"(r):"v"(a),"v"(b));return r;}
__device__ __forceinline__ float fsub_s(float a,float b){float r;asm("v_sub_f32_e32 %0, %1, %2":"=v"(r):"v"(a),"v"(b));return r;}
typedef float f32x2_t __attribute__((ext_vector_type(2))); typedef __bf16 bf16x2_t __attribute__((ext_vector_type(2)));
__device__ __forceinline__ unsigned cvtpk_s(float lo,float hi){f32x2_t v={lo,hi};bf16x2_t b=__builtin_convertvector(v,bf16x2_t);return __builtin_bit_cast(unsigned,b);}
#define WAIT_BAR(N) asm volatile("s_waitcnt vmcnt(" #N ") lgkmcnt(0)\n\ts_barrier":::"memory")
__device__ __forceinline__ void qkt(f32x16&p0,f32x16&p1,const char*Kslot,const bf16x8*qr,const f32x16&negm,int r32,int hi){
  const char*kb=Kslot+hi*1024+r32*16;
  #pragma unroll
  for(int d0=0;d0<4;++d0){
    const bf16x8 b0=*reinterpret_cast<const bf16x8*>(kb+d0*2048);
    const bf16x8 b1=*reinterpret_cast<const bf16x8*>(kb+d0*2048+512);
    if(d0==0){p0=__builtin_amdgcn_mfma_f32_32x32x16_bf16(b0,qr[0],negm,0,0,0);p1=__builtin_amdgcn_mfma_f32_32x32x16_bf16(b1,qr[0],negm,0,0,0);}
    else{p0=__builtin_amdgcn_mfma_f32_32x32x16_bf16(b0,qr[d0],p0,0,0,0);p1=__builtin_amdgcn_mfma_f32_32x32x16_bf16(b1,qr[d0],p1,0,0,0);}}
}
typedef __attribute__((address_space(3))) const char* lds_cptr;
typedef short v4i16_t __attribute__((ext_vector_type(4)));
__device__ __forceinline__ void kload8(bf16x8*kf,lds_cptr kp){
  kf[0]=*(const __attribute__((address_space(3))) bf16x8*)(kp);      kf[1]=*(const __attribute__((address_space(3))) bf16x8*)(kp+512);
  kf[2]=*(const __attribute__((address_space(3))) bf16x8*)(kp+2048); kf[3]=*(const __attribute__((address_space(3))) bf16x8*)(kp+2560);
  kf[4]=*(const __attribute__((address_space(3))) bf16x8*)(kp+4096); kf[5]=*(const __attribute__((address_space(3))) bf16x8*)(kp+4608);
  kf[6]=*(const __attribute__((address_space(3))) bf16x8*)(kp+6144); kf[7]=*(const __attribute__((address_space(3))) bf16x8*)(kp+6656);
}
__device__ __forceinline__ void kload2(bf16x8*kf,lds_cptr kp,int j){ kf[2*j]=*(const __attribute__((address_space(3))) bf16x8*)(kp+j*2048); kf[2*j+1]=*(const __attribute__((address_space(3))) bf16x8*)(kp+j*2048+512); }
__device__ __forceinline__ s16x4 vtr(lds_cptr p){ return __builtin_bit_cast(s16x4,__builtin_amdgcn_ds_read_tr16_b64_v4i16((__attribute__((address_space(3))) v4i16_t*)p)); }
__device__ __forceinline__ float rowmax(const f32x16&p0,const f32x16&p1){
  float a=max3f(p0[0],p0[1],p1[0]),b=max3f(p0[2],p0[3],p1[1]);a=max3f(a,p1[2],p1[3]);
  #pragma unroll
  for(int r=4;r<16;r+=4){a=max3f(a,p0[r],p0[r+1]);b=max3f(b,p0[r+2],p0[r+3]);a=max3f(a,p1[r],p1[r+1]);b=max3f(b,p1[r+2],p1[r+3]);}
  const float m=max2f(a,b);
  auto rr=__builtin_amdgcn_permlane32_swap(__float_as_uint(m),__float_as_uint(m),false,false);
  return max2f(__uint_as_float(rr[0]),__uint_as_float(rr[1]));
}
__device__ __forceinline__ void pv(f32x16*o,int vb,bf16x8 pa0,bf16x8 pa1,bf16x8 pa2,bf16x8 pa3){
  #pragma unroll
  for(int d0=0;d0<2;++d0){s16x4 lo[4],hi[4];
    #pragma unroll
    for(int ks=0;ks<4;++ks){
      asm volatile("ds_read_b64_tr_b16 %0,%1 offset:%c2":"=&v"(lo[ks]):"v"(vb),"i"(d0*4096+ks*1024):"memory");
      asm volatile("ds_read_b64_tr_b16 %0,%1 offset:%c2":"=&v"(hi[ks]):"v"(vb),"i"(d0*4096+ks*1024+512):"memory");}
    asm volatile("s_waitcnt lgkmcnt(0)":::"memory");SBAR();
    #define PK(k) (bf16x8){lo[k][0],lo[k][1],lo[k][2],lo[k][3],hi[k][0],hi[k][1],hi[k][2],hi[k][3]}
    o[d0]=__builtin_amdgcn_mfma_f32_32x32x16_bf16(pa0,PK(0),o[d0],0,0,0);
    o[d0]=__builtin_amdgcn_mfma_f32_32x32x16_bf16(pa1,PK(1),o[d0],0,0,0);
    o[d0]=__builtin_amdgcn_mfma_f32_32x32x16_bf16(pa2,PK(2),o[d0],0,0,0);
    o[d0]=__builtin_amdgcn_mfma_f32_32x32x16_bf16(pa3,PK(3),o[d0],0,0,0);
    #undef PK
  }
}
template<int THRL> __device__ __forceinline__ void attn_unit(int b,int h,int qb,const bf16r*Q,const bf16r*__restrict__ K,const bf16r*__restrict__ V,bf16r*O,char*shm,bool pre_issued,bool issue_next,float bref){
  const int tid=threadIdx.x,lane=tid&63,r32=lane&31,hi=lane>>5; const int wid=__builtin_amdgcn_readfirstlane(tid>>6);
  const long rowbase=(long)b*SEQ; const int q0=qb*QB; const int hk=h>>2;
  const bf16r*Qw=Q+(rowbase+q0+wid*QBLK)*QP+h*D;
  const bf16r*Kh=K+rowbase*KP+hk*D,*Vh=V+rowbase*KP+hk*D;
  const unsigned lds0=(unsigned)(uintptr_t)shm;
  float*wsf=(float*)(shm+LDS_WS)+wid*64;
  const bf16r*ksrc=Kh+(long)lane*KP+wid*8;
  const bf16r*vsrc=Vh+(long)(16*(wid&3)+(lane>>2))*KP+(wid>>2)*32+(lane&3)*8;
  const unsigned kdst=lds0+LDS_K+wid*1024, vdst=lds0+LDS_V+wid*1024;
  #define DMA_K(t,slot) glds16(ksrc+(long)(t)*KVBLK*KP,(unsigned)__builtin_amdgcn_readfirstlane(kdst+(slot)))
  #define DMA_V(t,slot) glds16(vsrc+(long)(t)*KVBLK*KP,(unsigned)__builtin_amdgcn_readfirstlane(vdst+(slot)))
  const int vb0=(int)(lds0+LDS_V)+((lane>>4)&1)*32+(lane&3)*8+(4*hi+((lane&15)>>2))*64;
  const char*Kbase=shm+LDS_K; bf16x8 kf[8];
  const lds_cptr shm3=(lds_cptr)shm; const lds_cptr kp0=shm3+LDS_K+hi*1024+r32*16; const lds_cptr vp0=shm3+LDS_V+((lane>>4)&1)*32+(lane&3)*8+(4*hi+((lane&15)>>2))*64;
  constexpr int NT=SEQ/KVBLK;
  if(!pre_issued){DMA_K(0,0);DMA_V(0,0);DMA_K(1,SLOTB);}
  bf16x8 qr[4];
  #pragma unroll
  for(int d0=0;d0<4;++d0)qr[d0]=*reinterpret_cast<const bf16x8*>(&Qw[(long)r32*QP+d0*16+hi*8]);
  float l_reg=0.f;f32x16 o[2];o[0]=f32x16{};o[1]=f32x16{};f32x16 negm;
  _Pragma("unroll") for(int r=0;r<16;++r)negm[r]=-bref; asm volatile("":"+v"(negm));
  bool resc=false;
  #define START(P0,P1) do{ _Pragma("unroll") for(int r=0;r<16;++r)P0[r]=__builtin_amdgcn_exp2f(P0[r]); }while(0)
  #define RESC() do{ if(resc){ asm volatile("s_waitcnt lgkmcnt(0)":::"memory"); \
      _Pragma("unroll") for(int d_=0;d_<2;++d_) _Pragma("unroll") for(int r=0;r<16;++r)o[d_][r]*=wsf[crow(r,hi)]; } }while(0)
  f32x16 pA0,pA1,pB0,pB1;
  int sl_prev=0,sl_cur=0,sl_next=SLOTB;
  #define ROT() do{sl_prev=sl_cur;sl_cur=sl_next;sl_next=(sl_next==(NSLOT-1)*SLOTB)?0:sl_next+SLOTB;}while(0)
  if(!pre_issued){DMA_K(2,2*SLOTB);}
  WAIT_BAR(3);
  qkt(pA0,pA1,Kbase,qr,negm,r32,hi);asm volatile("s_nop 15\n\ts_nop 7":"+v"(pA0),"+v"(pA1));
  START(pA0,pA1);
  _Pragma("unroll") for(int r=0;r<16;++r)pA1[r]=__builtin_amdgcn_exp2f(pA1[r]);
  WAIT_BAR(0);
  DMA_K(3,0);DMA_V(1,SLOTB);
  ROT();
  kload8(kf,kp0+sl_cur);
  WAIT_BAR(2);
  s16x4 vlo[8],vhi[8]; u32x4 pw0,pw1,pw2,pw3;
  #define PKW(P,B) cvtpk_s(P[B],P[B+1])
  #define PAF(k) __builtin_bit_cast(bf16x8,pw##k)
  #define VFR(i) (bf16x8){vlo[i][0],vlo[i][1],vlo[i][2],vlo[i][3],vhi[i][0],vhi[i][1],vhi[i][2],vhi[i][3]}
  #define PIN(x) asm volatile("":"+v"(x))
  #define MX3(a,b,c) __builtin_fmaxf(__builtin_fmaxf((a),(b)),(c))
  #define GAPA(MF,A0,A1,A2,A3,W0,W1,PW) do{ MF; sacc+=A0; sacc+=A1; sacc+=A2; sacc+=A3; PIN(sacc); W0; W1; PIN(PW); SBAR(); }while(0)
  #define EX(v) __builtin_amdgcn_exp2f(v)
  #define GAPB(MF,X,B) do{ MF; X[B]=EX(X[B]); X[B+1]=EX(X[B+1]); X[B+2]=EX(X[B+2]); X[B+3]=EX(X[B+3]); PIN(X); SBAR(); }while(0)
  #define VRD(i) do{ vlo[i]=vtr(vp_+(((i)>>2)*4096+((i)&3)*1024)); vhi[i]=vtr(vp_+(((i)>>2)*4096+((i)&3)*1024+512)); }while(0)
  #define KRD(G,j) do{ if(G){ kload2(kf,kp0+sl_next,j); SBAR(); } }while(0)
  #define STEP(C0,C1,P0,P1,t,GK,GV,GL) do{ SBAR(); \
    const lds_cptr vp_=vp0+sl_prev; \
    VRD(0); SBAR(); float sacc=(P0[0]+P0[1]); \
    GAPA(C0=__builtin_amdgcn_mfma_f32_32x32x16_bf16(kf[0],qr[0],negm,0,0,0), P0[2],P0[3],P0[4],P0[5],     pw0[0]=PKW(P0,0), pw0[1]=PKW(P0,2), pw0); \
    VRD(4); SBAR(); GAPA(C1=__builtin_amdgcn_mfma_f32_32x32x16_bf16(kf[1],qr[0],negm,0,0,0), P0[6],P0[7],P0[8],P0[9],     pw0[2]=PKW(P0,4), pw0[3]=PKW(P0,6), pw0); \
    VRD(1); SBAR(); GAPA(C0=__builtin_amdgcn_mfma_f32_32x32x16_bf16(kf[2],qr[1],C0,0,0,0),   P0[10],P0[11],P0[12],P0[13], pw1[0]=PKW(P0,8), pw1[1]=PKW(P0,10), pw1); \
    VRD(5); SBAR(); GAPA(C1=__builtin_amdgcn_mfma_f32_32x32x16_bf16(kf[3],qr[1],C1,0,0,0),   P0[14],P0[15],P1[0],P1[1],   pw1[2]=PKW(P0,12),pw1[3]=PKW(P0,14), pw1); \
    VRD(2); SBAR(); GAPA(C0=__builtin_amdgcn_mfma_f32_32x32x16_bf16(kf[4],qr[2],C0,0,0,0),   P1[2],P1[3],P1[4],P1[5],     pw2[0]=PKW(P1,0), pw2[1]=PKW(P1,2), pw2); \
    VRD(6); SBAR(); GAPA(C1=__builtin_amdgcn_mfma_f32_32x32x16_bf16(kf[5],qr[2],C1,0,0,0),   P1[6],P1[7],P1[8],P1[9],     pw2[2]=PKW(P1,4), pw2[3]=PKW(P1,6), pw2); \
    VRD(3); SBAR(); GAPA(C0=__builtin_amdgcn_mfma_f32_32x32x16_bf16(kf[6],qr[3],C0,0,0,0),   P1[10],P1[11],P1[12],P1[13], pw3[0]=PKW(P1,8), pw3[1]=PKW(P1,10), pw3); \
    VRD(7); SBAR(); GAPA(C1=__builtin_amdgcn_mfma_f32_32x32x16_bf16(kf[7],qr[3],C1,0,0,0),   P1[14],P1[15],0.f,0.f,       pw3[2]=PKW(P1,12),pw3[3]=PKW(P1,14), pw3); \
    l_reg+=sacc; \
    if(GK){DMA_K((t)+3,sl_cur);} if(GV){DMA_V((t)+1,sl_next);} \
    SBAR(); \
    GAPB(o[0]=__builtin_amdgcn_mfma_f32_32x32x16_bf16(PAF(0),VFR(0),o[0],0,0,0), C0,0); \
    GAPB(o[1]=__builtin_amdgcn_mfma_f32_32x32x16_bf16(PAF(0),VFR(4),o[1],0,0,0), C0,4); \
    KRD(GL,0); GAPB(o[0]=__builtin_amdgcn_mfma_f32_32x32x16_bf16(PAF(1),VFR(1),o[0],0,0,0), C0,8); \
    KRD(GL,1); GAPB(o[1]=__builtin_amdgcn_mfma_f32_32x32x16_bf16(PAF(1),VFR(5),o[1],0,0,0), C0,12); \
    KRD(GL,2); GAPB(o[0]=__builtin_amdgcn_mfma_f32_32x32x16_bf16(PAF(2),VFR(2),o[0],0,0,0), C1,0); \
    KRD(GL,3); GAPB(o[1]=__builtin_amdgcn_mfma_f32_32x32x16_bf16(PAF(2),VFR(6),o[1],0,0,0), C1,4); \
    GAPB(o[0]=__builtin_amdgcn_mfma_f32_32x32x16_bf16(PAF(3),VFR(3),o[0],0,0,0), C1,8); \
    GAPB(o[1]=__builtin_amdgcn_mfma_f32_32x32x16_bf16(PAF(3),VFR(7),o[1],0,0,0), C1,12); \
    }while(0)
  int t=1;
  for(;t+5<NT;t+=2){
    STEP(pB0,pB1,pA0,pA1,t,true,true,true);     WAIT_BAR(2); RESC(); ROT();
    STEP(pA0,pA1,pB0,pB1,t+1,true,true,true);   WAIT_BAR(2); RESC(); ROT();
  }
  #define ENDW(tt) do{ if((tt)+3<NT){WAIT_BAR(2);} else if((tt)+2<NT){WAIT_BAR(1);} else {WAIT_BAR(0);} }while(0)
  for(;t+1<NT;t+=2){
    STEP(pB0,pB1,pA0,pA1,t,(t+3<NT),(t+1<NT),(t+1<NT));       ENDW(t);   RESC(); ROT();
    STEP(pA0,pA1,pB0,pB1,t+1,(t+4<NT),(t+2<NT),(t+2<NT));     ENDW(t+1); RESC(); ROT();
  }
  STEP(pB0,pB1,pA0,pA1,NT-1,false,false,false); RESC();
  { float sacc=pB0[0]+pB0[1]; _Pragma("unroll") for(int r=2;r<16;++r)sacc+=pB0[r]; _Pragma("unroll") for(int r=0;r<16;++r)sacc+=pB1[r]; l_reg+=sacc;
    pw0=(u32x4){PKW(pB0,0),PKW(pB0,2),PKW(pB0,4),PKW(pB0,6)};pw1=(u32x4){PKW(pB0,8),PKW(pB0,10),PKW(pB0,12),PKW(pB0,14)};pw2=(u32x4){PKW(pB1,0),PKW(pB1,2),PKW(pB1,4),PKW(pB1,6)};pw3=(u32x4){PKW(pB1,8),PKW(pB1,10),PKW(pB1,12),PKW(pB1,14)};
    SBAR(); pv(o,vb0+sl_cur,PAF(0),PAF(1),PAF(2),PAF(3)); }
  #undef PKW
  #undef PAF
  #undef VFR
  #undef PIN
  #undef MX3
  #undef GAPA
  #undef GAPB
  #undef EX
  #undef VRD
  #undef KRD
  #undef STEP
  #undef ENDW
  if(issue_next){ asm volatile("s_waitcnt lgkmcnt(0)\n\ts_barrier":::"memory");
    DMA_K(0,0);DMA_V(0,0);DMA_K(1,SLOTB);DMA_K(2,2*SLOTB); }
  {auto rr=__builtin_amdgcn_permlane32_swap(__float_as_uint(l_reg),__float_as_uint(l_reg),false,false);l_reg=__uint_as_float(rr[0])+__uint_as_float(rr[1]);}
  if(hi==0)wsf[32+r32]=l_reg;asm volatile("s_waitcnt lgkmcnt(0)":::"memory");
  float rli[16];
  #pragma unroll
  for(int r=0;r<16;++r)rli[r]=__builtin_amdgcn_rcpf(wsf[32+crow(r,hi)]);
  bf16r*Ow=O+(rowbase+q0+wid*QBLK)*OP+h*D;
  { __hip_bfloat16*stg=(__hip_bfloat16*)(shm+LDS_OST)+wid*2048;
    #pragma unroll
    for(int r=0;r<16;++r){const int orow=crow(r,hi);
      #pragma unroll
      for(int d0=0;d0<2;++d0)stg[orow*64+d0*32+r32]=__float2bfloat16(o[d0][r]*rli[r]);}
    asm volatile("s_waitcnt lgkmcnt(0)":::"memory");
    #pragma unroll
    for(int i=0;i<4;++i){const int row=i*8+(lane>>3),ch=lane&7; const u32x4 v=*(const u32x4*)(stg+row*64+ch*8); *(u32x4*)(Ow+(long)row*OP+ch*8)=v;} }
  asm volatile("s_waitcnt lgkmcnt(0)\n\ts_barrier":::"memory");
  #undef DMA_K
  #undef DMA_V
  #undef START
  #undef RESC
  #undef ROT
}
#undef SBAR
#undef WAIT_BAR
}

#define XB_TMO      128
#define XB_XCNT(j)  (256  + 64 * (j))
#define XB_XSUB(j)  (1280 + 64 * (j))
#define XB_XGEN(j)  (2304 + 64 * (j))
#define XB_TOP      3328
#define XB_TOPGEN   3392
#define XCD_BAR_WORDS 3456
#define XB_SPIN_CAP (1u << 18)

__device__ __forceinline__ unsigned xb_ld(unsigned* p)              { return __hip_atomic_load(p, __ATOMIC_RELAXED, __HIP_MEMORY_SCOPE_AGENT); }
__device__ __forceinline__ unsigned xb_add(unsigned* p, unsigned v) { return __hip_atomic_fetch_add(p, v, __ATOMIC_RELAXED, __HIP_MEMORY_SCOPE_AGENT); }
__device__ __forceinline__ unsigned xb_xcc_id() { return (unsigned)__builtin_amdgcn_s_getreg((3 << 11) | 20) & 0xFu; }
#define XB_SPIN(cond, bar) do { unsigned _sp = 0; while (cond) { __builtin_amdgcn_s_sleep(1); \
    if ((++_sp & 255u) == 0u) { if (xb_ld(&(bar)[XB_TMO])) break; if (_sp > XB_SPIN_CAP) { atomicAdd(&(bar)[XB_TMO], 1u); break; } } } } while (0)

struct XcdBarrier {
    unsigned* bar; unsigned x;
    volatile LAS unsigned* st;
};

__device__ __forceinline__ XcdBarrier xcd_barrier_post(unsigned* bar, volatile LAS unsigned* st) {
    XcdBarrier b; b.bar = bar; b.x = xb_xcc_id(); b.st = st;
    if (threadIdx.x == 0) (void)xb_add(&bar[XB_XCNT(b.x)], 1u);
    return b;
}
__device__ __forceinline__ void xcd_barrier_complete(unsigned* bar, unsigned x, unsigned& nloc, unsigned& nx) {
    const unsigned G = gridDim.x * gridDim.y * gridDim.z;
    unsigned sum, cnt, mine, sp = 0u;
    for (;;) {
        sum = 0u; cnt = 0u; mine = 0u;
#pragma unroll
        for (unsigned j = 0; j < 16; ++j) { const unsigned c = xb_ld(&bar[XB_XCNT(j)]); sum += c; cnt += (c > 0u) ? 1u : 0u; mine = (j == x) ? c : mine; }
        if (sum == G) break;
        __builtin_amdgcn_s_sleep(1);
        if ((++sp & 255u) == 0u) { if (xb_ld(&bar[XB_TMO])) break; if (sp > XB_SPIN_CAP) { atomicAdd(&bar[XB_TMO], 1u); break; } }
    }
    nloc = mine > 0u ? mine : 1u; nx = cnt > 0u ? cnt : 1u;
}

__device__ __forceinline__ void xcd_barrier(const XcdBarrier& b) {
    asm volatile("s_waitcnt vmcnt(0)" ::: "memory");
    __syncthreads();
    if (threadIdx.x == 0) {
        unsigned* bar = b.bar;
        __builtin_amdgcn_s_waitcnt(0);
        unsigned nloc = b.st[0], nx = b.st[1];
        if (nloc == 0u) { xcd_barrier_complete(bar, b.x, nloc, nx); b.st[0] = nloc; b.st[1] = nx; }
        const unsigned old = xb_add(&bar[XB_XSUB(b.x)], 1u);
        const unsigned gen = old / nloc;
        if (old + 1u == (gen + 1u) * nloc) {
            __builtin_amdgcn_fence(__ATOMIC_RELEASE, "agent");
            asm volatile("s_waitcnt vmcnt(0)" ::: "memory");
            const unsigned og = xb_add(&bar[XB_TOP], 1u);
            const unsigned tg = og / nx;
            if (og + 1u == (tg + 1u) * nx) xb_add(&bar[XB_TOPGEN], 1u);
            else XB_SPIN(xb_ld(&bar[XB_TOPGEN]) == tg, bar);
            __builtin_amdgcn_fence(__ATOMIC_ACQUIRE, "agent");
            xb_add(&bar[XB_XGEN(b.x)], 1u);
            asm volatile("s_waitcnt vmcnt(0)" ::: "memory");
        } else {
            XB_SPIN(xb_ld(&bar[XB_XGEN(b.x)]) == gen, bar);
            __builtin_amdgcn_fence(__ATOMIC_ACQUIRE, "agent");
            asm volatile("s_waitcnt vmcnt(0)" ::: "memory");
        }
    }
    __syncthreads();
}


struct Frame {
    LAS unsigned char* lds;
    int tid, lane, wave;
    int vcu, G;
    unsigned flags;
};
struct Args { const float* in[25]; float* out; unsigned char* ws; unsigned mask, pad; };

__device__ __forceinline__ void p0_transpose_item(const float* W, int K, int N, bf16* WT, int k0, int n0, int v0, LAS float* scr, int lane, const float* ksc = nullptr, int kmode = 0) {
#pragma unroll 8
    for (int i = 0; i < 32; ++i) { const int kk = 2 * i + (lane >> 5); float wv = W[(size_t)(k0 + kk) * N + n0 + (lane & 31)];
        if (ksc) { const float mv = ksc[k0 + kk]; wv *= (kmode == 1) ? (1.0f - mv) : (0.5f * mv); }
        scr[kk * 33 + (lane & 31)] = wv; }
    LDS_WAIT(); asm volatile("" ::: "memory");
    const int c = lane & 7;
#pragma unroll
    for (int j = 0; j < 4; ++j) { const int n = (lane >> 3) + 8 * j; const LAS float* s = scr + (8 * c) * 33 + n;
        v4u o; o.x = pk2(s[0 * 33], s[1 * 33]); o.y = pk2(s[2 * 33], s[3 * 33]); o.z = pk2(s[4 * 33], s[5 * 33]); o.w = pk2(s[6 * 33], s[7 * 33]);
        *(GAS v4u*)(WT + (size_t)(v0 + n) * K + k0 + 8 * c) = o; }
    LDS_WAIT(); asm volatile("" ::: "memory");
}
__device__ __forceinline__ void p0_transpose_item_fp8(const float* W, int K, int N, unsigned char* WT, int k0, int n0, int v0, LAS float* scr, int lane, float sc, bool remap16 = false) {
#pragma unroll 8
    for (int i = 0; i < 32; ++i) { const int kk = 2 * i + (lane >> 5); scr[kk * 33 + (lane & 31)] = W[(size_t)(k0 + kk) * N + n0 + (lane & 31)] * sc; }
    LDS_WAIT(); asm volatile("" ::: "memory");
    const int c = lane & 7;
#pragma unroll
    for (int j = 0; j < 4; ++j) { const int n = (lane >> 3) + 8 * j; const LAS float* s = scr + (8 * c) * 33 + n;
        unsigned w0 = 0u, w1 = 0u;
        w0 = cvt2_fp8(s[0 * 33], s[1 * 33], w0, false); w0 = cvt2_fp8(s[2 * 33], s[3 * 33], w0, true);
        w1 = cvt2_fp8(s[4 * 33], s[5 * 33], w1, false); w1 = cvt2_fp8(s[6 * 33], s[7 * 33], w1, true);
        v2u o; o.x = w0; o.y = w1;
        int vr = v0 + n;
        if (remap16) { const int t = (n0 & 255) + n, wc = t >> 6, fq = (t >> 4) & 3, bj = (t >> 3) & 1; vr = (n0 & ~255) + 128 * bj + 32 * wc + 8 * fq + (t & 7); }
        *(GAS v2u*)(WT + (size_t)vr * K + k0 + 8 * c) = o; }
    LDS_WAIT(); asm volatile("" ::: "memory");
}
struct ExpItem { const float* W; unsigned char* WT; int k0, n0, v0; bool remap; };
__device__ __forceinline__ ExpItem exp_item(const Args& a, int r) {
    constexpr int I_E = (DM / 64) * (FF / 32);
    const int mat = r / I_E, rr = r % I_E, which = mat / NE, e = mat % NE; const int nblk = FF / 32, kb = rr / nblk, nb = rr % nblk, n0 = 32 * nb;
    ExpItem it; it.k0 = 64 * kb; it.n0 = n0; it.remap = false;
    if (which == 0) { it.W = a.in[22] + (size_t)e * DM * FF; it.WT = a.ws + WS_WGU + (size_t)e * 2 * FF * DM; it.v0 = 256 * (n0 >> 7) + (n0 & 127); }
    else if (which == 1) { it.W = a.in[23] + (size_t)e * DM * FF; it.WT = a.ws + WS_WGU + (size_t)e * 2 * FF * DM; it.v0 = 256 * (n0 >> 7) + 128 + (n0 & 127); }
    else { it.W = a.in[24] + (size_t)e * FF * DM; it.WT = a.ws + WS_WD + (size_t)e * DM * FF; it.v0 = n0; it.remap = true; }
    return it;
}
__device__ __forceinline__ void exp_item_load(const ExpItem& it, float (&t)[32], int lane) {
#pragma unroll
    for (int i = 0; i < 32; ++i) { const int kk = 2 * i + (lane >> 5); t[i] = it.W[(size_t)(it.k0 + kk) * FF + it.n0 + (lane & 31)]; }
}
__device__ __forceinline__ void exp_item_store(const ExpItem& it, const float (&t)[32], LAS float* scr, int lane) {
#pragma unroll
    for (int i = 0; i < 32; ++i) { const int kk = 2 * i + (lane >> 5); scr[kk * 33 + (lane & 31)] = t[i] * 32.0f; }
    LDS_WAIT(); asm volatile("" ::: "memory");
    const int c = lane & 7;
#pragma unroll
    for (int j = 0; j < 4; ++j) { const int n = (lane >> 3) + 8 * j; const LAS float* s = scr + (8 * c) * 33 + n;
        unsigned w0 = 0u, w1 = 0u;
        w0 = cvt2_fp8(s[0 * 33], s[1 * 33], w0, false); w0 = cvt2_fp8(s[2 * 33], s[3 * 33], w0, true);
        w1 = cvt2_fp8(s[4 * 33], s[5 * 33], w1, false); w1 = cvt2_fp8(s[6 * 33], s[7 * 33], w1, true);
        v2u o; o.x = w0; o.y = w1;
        int vr = it.v0 + n;
        if (it.remap) { const int tt = (it.n0 & 255) + n, wc = tt >> 6, fq = (tt >> 4) & 3, bj = (tt >> 3) & 1; vr = (it.n0 & ~255) + 128 * bj + 32 * wc + 8 * fq + (tt & 7); }
        *(GAS v2u*)(it.WT + (size_t)vr * 1024 + it.k0 + 8 * c) = o; }
    LDS_WAIT(); asm volatile("" ::: "memory");
}
__host__ __device__ __forceinline__ int win_virt32(int n0) { const int tile = n0 >> 8, t = n0 & 255, wc = t >> 6, bj = (t >> 5) & 1; return 256 * tile + 128 * bj + 32 * wc; }

__device__ __forceinline__ void p0_prologue(Frame& F, const Args& a) {
    unsigned char* ws = a.ws;
    if (F.vcu < 192) {
        LAS float* st = (LAS float*)F.lds;
        const float* c = a.in[1];
        for (int i = F.tid; i < NB * DM; i += 512) { const float v = c[i]; st[i] = v / (1.0f + __expf(-v)); }
        __syncthreads();
        const int cc = F.tid & 31, kg = F.tid >> 5, col0 = F.vcu * 32;
        const float* wa = a.in[2] + (size_t)(kg * 64) * (6 * DM) + col0 + cc;
        float acc[32];
#pragma unroll
        for (int b = 0; b < 32; ++b) acc[b] = 0.f;
        for (int k = 0; k < 64; ++k) {
            const float wv = wa[(size_t)k * (6 * DM)];
            const LAS float* sp = st + kg * 64 + k;
#pragma unroll
            for (int b = 0; b < 32; ++b) acc[b] += sp[b * DM] * wv;
        }
        __syncthreads();
        LAS float* part = (LAS float*)F.lds;
#pragma unroll
        for (int b = 0; b < 32; ++b) part[(kg * 32 + b) * 32 + cc] = acc[b];
        __syncthreads();
        float* mod = (float*)(ws + WS_MOD);
        for (int o = F.tid; o < 1024; o += 512) { const int b = o >> 5, c2 = o & 31; float s = a.in[3][col0 + c2];
#pragma unroll
            for (int g = 0; g < 16; ++g) s += part[(g * 32 + b) * 32 + c2];
            mod[b * (6 * DM) + col0 + c2] = s; }
        __syncthreads();
    } else {
        float* rope = (float*)(ws + WS_ROPE);
        for (int j = (F.vcu - 192) * 512 + F.tid; j < SEQ * 32; j += 64 * 512) {
            const int t = j >> 5, i = j & 31;
            const float pos = (i < 16) ? (float)(t >> 6) : (float)(t & 63);
            const float freq = powf(10000.0f, -(float)(i & 15) / 16.0f);
            const float ang = pos * freq;
            rope[2 * j] = cosf(ang); rope[2 * j + 1] = sinf(ang);
        }
    }
    LAS float* scr = (LAS float*)(F.lds + F.wave * 16384);
    const int gw = F.vcu * NWAVES + F.wave, NGW = F.G * NWAVES;
    constexpr int I_IN = (DM / 64) * (NIN / 32), I_OUT = (DM / 64) * (DM / 32), I_E = (DM / 64) * (FF / 32), I_GUP = (128 / 64) * (RW / 32);
    constexpr int I_LORA = 6 * (RW / 32);
    constexpr int NITEMS = I_IN + I_OUT + I_GUP + I_LORA;
    for (int it = gw; it < NITEMS; it += NGW) {
        int r = it;
        if (r < I_IN) { const int nblk = NIN / 32, kb = r / nblk, nb = r % nblk; p0_transpose_item(a.in[5], DM, NIN, (bf16*)(ws + WS_WIN), 64 * kb, 32 * nb, win_virt32(32 * nb), scr, F.lane); continue; } r -= I_IN;
        if (r < I_OUT) { const int nblk = DM / 32, kb = r / nblk, nb = r % nblk; p0_transpose_item(a.in[19], DM, DM, (bf16*)(ws + WS_WOUT), 64 * kb, 32 * nb, 32 * nb, scr, F.lane); continue; } r -= I_OUT;
        if (r < I_GUP) { const int nblk = RW / 32, kb = r / nblk, nb = r % nblk; p0_transpose_item(a.in[13], 128, RW, (bf16*)(ws + WS_GUPT), 64 * kb, 32 * nb, 32 * nb, scr, F.lane); continue; } r -= I_GUP;
        { const int nblk = RW / 32, md = r / nblk, nb = r % nblk, which = md >> 1, d = md & 1;
          if (which == 0) p0_transpose_item(a.in[10] + (size_t)d * 64 * RW, 64, RW, (bf16*)(ws + WS_WUPT) + (size_t)d * RW * 64, 0, 32 * nb, 32 * nb, scr, F.lane);
          else if (which == 1) p0_transpose_item(a.in[12] + (size_t)d * 64 * RW, 64, RW, (bf16*)(ws + WS_AUPT) + (size_t)d * RW * 64, 0, 32 * nb, 32 * nb, scr, F.lane); }
    }
}

__device__ __forceinline__ void p1_norm(Frame& F, const Args& a) {
    const float* mod = (const float*)(a.ws + WS_MOD); bf16* H = (bf16*)(a.ws + WS_H);
    const int gw = F.vcu * NWAVES + F.wave; const int b = F.vcu >> 3;
    f32x4 gs[4], sh[4];
#pragma unroll
    for (int j = 0; j < 4; ++j) { const int c = 4 * F.lane + 256 * j; const f32x4 g = *(const f32x4*)(a.in[4] + c); const f32x4 sc = *(const f32x4*)(mod + b * 6 * DM + DM + c);
        gs[j] = g * (sc + 1.0f); sh[j] = *(const f32x4*)(mod + b * 6 * DM + c); }
    f32x4 vn[4][4];
#pragma unroll
    for (int r = 0; r < 4; ++r) { const GAS f32x4* xr = (const GAS f32x4*)(a.in[0] + ((size_t)gw * 32 + r) * DM) + F.lane;
#pragma unroll
        for (int j = 0; j < 4; ++j) vn[r][j] = xr[64 * j]; }
    for (int i = 0; i < 32; i += 4) {
        const size_t row = (size_t)gw * 32 + i;
        f32x4 v[4][4]; float s2[4];
#pragma unroll
        for (int r = 0; r < 4; ++r)
#pragma unroll
            for (int j = 0; j < 4; ++j) v[r][j] = vn[r][j];
        if (i + 4 < 32) {
#pragma unroll
            for (int r = 0; r < 4; ++r) { const GAS f32x4* xr = (const GAS f32x4*)(a.in[0] + (row + 4 + r) * DM) + F.lane;
#pragma unroll
                for (int j = 0; j < 4; ++j) vn[r][j] = xr[64 * j]; } }
        asm volatile("" ::: "memory");
#pragma unroll
        for (int r = 0; r < 4; ++r) { float t = 0.f;
#pragma unroll
            for (int j = 0; j < 4; ++j) t += (v[r][j].x * v[r][j].x + v[r][j].y * v[r][j].y) + (v[r][j].z * v[r][j].z + v[r][j].w * v[r][j].w);
            s2[r] = t; }
#pragma unroll
        for (int r = 0; r < 4; ++r) s2[r] = wave_sum(s2[r]);
#pragma unroll
        for (int r = 0; r < 4; ++r) { const float rstd = 1.0f / sqrtf(s2[r] * (1.0f / DM) + NORM_EPS);
            GAS unsigned long long* o8 = (GAS unsigned long long*)(H + (row + r) * DM) + F.lane;
#pragma unroll
            for (int j = 0; j < 4; ++j) { const f32x4 y = v[r][j] * rstd * gs[j] + sh[j]; o8[64 * j] = (unsigned long long)pk2(y.x, y.y) | ((unsigned long long)pk2(y.z, y.w) << 32); } }
    }
}

struct EpiInProj {
    static constexpr bool PERM = true;
    bf16 *Q, *K, *V, *PR; const float *qn, *kn, *rope;
    __device__ __forceinline__ void operator()(const f32x4 (&acc)[2][2][4][2], const pg8::Unit& u, int wr, int wc, int fr, int fq) const {
        { int l_ = threadIdx.x; asm volatile("" : "+v"(l_)); fr = l_ & 15; fq = (l_ >> 4) & 3; }
        const int row0 = u.pm * 256 + wr * 64 + fr;
        if (u.pn >= 3) {
            const int col0 = 256 * (u.pn - 3) + 64 * wc + 8 * fq;
#pragma unroll
            for (int ai = 0; ai < 2; ++ai)
#pragma unroll
                for (int m = 0; m < 4; ++m) { bf16* rowp = PR + (size_t)(row0 + ai * 128 + m * 16) * NSH + col0;
#pragma unroll
                    for (int bj = 0; bj < 2; ++bj) { const f32x4 v0 = acc[ai][bj][m][0], v1 = acc[ai][bj][m][1];
                        v4u w; w.x = pk2(v0[0], v0[1]); w.y = pk2(v0[2], v0[3]); w.z = pk2(v1[0], v1[1]); w.w = pk2(v1[2], v1[3]);
                        *(v4u*)(rowp + 32 * bj) = w; } }
            return;
        }
        const bool isV = (u.pn == 2 && wc >= 2);
        if (isV) {
            const int col0 = 64 * (wc - 2) + 8 * fq;
#pragma unroll
            for (int ai = 0; ai < 2; ++ai)
#pragma unroll
                for (int m = 0; m < 4; ++m) { bf16* rowp = V + (size_t)(row0 + ai * 128 + m * 16) * KVW + col0;
#pragma unroll
                    for (int bj = 0; bj < 2; ++bj) { const f32x4 v0 = acc[ai][bj][m][0], v1 = acc[ai][bj][m][1];
                        v4u w; w.x = pk2(v0[0], v0[1]); w.y = pk2(v0[2], v0[3]); w.z = pk2(v1[0], v1[1]); w.w = pk2(v1[2], v1[3]);
                        *(v4u*)(rowp + 32 * bj) = w; } }
            return;
        }
        const bool isQ = (u.pn < 2);
        const float* gn = isQ ? qn : kn;
        bf16* dst = isQ ? (Q + 64 * (4 * u.pn + wc)) : (K + 64 * wc);
        const int pitch = isQ ? AW : KVW;
        const float osc = isQ ? QSCALE : 1.0f;
        f32x4 gv[2][2];
#pragma unroll
        for (int bj = 0; bj < 2; ++bj)
#pragma unroll
            for (int n = 0; n < 2; ++n) gv[bj][n] = *(const f32x4*)(gn + 32 * bj + 8 * fq + 4 * n);
#pragma unroll
        for (int ai = 0; ai < 2; ++ai) {
            f32x4 csv[4][2][2];
#pragma unroll
            for (int m = 0; m < 4; ++m) { const int t = (row0 + ai * 128 + m * 16) & (SEQ - 1);
#pragma unroll
                for (int bj = 0; bj < 2; ++bj)
#pragma unroll
                    for (int n = 0; n < 2; ++n) csv[m][bj][n] = *(const f32x4*)(rope + ((size_t)t * 32 + 16 * bj + 4 * fq + 2 * n) * 2); }
            asm volatile("" ::: "memory");
#pragma unroll
            for (int m = 0; m < 4; ++m) {
                const int row = row0 + ai * 128 + m * 16;
                float ss = 0.f;
#pragma unroll
                for (int bj = 0; bj < 2; ++bj)
#pragma unroll
                    for (int n = 0; n < 2; ++n) { const f32x4 x = acc[ai][bj][m][n]; ss += (x[0] * x[0] + x[1] * x[1]) + (x[2] * x[2] + x[3] * x[3]); }
                ss = xor32_sum(xor16_sum(ss));
                const float rstd = 1.0f / sqrtf(ss * (1.0f / 64.0f) + NORM_EPS);
                bf16* rowp = dst + (size_t)row * pitch + 8 * fq;
#pragma unroll
                for (int bj = 0; bj < 2; ++bj) {
                    unsigned w[4];
#pragma unroll
                    for (int n = 0; n < 2; ++n) {
                        const f32x4 x = acc[ai][bj][m][n] * rstd * gv[bj][n];
                        const f32x4 cs = csv[m][bj][n];
                        const float o0 = x[0] * cs[0] - x[1] * cs[1], o1 = x[0] * cs[1] + x[1] * cs[0];
                        const float o2 = x[2] * cs[2] - x[3] * cs[3], o3 = x[2] * cs[3] + x[3] * cs[2];
                        w[2 * n] = pk2(o0 * osc, o1 * osc); w[2 * n + 1] = pk2(o2 * osc, o3 * osc);
                    }
                    v4u wv; wv.x = w[0]; wv.y = w[1]; wv.z = w[2]; wv.w = w[3];
                    *(v4u*)(rowp + 32 * bj) = wv;
                }
            }
            asm volatile("" ::: "memory");
        }
    }
};

struct EpiOutProj {
    static constexpr bool PERM = true;
    const float* x; bf16* x1; const float* mod;
    __device__ __forceinline__ void operator()(const f32x4 (&acc)[2][2][4][2], const pg8::Unit& u, int wr, int wc, int fr, int fq) const {
        { int l_ = threadIdx.x; asm volatile("" : "+v"(l_)); fr = l_ & 15; fq = (l_ >> 4) & 3; }
        const int row0 = u.pm * 256 + wr * 64 + fr, col0 = u.pn * 256 + wc * 32 + 8 * fq; const int b = u.pm >> 3;
        f32x4 gt[2][2];
#pragma unroll
        for (int bj = 0; bj < 2; ++bj)
#pragma unroll
            for (int n = 0; n < 2; ++n) gt[bj][n] = *(const f32x4*)(mod + b * 6 * DM + 2 * DM + col0 + bj * 128 + n * 4);
#pragma unroll
        for (int ai = 0; ai < 2; ++ai) {
            f32x4 xv[4][2][2];
#pragma unroll
            for (int m = 0; m < 4; ++m) { const size_t off = (size_t)(row0 + ai * 128 + m * 16) * DM + col0;
#pragma unroll
                for (int bj = 0; bj < 2; ++bj)
#pragma unroll
                    for (int n = 0; n < 2; ++n) xv[m][bj][n] = *(const f32x4*)(x + off + bj * 128 + n * 4); }
            asm volatile("" ::: "memory");
#pragma unroll
            for (int m = 0; m < 4; ++m) { const size_t off = (size_t)(row0 + ai * 128 + m * 16) * DM + col0;
#pragma unroll
                for (int bj = 0; bj < 2; ++bj) { const f32x4 v0 = xv[m][bj][0] + gt[bj][0] * acc[ai][bj][m][0], v1 = xv[m][bj][1] + gt[bj][1] * acc[ai][bj][m][1];
                    v4u w; w.x = pk2(v0[0], v0[1]); w.y = pk2(v0[2], v0[3]); w.z = pk2(v1[0], v1[1]); w.w = pk2(v1[2], v1[3]);
                    *(v4u*)(x1 + off + bj * 128) = w; } }
            asm volatile("" ::: "memory");
        }
    }
};


__device__ __forceinline__ int grot(int b) { return (b * 37) & (SEQ / 4 - 1); }
__device__ __forceinline__ void prs_pass(Frame& F, const Args& a) {
    const bf16* __restrict__ PR = (const bf16*)(a.ws + WS_PR); bf16* __restrict__ RK = (bf16*)(a.ws + WS_RKVS); bf16* __restrict__ TD = (bf16*)(a.ws + WS_TDS);
    const float* __restrict__ mu = a.in[8];
    const int lane = F.lane; const int b = F.vcu >> 3;
    f32x4 mus[7];
#pragma unroll
    for (int cs = 0; cs < 7; ++cs) mus[cs] = *(const f32x4*)(mu + 256 * cs + 4 * lane);
    v2u xn[7][6];
#define PRS_LOAD(G) do { _Pragma("unroll") for (int r = 0; r < 6; ++r) { int t_ = 4 * (G) - 1 + r; t_ = t_ < 0 ? 0 : t_ > SEQ - 1 ? SEQ - 1 : t_; \
            const bf16* rp_ = PR + ((size_t)b * SEQ + t_) * NSH + 4 * lane; _Pragma("unroll") for (int cs = 0; cs < 7; ++cs) xn[cs][r] = *(const v2u*)(rp_ + 256 * cs); } } while (0)
    PRS_LOAD((F.vcu & 7) * 64 + F.wave * 8);
    for (int it = 0; it < 8; ++it) {
        const int g = (F.vcu & 7) * 64 + F.wave * 8 + it;
        const size_t row0 = (size_t)b * SEQ + 4 * g;
        v2u x[7][6];
#pragma unroll
        for (int cs = 0; cs < 7; ++cs)
#pragma unroll
            for (int r = 0; r < 6; ++r) x[cs][r] = xn[cs][r];
        if (it + 1 < 8) PRS_LOAD(g + 1);
        asm volatile("" ::: "memory");
        if (g == 0) {
#pragma unroll
            for (int cs = 0; cs < 7; ++cs) x[cs][0] = (v2u){0u, 0u}; }
        if (g == SEQ / 4 - 1) {
#pragma unroll
            for (int cs = 0; cs < 7; ++cs) x[cs][5] = (v2u){0u, 0u}; }
#pragma unroll
        for (int cs = 0; cs < 7; ++cs) {
            float y[4][4];
#pragma unroll
            for (int e = 0; e < 4; ++e) { const v2u c = x[cs][e + 1], p = x[cs][e], n = x[cs][e + 2];
                const float c0 = bflo(c.x), c1 = bfhi(c.x), c2 = bflo(c.y), c3 = bfhi(c.y);
                y[e][0] = c0 + mus[cs][0] * (0.5f * (bflo(p.x) + bflo(n.x)) - c0); y[e][1] = c1 + mus[cs][1] * (0.5f * (bfhi(p.x) + bfhi(n.x)) - c1);
                y[e][2] = c2 + mus[cs][2] * (0.5f * (bflo(p.y) + bflo(n.y)) - c2); y[e][3] = c3 + mus[cs][3] * (0.5f * (bfhi(p.y) + bfhi(n.y)) - c3); }
            if (cs < 6) {
                bf16* dst = RK + (((size_t)b * (SEQ / 4) + ((g + grot(b)) & (SEQ / 4 - 1))) * 1536 + 256 * cs + 4 * lane) * 4;
                v4u w0, w1;
                w0.x = pk2(y[0][0], y[1][0]); w0.y = pk2(y[2][0], y[3][0]); w0.z = pk2(y[0][1], y[1][1]); w0.w = pk2(y[2][1], y[3][1]);
                w1.x = pk2(y[0][2], y[1][2]); w1.y = pk2(y[2][2], y[3][2]); w1.z = pk2(y[0][3], y[1][3]); w1.w = pk2(y[2][3], y[3][3]);
                *(v4u*)dst = w0; *(v4u*)(dst + 8) = w1;
            } else {
#pragma unroll
                for (int e = 0; e < 4; ++e) { float o[4];
#pragma unroll
                    for (int j = 0; j < 4; ++j) { const float v = y[e][j]; const float th = 1.0f - 2.0f * __builtin_amdgcn_rcpf(__expf(2.0f * v) + 1.0f), sg = __builtin_amdgcn_rcpf(1.0f + __expf(-v));
                        o[j] = lane < 16 ? th : lane < 32 ? v : sg; }
                    v2u w; w.x = pk2(o[0], o[1]); w.y = pk2(o[2], o[3]);
                    *(v2u*)(TD + ((size_t)b * SEQ + ((4 * g + e + 4 * grot(b)) & (SEQ - 1))) * 256 + 4 * lane) = w; }
            }
        }
    }
}

#undef PRS_LOAD
namespace wkv {
constexpr int SLOT = 12544, O_AT = 0, O_RT = 2048, O_BT = 4096, O_KT = 6144, O_VT = 8192, O_MAK = 10240, O_MTM = 10752, O_MRB = 11264, O_MRK = 11776, O_GC = 12288;
typedef short v4i16_t __attribute__((ext_vector_type(4)));
typedef __bf16 bf16x2_t __attribute__((ext_vector_type(2)));
__device__ __forceinline__ unsigned cvtpk(float lo, float hi) { f32x2 v = {lo, hi}; bf16x2_t b = __builtin_convertvector(v, bf16x2_t); return __builtin_bit_cast(unsigned, b); }
__device__ __forceinline__ v2u pack4(const f32x4 v) { v2u r; r.x = cvtpk(v[0], v[1]); r.y = cvtpk(v[2], v[3]); return r; }
__device__ __forceinline__ bf16x8 frag(v2u lo, v2u hi) { v4u w; w.x = lo.x; w.y = lo.y; w.z = hi.x; w.w = hi.y; return __builtin_bit_cast(bf16x8, w); }
__device__ __forceinline__ bf16x8 frag4(const f32x4 v) { return frag(pack4(v), (v2u){0u, 0u}); }
__device__ __forceinline__ v2u trrd(LAS const unsigned char* p) { return __builtin_bit_cast(v2u, __builtin_amdgcn_ds_read_tr16_b64_v4i16((LAS v4i16_t*)p)); }
__device__ __forceinline__ bf16x8 trop(LAS const unsigned char* arr, int m, int lane) {
    LAS const unsigned char* p = arr + (32 * m + 4 * (lane >> 4) + ((lane & 15) >> 2)) * 32 + (lane & 3) * 8;
    return frag(trrd(p), trrd(p + 16 * 32));
}
#define MFMA16(A, B, C) __builtin_amdgcn_mfma_f32_16x16x32_bf16((A), (B), (C), 0, 0, 0)
__device__ __forceinline__ void up8(const v4u w, float (&o)[8]) { o[0] = bflo(w.x); o[1] = bfhi(w.x); o[2] = bflo(w.y); o[3] = bfhi(w.y); o[4] = bflo(w.z); o[5] = bfhi(w.z); o[6] = bflo(w.w); o[7] = bfhi(w.w); }
__device__ __forceinline__ bf16x8 pack8(const float (&o)[8]) { v4u w; w.x = cvtpk(o[0], o[1]); w.y = cvtpk(o[2], o[3]); w.z = cvtpk(o[4], o[5]); w.w = cvtpk(o[6], o[7]); return __builtin_bit_cast(bf16x8, w); }
__device__ __forceinline__ float dppf(float v, int ctrl_tag);
#define WKV_DPP_ADD(v, CTRL) ((v) + __builtin_bit_cast(float, __builtin_amdgcn_update_dpp(0, __builtin_bit_cast(int, (v)), (CTRL), 0xf, 0xf, false)))
__device__ __forceinline__ float red16(float v) { v = WKV_DPP_ADD(v, 0xB1); v = WKV_DPP_ADD(v, 0x4E); v = WKV_DPP_ADD(v, 0x141); v = WKV_DPP_ADD(v, 0x140); return v; }
__device__ __forceinline__ float fsig(float x) { return __builtin_amdgcn_rcpf(1.0f + __expf(-x)); }
constexpr int NRAW = 10;
constexpr int LORA_OFF = 8 * SLOT + 12 * 64 * 4, LORA_ROW = 144, LORA_TAB = 64 * LORA_ROW;
constexpr int CST_OFF = 8 * SLOT;
__device__ __forceinline__ void prep_load(v4u (&raw)[NRAW], const bf16* RK, const bf16* TD, int b, int h, int dir, int c, int lane) {
    const int kl = lane & 15, q = lane >> 4;
    const int g = dir ? (SEQ / 4 - 1 - (4 * c + q)) : (4 * c + q);
    const bf16* rp = RK + (((size_t)b * (SEQ / 4) + ((g + grot(b)) & (SEQ / 4 - 1))) * 1536 + 64 * h + kl) * 4;
#pragma unroll
    for (int X = 0; X < 3; ++X)
#pragma unroll
        for (int cp = 0; cp < 2; ++cp) { const v2u lo = *(const v2u*)(rp + (512 * X + 16 * (2 * cp)) * 4), hi = *(const v2u*)(rp + (512 * X + 16 * (2 * cp + 1)) * 4);
            raw[X * 2 + cp] = (v4u){lo.x, lo.y, hi.x, hi.y}; }
    const int s_i = c * 16 + kl; const int t_i = dir ? (SEQ - 1 - s_i) : s_i;
    const bf16* tp = TD + ((size_t)b * SEQ + ((t_i + 4 * grot(b)) & (SEQ - 1))) * 256 + 8 * q;
#pragma unroll
    for (int m = 0; m < 2; ++m) { raw[6 + m] = *(const v4u*)(tp + 32 * m); raw[8 + m] = *(const v4u*)(tp + 64 + 32 * m); }
}
__device__ __forceinline__ f32x4 up4(unsigned w0, unsigned w1, bool rev) {
    const f32x4 t = (f32x4){bflo(w0), bfhi(w0), bflo(w1), bfhi(w1)};
    return rev ? (f32x4){t[3], t[2], t[1], t[0]} : t;
}

__device__ __forceinline__ void prep(const v4u (&raw)[NRAW], const Args& a, int b, int h, int dir, int c, LAS unsigned char* slot, LAS const float* cst, int lane, bool nostore) {
    const int kl = lane & 15, q = lane >> 4;
    LAS const unsigned char* lw_ = (LAS const unsigned char*)cst + (LORA_OFF - CST_OFF) + dir * 2 * LORA_TAB; LAS const unsigned char* la_ = lw_ + LORA_TAB;
    float* BON = (float*)(a.ws + WS_BON) + (size_t)dir * MT * 8;
    const f32x4 z4 = (f32x4){0.f, 0.f, 0.f, 0.f};
    const bool rev = dir != 0;
    f32x4 wp[4], ap[4], rx[4], kx[4], vx[4];
#pragma unroll
    for (int ct = 0; ct < 4; ++ct) { wp[ct] = z4; ap[ct] = z4;
#pragma unroll
        for (int m = 0; m < 2; ++m) { const int off = (16 * ct + kl) * LORA_ROW + (32 * m + 8 * q) * 2;
            wp[ct] = MFMA16(__builtin_bit_cast(bf16x8, raw[6 + m]), *(const LAS bf16x8*)(lw_ + off), wp[ct]); ap[ct] = MFMA16(__builtin_bit_cast(bf16x8, raw[8 + m]), *(const LAS bf16x8*)(la_ + off), ap[ct]); } }
    if (rev) {
#pragma unroll
        for (int cp = 0; cp < 2; ++cp) {
            rx[2 * cp] = up4(raw[0 + cp].x, raw[0 + cp].y, true); rx[2 * cp + 1] = up4(raw[0 + cp].z, raw[0 + cp].w, true);
            kx[2 * cp] = up4(raw[2 + cp].x, raw[2 + cp].y, true); kx[2 * cp + 1] = up4(raw[2 + cp].z, raw[2 + cp].w, true);
            vx[2 * cp] = up4(raw[4 + cp].x, raw[4 + cp].y, true); vx[2 * cp + 1] = up4(raw[4 + cp].z, raw[4 + cp].w, true); }
    } else {
#pragma unroll
        for (int cp = 0; cp < 2; ++cp) {
            rx[2 * cp] = up4(raw[0 + cp].x, raw[0 + cp].y, false); rx[2 * cp + 1] = up4(raw[0 + cp].z, raw[0 + cp].w, false);
            kx[2 * cp] = up4(raw[2 + cp].x, raw[2 + cp].y, false); kx[2 * cp + 1] = up4(raw[2 + cp].z, raw[2 + cp].w, false);
            vx[2 * cp] = up4(raw[4 + cp].x, raw[4 + cp].y, false); vx[2 * cp + 1] = up4(raw[4 + cp].z, raw[4 + cp].w, false); }
    }
    f32x4 n2 = z4, bsum = z4;
    f32x4 av[4], kd[4];
#pragma unroll
    for (int ct = 0; ct < 4; ++ct) { const int cj = 16 * ct + kl;
        const float a0 = cst[(5 + dir) * 64 + cj], kkg = cst[9 * 64 + cj], kag = cst[10 * 64 + cj], rkg = cst[11 * 64 + cj];
#pragma unroll
        for (int e = 0; e < 4; ++e) { av[ct][e] = fsig(ap[ct][e] + a0); const float kkv = kx[ct][e] * kkg; n2[e] += kkv * kkv;
            kd[ct][e] = kx[ct][e] * (1.0f + (av[ct][e] - 1.0f) * kag); bsum[e] += rx[ct][e] * kd[ct][e] * rkg; } }
#pragma unroll
    for (int e = 0; e < 4; ++e) { n2[e] = red16(n2[e]); bsum[e] = red16(bsum[e]); }
    if (kl == 0 && !nostore) {
        const int s0 = c * 16 + 4 * q; const int t0 = rev ? (SEQ - 1 - s0 - 3) : s0;
        *(f32x4*)(BON + ((size_t)b * 8 + h) * SEQ + t0) = rev ? (f32x4){bsum[3], bsum[2], bsum[1], bsum[0]} : bsum; }
    f32x4 rn;
#pragma unroll
    for (int e = 0; e < 4; ++e) rn[e] = __builtin_amdgcn_rsqf(fmaxf(n2[e], 1e-24f));
#pragma unroll
    for (int ct = 0; ct < 4; ++ct) { const int cj = 16 * ct + kl;
        const float w0 = cst[(7 + dir) * 64 + cj], kkg = cst[9 * 64 + cj];
        f32x4 L, lw;
#pragma unroll
        for (int e = 0; e < 4; ++e) lw[e] = -DECAY_SCALE * fsig(wp[ct][e] + w0);
        L[0] = lw[0]; L[1] = L[0] + lw[1]; L[2] = L[1] + lw[2]; L[3] = L[2] + lw[3];
        const float g = L[3];
        const auto ra = __builtin_amdgcn_permlane16_swap(__float_as_uint(g), __float_as_uint(g), false, false);
        const float pair = __uint_as_float(ra[0]) + __uint_as_float(ra[1]);
        const auto rb = __builtin_amdgcn_permlane32_swap(__float_as_uint(pair), __float_as_uint(pair), false, false);
        const float P = ((q & 1) ? __uint_as_float(ra[0]) : 0.f) + ((q & 2) ? __uint_as_float(rb[0]) : 0.f);
        const float Ltot = __uint_as_float(rb[0]) + __uint_as_float(rb[1]);
        f32x4 ah, bh, kh, rh;
#pragma unroll
        for (int e = 0; e < 4; ++e) { const float Le = L[e] + P; const float ep = __expf(Le), en = __expf(-Le), epv = __expf(Le - lw[e]);
            const float kk = kx[ct][e] * kkg * rn[e];
            ah[e] = -kk * epv; bh[e] = kk * av[ct][e] * en; kh[e] = kd[ct][e] * en; rh[e] = rx[ct][e] * ep; }
        const int ro = (16 * ct + kl) * 32 + q * 8;
        *(LAS v2u*)(slot + O_AT + ro) = pack4(ah); *(LAS v2u*)(slot + O_BT + ro) = pack4(bh); *(LAS v2u*)(slot + O_KT + ro) = pack4(kh); *(LAS v2u*)(slot + O_RT + ro) = pack4(rh);
        *(LAS v2u*)(slot + O_VT + ro) = pack4(vx[ct]);
        if (q == 0) *(LAS float*)(slot + O_GC + (16 * ct + kl) * 4) = __expf(Ltot);
    }
    LDS_WAIT();
    f32x4 OA = z4, OAT = z4, OAK = z4, ORB = z4, ORK = z4;
#pragma unroll
    for (int m = 0; m < 2; ++m) { const bf16x8 tA = trop(slot + O_AT, m, lane), tB = trop(slot + O_BT, m, lane), tK = trop(slot + O_KT, m, lane), tR = trop(slot + O_RT, m, lane);
        OA = MFMA16(tA, tB, OA); OAT = MFMA16(tB, tA, OAT); OAK = MFMA16(tK, tA, OAK); ORB = MFMA16(tB, tR, ORB); ORK = MFMA16(tK, tR, ORK); }
    f32x4 Z;
#pragma unroll
    for (int e = 0; e < 4; ++e) { const int rr = 4 * q + e;
        OA[e] = (kl < rr) ? OA[e] : 0.f;
        OAT[e] = (rr < kl) ? OAT[e] : 0.f;
        OAK[e] = (rr < kl) ? OAK[e] : 0.f; ORB[e] = (rr <= kl) ? ORB[e] : 0.f; ORK[e] = (rr <= kl) ? ORK[e] : 0.f;
        Z[e] = OAT[e] + ((rr == kl) ? 1.0f : 0.f); }
    *(LAS v2u*)(slot + O_MAK + lane * 8) = pack4(OAK); *(LAS v2u*)(slot + O_MRB + lane * 8) = pack4(ORB); *(LAS v2u*)(slot + O_MRK + lane * 8) = pack4(ORK);
    const bf16x8 pA = frag4(OA), pAT = frag4(OAT);
    const f32x4 OA2 = MFMA16(pAT, pA, z4), OA2T = MFMA16(pA, pAT, z4);
    const bf16x8 pA2 = frag4(OA2), pA2T = frag4(OA2T);
    const f32x4 OA4 = MFMA16(pA2T, pA2, z4), OA4T = MFMA16(pA2, pA2T, z4);
    const bf16x8 pA4 = frag4(OA4), pA4T = frag4(OA4T);
    const f32x4 OA8 = MFMA16(pA4T, pA4, z4);
    Z = MFMA16(pA2, frag4(Z), Z);
    Z = MFMA16(pA4, frag4(Z), Z);
    Z = MFMA16(frag4(OA8), frag4(Z), Z);
    *(LAS v2u*)(slot + O_MTM + lane * 8) = pack4(Z);
}

__device__ __forceinline__ v2u scan_chunk(f32x4 (&acc)[4], LAS const unsigned char* slot, int vs, int lane, bool rev) {
    const int kl = lane & 15, q = lane >> 4;
    const f32x4 z4 = (f32x4){0.f, 0.f, 0.f, 0.f}; const v2u z2 = (v2u){0u, 0u};
    const bf16x8 Sb0 = frag(pack4(acc[0]), pack4(acc[1])), Sb1 = frag(pack4(acc[2]), pack4(acc[3]));
    const v2u Vv = *(const LAS v2u*)(slot + O_VT + (16 * vs + kl) * 32 + q * 8);
    f32x4 X = MFMA16(frag(*(const LAS v2u*)(slot + O_MAK + lane * 8), z2), frag(Vv, z2), z4);
    X = MFMA16(trop(slot + O_AT, 0, lane), Sb0, X); X = MFMA16(trop(slot + O_AT, 1, lane), Sb1, X);
    const f32x4 Ut = MFMA16(frag(*(const LAS v2u*)(slot + O_MTM + lane * 8), z2), frag4(X), z4);
    const bf16x8 UV = frag(pack4(Ut), Vv);
    f32x4 Yt = MFMA16(trop(slot + O_RT, 0, lane), Sb0, z4); Yt = MFMA16(trop(slot + O_RT, 1, lane), Sb1, Yt);
    Yt = MFMA16(frag(*(const LAS v2u*)(slot + O_MRB + lane * 8), *(const LAS v2u*)(slot + O_MRK + lane * 8)), UV, Yt);
    v2u w; if (rev) { w.x = cvtpk(Yt[3], Yt[2]); w.y = cvtpk(Yt[1], Yt[0]); } else { w.x = cvtpk(Yt[0], Yt[1]); w.y = cvtpk(Yt[2], Yt[3]); }
#pragma unroll
    for (int kt = 0; kt < 4; ++kt) {
        const int ro = (16 * kt + kl) * 32 + q * 8;
        acc[kt] = MFMA16(frag(*(const LAS v2u*)(slot + O_BT + ro), *(const LAS v2u*)(slot + O_KT + ro)), UV, acc[kt]);
        acc[kt] = acc[kt] * *(const LAS f32x4*)(slot + O_GC + (16 * kt + 4 * q) * 4);
    }
    return w;
}

__device__ __forceinline__ void phase(Frame& F, const Args& a) {
    const int b = F.vcu >> 3, h = F.vcu & 7; const int w = F.wave, lane = F.lane;
    const int dir = w >> 2, vs = w & 3;
    LAS unsigned char* slots = F.lds;
    LAS float* cst = (LAS float*)(F.lds + CST_OFF);
    for (int idx = F.tid; idx < 12 * 64; idx += 512) { const int arr = idx >> 6, j = idx & 63; float v = 0.f;
        if (arr < 5) v = 0.f;
        else if (arr < 7) v = a.in[11][(arr - 5) * RW + 64 * h + j];
        else if (arr < 9) v = a.in[9][(arr - 7) * RW + 64 * h + j];
        else v = a.in[14 + (arr - 9)][64 * h + j];
        cst[idx] = v; }
    {
        const bf16* WU = (const bf16*)(a.ws + WS_WUPT); const bf16* AU = (const bf16*)(a.ws + WS_AUPT);
        for (int idx = F.tid; idx < 4 * 64 * 8; idx += 512) { const int ch16 = idx & 7, row = (idx >> 3) & 63, tb = idx >> 9; const int d = tb >> 1;
            const bf16* src = ((tb & 1) ? AU : WU) + ((size_t)d * RW + 64 * h + row) * 64 + 8 * ch16;
            *(LAS v4u*)(F.lds + LORA_OFF + tb * LORA_TAB + row * LORA_ROW + ch16 * 16) = *(const v4u*)src; }
    }
    const bf16* RK = (const bf16*)(a.ws + WS_RKVS); const bf16* TD = (const bf16*)(a.ws + WS_TDS);
    bf16* Y = (bf16*)(a.ws + (dir ? WS_YB : WS_YF)) + ((size_t)b * 8 + h) * (SEQ / 4) * 64 * 4;
    f32x4 acc[4];
#pragma unroll
    for (int kt = 0; kt < 4; ++kt) acc[kt] = (f32x4){0.f, 0.f, 0.f, 0.f};
#if DBG_WKV_FLAGS
    const bool f_noscan = (F.flags >> 18) & 1u, f_noprep = (F.flags >> 19) & 1u, f_nostore = (F.flags >> 20) & 1u;
#else
    constexpr bool f_noscan = false, f_noprep = false, f_nostore = false;
#endif
    v4u raw[NRAW]; v2u yq[4] = {{0u, 0u}, {0u, 0u}, {0u, 0u}, {0u, 0u}};
    prep_load(raw, RK, TD, b, h, dir, vs, lane);
    LDS_WAIT(); __builtin_amdgcn_s_barrier(); asm volatile("" ::: "memory");
    for (int R = 0; R < SEQ / 64; ++R) {
        if (!f_noprep) prep(raw, a, b, h, dir, 4 * R + vs, slots + w * SLOT, cst, lane, f_nostore);
        else { unsigned x = 0;
#pragma unroll
            for (int i = 0; i < NRAW; ++i) x ^= raw[i].x ^ raw[i].y ^ raw[i].z ^ raw[i].w;
            asm volatile("" :: "v"(x)); }
        LDS_WAIT(); __builtin_amdgcn_s_barrier(); asm volatile("" ::: "memory");
        if (R > 0 && !f_nostore) {
#pragma unroll
            for (int ci = 0; ci < 4; ++ci) { const int c = 4 * (R - 1) + ci; const int g = dir ? (SEQ / 4 - 1 - (4 * c + (lane >> 4))) : (4 * c + (lane >> 4));
                *(v2u*)(Y + ((size_t)g * 64 + 16 * vs + (lane & 15)) * 4) = yq[ci]; } }
        if (R + 1 < SEQ / 64) prep_load(raw, RK, TD, b, h, dir, 4 * (R + 1) + vs, lane);
        asm volatile("" ::: "memory");
        if (!f_noscan) {
#pragma unroll
            for (int ci = 0; ci < 4; ++ci) yq[ci] = scan_chunk(acc, slots + (dir * 4 + ci) * SLOT, vs, lane, dir != 0);
        }
        LDS_WAIT(); __builtin_amdgcn_s_barrier(); asm volatile("" ::: "memory");
    }
    if (!f_nostore) {
#pragma unroll
        for (int ci = 0; ci < 4; ++ci) { const int c = 4 * (SEQ / 64 - 1) + ci; const int g = dir ? (SEQ / 4 - 1 - (4 * c + (lane >> 4))) : (4 * c + (lane >> 4));
            *(v2u*)(Y + ((size_t)g * 64 + 16 * vs + (lane & 15)) * 4) = yq[ci]; } }
    if (f_nostore) { asm volatile("" :: "v"(acc[0]), "v"(acc[1]), "v"(acc[2]), "v"(acc[3])); }
}
#undef MFMA16
}

__device__ __forceinline__ void p4_finalize(Frame& F, const Args& a) {
    const bf16* __restrict__ RK = (const bf16*)(a.ws + WS_RKVS); const bf16* __restrict__ TD = (const bf16*)(a.ws + WS_TDS); const bf16* __restrict__ GT = (const bf16*)(a.ws + WS_GUPT);
    const bf16* __restrict__ YF = (const bf16*)(a.ws + WS_YF); const bf16* __restrict__ YB = (const bf16*)(a.ws + WS_YB);
    const float* __restrict__ BON = (const float*)(a.ws + WS_BON); bf16* __restrict__ MIX = (bf16*)(a.ws + WS_MIX);
    const float* __restrict__ ln_w = a.in[17]; const float* __restrict__ ln_b = a.in[18];
    const int gw = F.vcu * NWAVES + F.wave; const int kl = F.lane & 15, q = F.lane >> 4; const int b = F.vcu >> 3;
    LAS unsigned char* stg = F.lds + F.wave * (16 * 1040);
    for (int i = 0; i < 2; ++i) {
        const size_t row0 = (size_t)(gw * 2 + i) * 16; const int t0 = (int)(row0 & (SEQ - 1)); const int g = (t0 >> 2) + q;
        bf16x8 sg[4];
#pragma unroll
        for (int ks = 0; ks < 4; ++ks) sg[ks] = *(const bf16x8*)(TD + ((size_t)b * SEQ + ((t0 + kl + 4 * grot(b)) & (SEQ - 1))) * 256 + 128 + 32 * ks + 8 * q);
        v2u n_yf[4], n_yb[4], n_vv[4]; f32x4 n_bf, n_bb; float n_lw[4], n_lb[4]; bf16x8 n_gt[4][4];
#define P4_LOAD(HH) do { _Pragma("unroll") for (int ct = 0; ct < 4; ++ct) { const int ch_ = 64 * (HH) + 16 * ct + kl; \
            const size_t yo_ = ((((size_t)b * 8 + (HH)) * (SEQ / 4) + g) * 64 + 16 * ct + kl) * 4; \
            n_yf[ct] = *(const v2u*)(YF + yo_); n_yb[ct] = *(const v2u*)(YB + yo_); \
            n_vv[ct] = *(const v2u*)(RK + (((size_t)b * (SEQ / 4) + ((g + grot(b)) & (SEQ / 4 - 1))) * 1536 + 1024 + ch_) * 4); n_lw[ct] = ln_w[ch_]; n_lb[ct] = ln_b[ch_]; \
            _Pragma("unroll") for (int ks = 0; ks < 4; ++ks) n_gt[ct][ks] = *(const bf16x8*)(GT + (size_t)ch_ * 128 + 32 * ks + 8 * q); } \
            const size_t bo_ = ((size_t)b * 8 + (HH)) * SEQ + t0 + 4 * q; n_bf = *(const f32x4*)(BON + bo_); n_bb = *(const f32x4*)(BON + (size_t)MT * 8 + bo_); } while (0)
        P4_LOAD(0);
#pragma clang loop unroll(disable)
        for (int hh = 0; hh < 8; ++hh) {
            f32x4 acc[4], y[4], vs[4]; float lw[4], lb[4];
#pragma unroll
            for (int ct = 0; ct < 4; ++ct) {
                y[ct] = (f32x4){bflo(n_yf[ct].x) + bflo(n_yb[ct].x), bfhi(n_yf[ct].x) + bfhi(n_yb[ct].x), bflo(n_yf[ct].y) + bflo(n_yb[ct].y), bfhi(n_yf[ct].y) + bfhi(n_yb[ct].y)};
                vs[ct] = (f32x4){bflo(n_vv[ct].x), bfhi(n_vv[ct].x), bflo(n_vv[ct].y), bfhi(n_vv[ct].y)}; lw[ct] = n_lw[ct]; lb[ct] = n_lb[ct]; }
            const f32x4 bon = n_bf + n_bb;
#pragma unroll
            for (int ct = 0; ct < 4; ++ct) { acc[ct] = (f32x4){0.f, 0.f, 0.f, 0.f};
#pragma unroll
                for (int ks = 0; ks < 4; ++ks) acc[ct] = __builtin_amdgcn_mfma_f32_16x16x32_bf16(sg[ks], n_gt[ct][ks], acc[ct], 0, 0, 0); }
            if (hh + 1 < 8) P4_LOAD(hh + 1);
            f32x4 sm = (y[0] + y[1]) + (y[2] + y[3]);
#pragma unroll
            for (int e = 0; e < 4; ++e) sm[e] = wkv::red16(sm[e]);
            const f32x4 mean = sm * (1.0f / 64.0f); f32x4 vq = (f32x4){0.f, 0.f, 0.f, 0.f};
#pragma unroll
            for (int ct = 0; ct < 4; ++ct) { y[ct] = y[ct] - mean; vq += y[ct] * y[ct]; }
            f32x4 rstd;
#pragma unroll
            for (int e = 0; e < 4; ++e) rstd[e] = __builtin_amdgcn_rsqf(wkv::red16(vq[e]) * (1.0f / 64.0f) + GN_EPS);
#pragma unroll
            for (int ct = 0; ct < 4; ++ct) { const f32x4 o = ((y[ct] * rstd) * lw[ct] + lb[ct] + vs[ct] * bon) * acc[ct];
#pragma unroll
                for (int e = 0; e < 4; ++e) *(LAS unsigned short*)(stg + (4 * q + e) * 1040 + (64 * hh + 16 * ct + kl) * 2) = (unsigned short)f2bf(o[e]); }
        }
#undef P4_LOAD
        LDS_WAIT();
#pragma unroll
        for (int r = 0; r < 16; ++r) { const v4u w = *(const LAS v4u*)(stg + r * 1040 + F.lane * 16); *(v4u*)(MIX + (row0 + r) * DM + 512 + F.lane * 8) = w; }
        LDS_WAIT();
    }
}

__device__ __forceinline__ void p6_norm_router(Frame& F, const Args& a) {
    LAS float* wr = (LAS float*)F.lds;
    for (int i = F.tid; i < DM * NE; i += 512) { const int k = i >> 4, e = i & 15; wr[e * DM + k] = a.in[21][i]; }
    __syncthreads();
    const float* mod = (const float*)(a.ws + WS_MOD); unsigned char* H2 = a.ws + WS_H; float* AFF = (float*)(a.ws + WS_AFF);
    const int gw = F.vcu * NWAVES + F.wave; const int b = F.vcu >> 3; const int lane = F.lane;
    f32x4 gs[4], sh[4];
#pragma unroll
    for (int j = 0; j < 4; ++j) { const int c = 4 * lane + 256 * j; const f32x4 g = *(const f32x4*)(a.in[20] + c); const f32x4 sc = *(const f32x4*)(mod + b * 6 * DM + 4 * DM + c);
        gs[j] = g * (sc + 1.0f); sh[j] = *(const f32x4*)(mod + b * 6 * DM + 3 * DM + c); }
    const bf16* X1 = (const bf16*)(a.ws + WS_X1);
    v2u vn[4];
    { const GAS v2u* xr = (const GAS v2u*)(X1 + (size_t)gw * 32 * DM) + lane;
#pragma unroll
      for (int j = 0; j < 4; ++j) vn[j] = xr[64 * j]; }
    for (int i = 0; i < 32; ++i) {
        const size_t row = (size_t)gw * 32 + i;
        f32x4 v[4]; float s2 = 0.f;
#pragma unroll
        for (int j = 0; j < 4; ++j) { v[j] = (f32x4){bflo(vn[j].x), bfhi(vn[j].x), bflo(vn[j].y), bfhi(vn[j].y)}; s2 += (v[j].x * v[j].x + v[j].y * v[j].y) + (v[j].z * v[j].z + v[j].w * v[j].w); }
        if (i + 1 < 32) { const GAS v2u* xr = (const GAS v2u*)(X1 + (row + 1) * DM) + lane;
#pragma unroll
            for (int j = 0; j < 4; ++j) vn[j] = xr[64 * j]; }
        asm volatile("" ::: "memory");
        const float rstd = 1.0f / sqrtf(wave_sum(s2) * (1.0f / DM) + NORM_EPS);
        GAS unsigned* o4 = (GAS unsigned*)(H2 + row * DM) + lane;
#pragma unroll
        for (int j = 0; j < 4; ++j) { v[j] = v[j] * rstd * gs[j] + sh[j]; unsigned w = 0u;
            w = cvt2_fp8(v[j].x * 4.0f, v[j].y * 4.0f, w, false); w = cvt2_fp8(v[j].z * 4.0f, v[j].w * 4.0f, w, true); o4[64 * j] = w; }
        float d[16];
#pragma unroll
        for (int e = 0; e < 16; ++e) { float acc = 0.f;
#pragma unroll
            for (int j = 0; j < 4; ++j) { const f32x4 w = *(const LAS f32x4*)(wr + e * DM + 4 * lane + 256 * j); acc += (v[j].x * w.x + v[j].y * w.y) + (v[j].z * w.z + v[j].w * w.w); }
            d[e] = acc; asm volatile("" ::: "memory"); }
#pragma unroll
        for (int k = 0; k < 8; ++k) { auto r = __builtin_amdgcn_permlane32_swap(__float_as_uint(d[k]), __float_as_uint(d[k + 8]), false, false); d[k] = __uint_as_float(r[0]) + __uint_as_float(r[1]); }
#pragma unroll
        for (int k = 0; k < 4; ++k) { auto r = __builtin_amdgcn_permlane16_swap(__float_as_uint(d[k]), __float_as_uint(d[k + 4]), false, false); d[k] = __uint_as_float(r[0]) + __uint_as_float(r[1]); }
        { const bool up = (lane & 8) != 0;
#pragma unroll
          for (int k = 0; k < 2; ++k) { const float send = up ? d[k] : d[k + 2], keep = up ? d[k + 2] : d[k];
              d[k] = keep + __builtin_bit_cast(float, __builtin_amdgcn_update_dpp(0, __builtin_bit_cast(int, send), 0x128, 0xf, 0xf, false)); } }
        { const bool up = (lane & 4) != 0; const float send = up ? d[0] : d[1], keep = up ? d[1] : d[0]; d[0] = keep + __shfl_xor(send, 4); }
        float lg = d[0]; lg = DPP_ADD(lg, 0x4E); lg = DPP_ADD(lg, 0xB1);
        float mx = lg;
        mx = fmaxf(mx, __shfl_xor(mx, 4)); mx = fmaxf(mx, __builtin_bit_cast(float, __builtin_amdgcn_update_dpp(0, __builtin_bit_cast(int, mx), 0x128, 0xf, 0xf, false)));
        { auto r = __builtin_amdgcn_permlane16_swap(__float_as_uint(mx), __float_as_uint(mx), false, false); mx = fmaxf(__uint_as_float(r[0]), __uint_as_float(r[1])); }
        { auto r = __builtin_amdgcn_permlane32_swap(__float_as_uint(mx), __float_as_uint(mx), false, false); mx = fmaxf(__uint_as_float(r[0]), __uint_as_float(r[1])); }
        const float pe = expf(lg - mx); float sm = pe;
        sm += __shfl_xor(sm, 4); sm = DPP_ADD(sm, 0x128); sm = xor32_sum(xor16_sum(sm));
        if ((lane & 3) == 0) AFF[((size_t)b * NE + (lane >> 2)) * SEQ + (row & (SEQ - 1))] = pe / sm;
    }
    __syncthreads();
}

__device__ __forceinline__ void p7_topk_gather(Frame& F, const Args& a) {
    LAS unsigned* red = (LAS unsigned*)F.lds;
    const float* AFF = (const float*)(a.ws + WS_AFF); int* IDX = (int*)(a.ws + WS_IDX); float* VAL = (float*)(a.ws + WS_VAL); int* INV = (int*)(a.ws + WS_INV);
    const int tid = F.tid, lane = F.lane, wave = F.wave;
    f32x4 v[2]; unsigned u[2][4], T[2] = {0u, 0u};
#pragma unroll
    for (int pr = 0; pr < 2; ++pr) { v[pr] = *(const f32x4*)(AFF + (size_t)(F.vcu * 2 + pr) * SEQ + 4 * tid);
#pragma unroll
        for (int j = 0; j < 4; ++j) u[pr][j] = __float_as_uint(v[pr][j]); }
    constexpr int XITEMS = 3 * NE * (DM / 64) * (FF / 32);
    const int xgw = F.vcu * NWAVES + wave, XNGW = F.G * NWAVES;
    LAS float* xscr = (LAS float*)(F.lds + 4096 + wave * 8448);
    int xit = xgw; float xt[32]; ExpItem xcur;
    if (xit < XITEMS) { xcur = exp_item(a, xit); exp_item_load(xcur, xt, lane); }
    int par = 0;
    for (int bit = 30; bit >= 0; --bit) {
        unsigned cand[2];
#pragma unroll
        for (int pr = 0; pr < 2; ++pr) { cand[pr] = T[pr] | (1u << bit);
            const int c = __builtin_popcountll(__ballot(u[pr][0] >= cand[pr])) + __builtin_popcountll(__ballot(u[pr][1] >= cand[pr])) + __builtin_popcountll(__ballot(u[pr][2] >= cand[pr])) + __builtin_popcountll(__ballot(u[pr][3] >= cand[pr]));
            if (lane == 0) red[(par * 2 + pr) * 8 + wave] = (unsigned)c; }
        LDS_WAIT(); __builtin_amdgcn_s_barrier(); asm volatile("" ::: "memory");
#pragma unroll
        for (int pr = 0; pr < 2; ++pr) { unsigned tot = 0;
#pragma unroll
            for (int w = 0; w < 8; ++w) tot += red[(par * 2 + pr) * 8 + w];
            if (tot >= (unsigned)CAP) T[pr] = cand[pr]; }
        par ^= 1;
        if (xit < XITEMS) { exp_item_store(xcur, xt, xscr, lane); xit += XNGW; if (xit < XITEMS) { xcur = exp_item(a, xit); exp_item_load(xcur, xt, lane); } }
    }
    while (xit < XITEMS) { exp_item_store(xcur, xt, xscr, lane); xit += XNGW; if (xit < XITEMS) { xcur = exp_item(a, xit); exp_item_load(xcur, xt, lane); } }
    int pk[2], inc[2];
#pragma unroll
    for (int pr = 0; pr < 2; ++pr) {
        const int cg = (u[pr][0] > T[pr]) + (u[pr][1] > T[pr]) + (u[pr][2] > T[pr]) + (u[pr][3] > T[pr]), ce = (u[pr][0] == T[pr]) + (u[pr][1] == T[pr]) + (u[pr][2] == T[pr]) + (u[pr][3] == T[pr]);
        pk[pr] = cg | (ce << 16); inc[pr] = pk[pr];
#pragma unroll
        for (int o = 1; o < 64; o <<= 1) { const int n = __shfl_up(inc[pr], o); if (lane >= o) inc[pr] += n; }
        if (lane == 63) red[64 + 16 * pr + wave] = (unsigned)inc[pr]; }
    __syncthreads();
#pragma unroll
    for (int pr = 0; pr < 2; ++pr) {
        const int p = F.vcu * 2 + pr; const int b = p >> 4, e = p & 15;
        int base = 0, total = 0;
#pragma unroll
        for (int w = 0; w < 8; ++w) { const int tw = (int)red[64 + 16 * pr + w]; if (w < wave) base += tw; total += tw; }
        const int excl = base + inc[pr] - pk[pr];
        int gtb = excl & 0xffff, eqb = excl >> 16; const int need_eq = CAP - (total & 0xffff);
#pragma unroll
        for (int j = 0; j < 4; ++j) {
            const bool g = u[pr][j] > T[pr], q = u[pr][j] == T[pr]; const bool sel = g || (q && eqb < need_eq);
            const int slot = gtb + (eqb < need_eq ? eqb : need_eq); const int t = 4 * tid + j;
            if (sel) { IDX[p * CAP + slot] = t; VAL[p * CAP + slot] = v[pr][j]; }
            INV[((size_t)b * SEQ + t) * NE + e] = sel ? slot : -1;
            gtb += g ? 1 : 0; eqb += q ? 1 : 0;
        }
    }
    __syncthreads();
}

struct GuOrder { int vcu; const LAS unsigned short* lidx;
    static constexpr bool GATHER = true;
    __device__ __forceinline__ unsigned a_base(const pg8::Unit& u) const { return (unsigned)(u.pm >> 4) * (unsigned)(SEQ * DM); }
    __device__ __forceinline__ void rows(const pg8::Unit& u, unsigned (&g)[2][2]) const {
        int tid = threadIdx.x; asm volatile("" : "+v"(tid));
#pragma unroll
        for (int i = 0; i < 2; ++i) { int R, C; pg8::stage_rc(tid * 16 + i * 8192, R, C);
#pragma unroll
            for (int h = 0; h < 2; ++h) g[h][i] = (unsigned)lidx[(u.pm & 15) * CAP + 128 * h + R] * (unsigned)DM + (unsigned)C * 2u; } }
    __device__ __forceinline__ bool next(int i, pg8::Unit& u) const { if (i >= NE) return false; const int b = vcu >> 3, pn = vcu & 7; u.pm = b * NE + i; u.pn = pn; u.bt = i * 8 + pn; return true; } };
struct DownOrder { int vcu; static constexpr bool GATHER = false;
    __device__ __forceinline__ bool next(int i, pg8::Unit& u) const { if (i >= NE / 2) return false; const int b = vcu >> 3, j = vcu & 7, e = 2 * i + (j >> 2); u.pm = b * NE + e; u.pn = j & 3; u.bt = e * 4 + (j & 3); return true; } };
struct EpiSwiGLU {
    static constexpr bool PERM = true;
    unsigned char* HID;
    __device__ __forceinline__ void operator()(const f32x4 (&acc)[2][2][4][2], const pg8::Unit& u, int wr, int wc, int fr, int fq) const {
        { int l_ = threadIdx.x; asm volatile("" : "+v"(l_)); fr = l_ & 15; fq = (l_ >> 4) & 3; }
        const int row0 = u.pm * 256 + wr * 64 + fr, col0 = u.pn * 128 + wc * 32 + 8 * fq;
        const __amdgpu_buffer_rsrc_t hrs = __builtin_amdgcn_make_buffer_rsrc((void*)HID, 0, 0x7fffffff, 0x00020000);
#pragma unroll
        for (int ai = 0; ai < 2; ++ai)
#pragma unroll
            for (int m = 0; m < 4; ++m) {
                unsigned w[2];
#pragma unroll
                for (int n = 0; n < 2; ++n) { const f32x4 g = acc[ai][0][m][n], up = acc[ai][1][m][n]; f32x4 h;
#pragma unroll
                    for (int e = 0; e < 4; ++e) { const float gg = g[e] * (1.0f / 128.0f); h[e] = gg * __builtin_amdgcn_rcpf(1.0f + __expf(-gg)) * up[e] * (8.0f / 128.0f); }
                    unsigned x = 0u; x = cvt2_fp8(h[0], h[1], x, false); x = cvt2_fp8(h[2], h[3], x, true); w[n] = x; }
                v2u wv; wv.x = w[0]; wv.y = w[1];
                __builtin_amdgcn_raw_buffer_store_b64(wv, hrs, (unsigned)(row0 + ai * 128 + m * 16) * (unsigned)FF + (unsigned)col0, 0, 0);
            }
    }
};
struct EpiDown {
    static constexpr bool PERM = true;
    unsigned char* Y; const float* VAL; const float* mod;
    __device__ __forceinline__ void operator()(const f32x4 (&acc)[2][2][4][2], const pg8::Unit& u, int wr, int wc, int fr, int fq) const {
        { int l_ = threadIdx.x; asm volatile("" : "+v"(l_)); fr = l_ & 15; fq = (l_ >> 4) & 3; }
        const int row0 = u.pm * 256 + wr * 64 + fr, col0 = u.pn * 256 + wc * 64 + 16 * fq; const int b = u.pm >> 4;
        f32x4 gt[2][2];
#pragma unroll
        for (int bj = 0; bj < 2; ++bj)
#pragma unroll
            for (int n = 0; n < 2; ++n) gt[bj][n] = *(const f32x4*)(mod + b * 6 * DM + 5 * DM + col0 + 8 * bj + 4 * n);
        const __amdgpu_buffer_rsrc_t yrs = __builtin_amdgcn_make_buffer_rsrc((void*)Y, 0, 0x7fffffff, 0x00020000);
        float vls[2][4];
#pragma unroll
        for (int ai = 0; ai < 2; ++ai)
#pragma unroll
            for (int m = 0; m < 4; ++m) vls[ai][m] = VAL[row0 + ai * 128 + m * 16] * (64.0f / 256.0f);
#pragma unroll
        for (int ai = 0; ai < 2; ++ai)
#pragma unroll
            for (int m = 0; m < 4; ++m) { const int row = row0 + ai * 128 + m * 16; const float vl = vls[ai][m];
                unsigned w[4];
#pragma unroll
                for (int bj = 0; bj < 2; ++bj)
#pragma unroll
                    for (int n = 0; n < 2; ++n) { const f32x4 v = acc[ai][bj][m][n] * gt[bj][n] * vl; unsigned x = 0u;
                        x = cvt2_fp8(v[0], v[1], x, false); x = cvt2_fp8(v[2], v[3], x, true); w[2 * bj + n] = x; }
                v4u wv; wv.x = w[0]; wv.y = w[1]; wv.z = w[2]; wv.w = w[3];
                __builtin_amdgcn_raw_buffer_store_b128(wv, yrs, (unsigned)row * (unsigned)DM + (unsigned)col0, 0, 0); }
    }
};

__device__ __forceinline__ void p10_combine(Frame& F, const Args& a) {
    const int* INV = (const int*)(a.ws + WS_INV); const unsigned char* Y = a.ws + WS_Y;
    const int gw = F.vcu * NWAVES + F.wave; const int b = F.vcu >> 3; const int lane = F.lane;
    const bool nostore = (F.flags >> 20) & 1u;
    int inv_n[2];
#pragma unroll
    for (int r = 0; r < 2; ++r) inv_n[r] = INV[((size_t)gw * 32 + r) * NE + (lane & 15)];
    const bf16* X1 = (const bf16*)(a.ws + WS_X1);
    v2u vnx[2][4];
#pragma unroll
    for (int r = 0; r < 2; ++r) { const GAS v2u* xr = (const GAS v2u*)(X1 + ((size_t)gw * 32 + r) * DM) + lane;
#pragma unroll
        for (int j = 0; j < 4; ++j) vnx[r][j] = xr[64 * j]; }
    for (int i = 0; i < 32; i += 2) {
        const size_t row = (size_t)gw * 32 + i;
        int inv[2]; inv[0] = inv_n[0]; inv[1] = inv_n[1];
        if (i + 2 < 32) {
#pragma unroll
            for (int r = 0; r < 2; ++r) inv_n[r] = INV[(row + 2 + r) * NE + (lane & 15)]; }
        f32x4 v[2][4];
#pragma unroll
        for (int r = 0; r < 2; ++r)
#pragma unroll
            for (int j = 0; j < 4; ++j) v[r][j] = (f32x4){bflo(vnx[r][j].x), bfhi(vnx[r][j].x), bflo(vnx[r][j].y), bfhi(vnx[r][j].y)};
        if (i + 2 < 32) {
#pragma unroll
            for (int r = 0; r < 2; ++r) { const GAS v2u* xr = (const GAS v2u*)(X1 + (row + 2 + r) * DM) + lane;
#pragma unroll
                for (int j = 0; j < 4; ++j) vnx[r][j] = xr[64 * j]; } }
        unsigned m0 = (unsigned)(__ballot(inv[0] >= 0) & 0xffffull), m1 = (unsigned)(__ballot(inv[1] >= 0) & 0xffffull);
        while (m0 | m1) {
            unsigned w[2][3][4]; bool hit[2][3];
#pragma unroll
            for (int r = 0; r < 2; ++r)
#pragma unroll
                for (int k = 0; k < 3; ++k) { unsigned& mm = r ? m1 : m0; hit[r][k] = mm != 0u;
                    if (hit[r][k]) { const int e = __builtin_ctz(mm); mm &= mm - 1u; const int sl = __builtin_amdgcn_readlane(inv[r], e);
                        const unsigned char* yr = Y + ((size_t)(b * NE + e) * CAP + sl) * DM + 4 * lane;
#pragma unroll
                        for (int j = 0; j < 4; ++j) w[r][k][j] = *(const unsigned*)(yr + 256 * j); } }
#pragma unroll
            for (int r = 0; r < 2; ++r)
#pragma unroll
                for (int k = 0; k < 3; ++k) if (hit[r][k]) {
#pragma unroll
                    for (int j = 0; j < 4; ++j) { const f32x2 lo = __builtin_amdgcn_cvt_pk_f32_fp8(w[r][k][j], false), hi = __builtin_amdgcn_cvt_pk_f32_fp8(w[r][k][j], true);
                        v[r][j].x += lo.x * (1.0f / 64.0f); v[r][j].y += lo.y * (1.0f / 64.0f); v[r][j].z += hi.x * (1.0f / 64.0f); v[r][j].w += hi.y * (1.0f / 64.0f); } }
        }
        if (!nostore) {
#pragma unroll
            for (int r = 0; r < 2; ++r) { GAS f32x4* xr = (GAS f32x4*)(a.out + (row + r) * DM) + lane;
#pragma unroll
                for (int j = 0; j < 4; ++j) xr[64 * j] = v[r][j]; }
        } else asm volatile("" :: "v"(v[0][0]), "v"(v[0][1]), "v"(v[0][2]), "v"(v[0][3]), "v"(v[1][0]), "v"(v[1][1]), "v"(v[1][2]), "v"(v[1][3]));
    }
}

__global__ void __launch_bounds__(NWAVES * 64, 2) fwd_kernel(Args args) {
    extern __shared__ __attribute__((aligned(16))) unsigned char lds[];
    cg::grid_group grid = cg::this_grid();
    Frame F;
    F.lds = (LAS unsigned char*)lds;
    F.tid = threadIdx.x; F.lane = F.tid & 63; F.wave = __builtin_amdgcn_readfirstlane(F.tid >> 6);
    F.G = gridDim.x; { const int bx = blockIdx.x; F.vcu = (F.G % 8 == 0) ? (bx % 8) * (F.G / 8) + bx / 8 : bx; }
    unsigned char* ws = args.ws;
    const unsigned mask = args.mask; F.flags = mask;
    volatile LAS unsigned* MISC = (volatile LAS unsigned*)(F.lds + MISC_OFF);
    if (F.tid < 32) MISC[F.tid] = 0u;
    __syncthreads();
    XcdBarrier bar; bar.bar = (unsigned*)(ws + WS_CTL) + CW_BAR; bar.x = 0; bar.st = nullptr;
    const bool one_launch = __builtin_popcount(mask & 0x7ffu) > 1;
    if (one_launch) bar = xcd_barrier_post((unsigned*)(ws + WS_CTL) + CW_BAR, MISC + 8);
    if (one_launch) grid.sync();
#define REFRESH() do { F.tid = threadIdx.x; asm volatile("" : "+v"(F.tid)); F.lane = F.tid & 63; } while (0)
#define IN(k) ((mask >> (k)) & 1u)
#define SEAM(k) do { if (IN(k) && ((mask & 0x7ffu) >> ((k) + 1)) != 0u) xcd_barrier(bar); REFRESH(); } while (0)

    if (IN(0)) { p0_prologue(F, args); } SEAM(0);
    if (IN(1)) { p1_norm(F, args); } SEAM(1);
    if (IN(2)) {
        pg8::Gemm g{(const bf16*)(ws + WS_H), (const bf16*)(ws + WS_WIN), MT, NIN, DM}; pg8::StaticOrder S; S.init(MT, NIN, F.G, (int)blockIdx.x);
        EpiInProj E{(bf16*)(ws + WS_Q), (bf16*)(ws + WS_K), (bf16*)(ws + WS_V), (bf16*)(ws + WS_PR), args.in[6], args.in[7], (const float*)(ws + WS_ROPE)};
        pg8::gemm_phase<EpiInProj, pg8::StaticOrder, true, true>(F.lds, g, S, E, (mask >> 22) & 1u);
    } SEAM(2);
    if (IN(3)) {
        const int b = F.vcu >> 3, h = F.vcu & 7;
        if (!((mask >> 16) & 1u)) {
            prs_pass(F, args);
            REFRESH();
            float bref;
            { float gq = fabsf(args.in[6][F.lane]), gk = fabsf(args.in[7][F.lane]);
#pragma unroll
              for (int o_ = 1; o_ < 64; o_ <<= 1) { gq = fmaxf(gq, __shfl_xor(gq, o_)); gk = fmaxf(gk, __shfl_xor(gk, o_)); }
              bref = 64.0f * QSCALE * gq * gk * 1.02f + 0.25f; }
            for (int qb = 0; qb < 8; ++qb)
                attn_body::attn_unit<8>(b, h, qb, (const bf16*)(ws + WS_Q), (const bf16*)(ws + WS_K), (const bf16*)(ws + WS_V), (bf16*)(ws + WS_MIX), (char*)lds, qb > 0, true, bref);
            __syncthreads();
        }
        if (one_launch) xcd_barrier(bar);
        REFRESH();
        if (!((mask >> 17) & 1u)) {
            wkv::phase(F, args);
        }
    } SEAM(3);
    if (IN(4)) { p4_finalize(F, args); } SEAM(4);
    if (IN(5)) {
        pg8::Gemm g{(const bf16*)(ws + WS_MIX), (const bf16*)(ws + WS_WOUT), MT, DM, DM}; pg8::StaticOrder S; S.init(MT, DM, F.G, (int)blockIdx.x);
        EpiOutProj E{args.in[0], (bf16*)(ws + WS_X1), (const float*)(ws + WS_MOD)};
        pg8::gemm_phase<EpiOutProj, pg8::StaticOrder, true, true>(F.lds, g, S, E, (mask >> 22) & 1u);
    } SEAM(5);
    if (IN(6)) { p6_norm_router(F, args); } SEAM(6);
    if (IN(7)) { p7_topk_gather(F, args); } SEAM(7);
    if (IN(8)) {
        LAS unsigned short* lidx = (LAS unsigned short*)(F.lds + LIDX_OFF);
        { const int* IDX = (const int*)(ws + WS_IDX) + (size_t)(F.vcu >> 3) * NE * CAP; for (int i = F.tid; i < NE * CAP; i += 512) lidx[i] = (unsigned short)IDX[i]; }
        __syncthreads();
        pg8::Gemm g{(const bf16*)(ws + WS_H), (const bf16*)(ws + WS_WGU), NGROUP * CAP, 2 * FF, DM / 2}; GuOrder S{F.vcu, lidx};
        EpiSwiGLU E{ws + WS_HID};
        pg8::gemm_phase<EpiSwiGLU, GuOrder, true, true, true>(F.lds, g, S, E, (mask >> 22) & 1u);
    } SEAM(8);
    if (IN(9)) {
        pg8::Gemm g{(const bf16*)(ws + WS_HID), (const bf16*)(ws + WS_WD), NGROUP * CAP, DM, FF / 2}; DownOrder S{F.vcu};
        EpiDown E{ws + WS_Y, (const float*)(ws + WS_VAL), (const float*)(ws + WS_MOD)};
        pg8::gemm_phase<EpiDown, DownOrder, true, true, true>(F.lds, g, S, E, (mask >> 22) & 1u);
    } SEAM(9);
    if (IN(10)) { p10_combine(F, args); }
#undef IN
#undef SEAM
}

extern "C" void kernel_launch(void* const* d_in, const int* in_sizes, int n_in, void* d_out, int out_size, void* d_ws, size_t ws_size, hipStream_t stream) {
    static int grid = 0;
    if (grid == 0) {
        if (n_in != 25 || out_size != MT * DM || ws_size < WS_END) { fprintf(stderr, "kernel_launch: unexpected shapes n_in %d out %d ws %zu\n", n_in, out_size, ws_size); grid = -1; return; }
        int dev = 0, cus = 0, per_cu = 0;
        (void)hipGetDevice(&dev); (void)hipDeviceGetAttribute(&cus, hipDeviceAttributeMultiprocessorCount, dev);
        (void)hipFuncSetAttribute((const void*)fwd_kernel, hipFuncAttributeMaxDynamicSharedMemorySize, LDS_BYTES);
        (void)hipOccupancyMaxActiveBlocksPerMultiprocessor(&per_cu, (const void*)fwd_kernel, NWAVES * 64, LDS_BYTES);
        (void)hipGetLastError();
        if (per_cu < 1) { fprintf(stderr, "kernel_launch: occupancy query says %d blocks per CU\n", per_cu); grid = -1; return; }
        if (cus != NB * 8) { fprintf(stderr, "kernel_launch: built for a %d-CU device (one workgroup per (batch, head)); found %d CUs; nothing launched\n", NB * 8, cus); grid = -1; return; }
        grid = cus;
    }
    if (grid < 0) return;
    (void)hipMemsetAsync((char*)d_ws + WS_CTL, 0, CTL_ZERO_BYTES, stream);
#if !((DBG_MASK >> 5) & 1)
    (void)hipMemcpyAsync(d_out, d_in[0], (size_t)MT * DM * 4, hipMemcpyDeviceToDevice, stream);
#endif
    Args a{};
    for (int i = 0; i < 25; ++i) a.in[i] = (const float*)d_in[i];
    a.out = (float*)d_out; a.ws = (unsigned char*)d_ws;
    constexpr int NPH = 11;
#if MK_N_LAUNCHES == 1
    a.mask = DBG_MASK;
    void* kargs[] = {&a};
    hipError_t e = hipLaunchCooperativeKernel((const void*)fwd_kernel, dim3(grid), dim3(NWAVES * 64), kargs, LDS_BYTES, stream);
    if (e != hipSuccess) fprintf(stderr, "cooperative launch failed: %s (grid %d)\n", hipGetErrorString(e), grid);
#else
    for (int p = 0; p < NPH; ++p) {
        if (!((DBG_MASK >> p) & 1)) continue;
        a.mask = 1u << p;
        if (p == 3) { a.mask |= 1u << 17; hipLaunchKernelGGL(fwd_kernel, dim3(grid), dim3(NWAVES * 64), LDS_BYTES, stream, a); a.mask = (1u << 3) | (1u << 16); }
        hipLaunchKernelGGL(fwd_kernel, dim3(grid), dim3(NWAVES * 64), LDS_BYTES, stream, a);
        const int rp = DBG_REPEAT;
        if (rp == p || ((rp == 31 || rp == 32 || rp == 33) && p == 3)) {
            if (rp == 31) a.mask = (1u << 3) | (1u << 17); if (rp == 32) a.mask = (1u << 3) | (1u << 16); if (rp == 33) a.mask = (1u << 3) | (1u << 16) | (1u << 17); a.mask |= DBG_XFLAGS;
            hipLaunchKernelGGL(fwd_kernel, dim3(grid), dim3(NWAVES * 64), LDS_BYTES, stream, a);
        }
    }
#endif
}
```
